# Optimizing an MI355X kernel written in HIP

```python
import math
import jax, jax.numpy as jnp
from jax import lax
import numpy as np

D_MODEL = 2048
BATCH = 8
SEQ = 2048
DEPTH = 2

CTX_LEN = 256
GRID_W = 64
HEAD_DIM = 128
ROPE_THETA = 10000.0
Q_BLOCK = 128
EPS = 1e-6
DIFF_HEADS = 4
DIFF_V_DIM = 2 * HEAD_DIM
LRU_WIDTH = 1024
LRU_BLOCKS = 8
LRU_BLOCK_W = LRU_WIDTH // LRU_BLOCKS
CONV_W = 4
LRU_C = 8.0
GQA_HEADS = 8
GQA_KV_HEADS = 2
N_BRANCH = 3
BRANCH_W = 1024
N_GROUPS = 4
EXPERTS_PER_GROUP = 8
N_EXPERTS = N_GROUPS * EXPERTS_PER_GROUP
TOP_K = 2
D_EXPERT = 512
N_MOD = 6

A_Q = 2 * DIFF_HEADS * HEAD_DIM
A_K = 2 * DIFF_HEADS * HEAD_DIM
A_V = DIFF_HEADS * DIFF_V_DIM
C_Q = GQA_HEADS * HEAD_DIM
C_KV = GQA_KV_HEADS * HEAD_DIM
SPLITS = (A_Q, A_K, A_V, LRU_WIDTH, LRU_WIDTH, C_Q, C_KV, C_KV, N_BRANCH * D_MODEL)
IN_COLS = A_Q + A_K + A_V + 2 * LRU_WIDTH + C_Q + 2 * C_KV + N_BRANCH * D_MODEL

kernel_name = "hybrid_diff_rglru_gqa_hmoe_dit"

F32 = jnp.float32


def rms_norm(x, g):
    xf = x.astype(F32)
    y = xf * lax.rsqrt(jnp.mean(xf * xf, axis=-1, keepdims=True) + EPS)
    return (y * g.astype(F32)).astype(x.dtype)


def modulate(x, shift, scale):
    return x * (1 + scale) + shift


def axial_rope_tables(n_tokens):
    n_rows = n_tokens // GRID_W
    row = jnp.repeat(jnp.arange(n_rows), GRID_W).astype(F32)
    col = jnp.tile(jnp.arange(GRID_W), n_rows).astype(F32)
    half = HEAD_DIM // 2
    inv = 1.0 / (ROPE_THETA ** (jnp.arange(0, half, 2, dtype=F32) / half))
    ang_r = row[:, None] * inv
    ang_c = col[:, None] * inv
    ang = jnp.concatenate([ang_r, ang_r, ang_c, ang_c], axis=-1)
    return jnp.cos(ang), jnp.sin(ang)


def _rot_half(u):
    u1, u2 = jnp.split(u, 2, axis=-1)
    return jnp.concatenate([-u2, u1], axis=-1)


def apply_axial_rope(x, cos, sin):
    xf = x.astype(F32)
    xr, xc = jnp.split(xf, 2, axis=-1)
    rot = jnp.concatenate([_rot_half(xr), _rot_half(xc)], axis=-1)
    return (xf * cos[:, None, :] + rot * sin[:, None, :]).astype(x.dtype)


def attn_probs(q, k):
    s = jnp.einsum('bqhgd,bkhd->bhgqk', q, k, preferred_element_type=F32) * (HEAD_DIM ** -0.5)
    return jax.nn.softmax(s, axis=-1)


def diff_attention(q, k, v, lam, lambda_init, sub_g):
    b, tq = q.shape[:2]
    p = attn_probs(q.reshape(b, tq, 2 * DIFF_HEADS, 1, HEAD_DIM), k)[:, :, 0]
    p = p.reshape(b, DIFF_HEADS, 2, tq, p.shape[-1])
    w = p[:, :, 0] - lam * p[:, :, 1]
    o = jnp.einsum('bhqk,bkhe->bqhe', w.astype(v.dtype), v)
    o = rms_norm(o, sub_g) * (1.0 - lambda_init)
    return o.reshape(b, tq, DIFF_HEADS * DIFF_V_DIM)


def gqa_attention(q, k, v):
    b, tq = q.shape[:2]
    qg = q.reshape(b, tq, GQA_KV_HEADS, GQA_HEADS // GQA_KV_HEADS, HEAD_DIM)
    p = attn_probs(qg, k)
    o = jnp.einsum('bhgqk,bkhd->bqhgd', p.astype(v.dtype), v)
    return o.reshape(b, tq, GQA_HEADS * HEAD_DIM)


def sweep_query_blocks(q, fn):
    b, t = q.shape[:2]
    nb = t // Q_BLOCK
    qb = q.reshape(b, nb, Q_BLOCK, *q.shape[2:]).swapaxes(0, 1)
    out = lax.map(fn, qb)
    return out.swapaxes(0, 1).reshape(b, t, *out.shape[3:])


def centred_depthwise_conv(x, w, bias):
    t = x.shape[1]
    left = CONV_W // 2
    right = CONV_W - 1 - left
    xp = jnp.pad(x, ((0, 0), (left, right), (0, 0)))
    out = xp[:, 0:t] * w[0]
    for k in range(1, CONV_W):
        out = out + xp[:, k:k + t] * w[k]
    return out + bias


def block_diag_linear(x, w, b):
    xb = x.reshape(*x.shape[:-1], LRU_BLOCKS, LRU_BLOCK_W)
    y = jnp.einsum('btnc,ncd->btnd', xb, w)
    return y.reshape(x.shape) + b


def linear_scan(a, b, h0, reverse):
    def combine(e1, e2):
        a1, b1 = e1
        a2, b2 = e2
        return a1 * a2, a2 * b1 + b2
    a_cum, h = lax.associative_scan(combine, (a, b), axis=1, reverse=reverse)
    return h + a_cum * h0[:, None, :]


def rglru_scan(xc, h0, w_a, b_a, w_x, b_x, lam, reverse):
    r = jax.nn.sigmoid(block_diag_linear(xc, w_a, b_a).astype(F32))
    i = jax.nn.sigmoid(block_diag_linear(xc, w_x, b_x).astype(F32))
    log_a = -LRU_C * r * jax.nn.softplus(-lam.astype(F32))
    a = jnp.exp(log_a)
    mult = jnp.sqrt(-jnp.expm1(2.0 * log_a))
    return linear_scan(a, mult * i * xc.astype(F32), h0, reverse)


def merge_branches(ya, yb, yc, gate_logits, b_gate, w_branch_a, w_branch_b, w_branch_c, w_out):
    g = jax.nn.sigmoid((gate_logits.reshape(*gate_logits.shape[:-1], N_BRANCH, D_MODEL) + b_gate).astype(F32)).astype(ya.dtype)
    m = g[..., 0, :] * (ya @ w_branch_a) + g[..., 1, :] * (yb @ w_branch_b) + g[..., 2, :] * (yc @ w_branch_c)
    return m @ w_out


def stream_projections(u, rope, w_in, q_norm_a, k_norm_a, q_norm_c, k_norm_c):
    b, t, _ = u.shape
    idx = np.cumsum(np.array(SPLITS))[:-1].tolist()
    aq, ak, av, bx, by, cq, ck, cv, gate_logits = jnp.split(u @ w_in, idx, axis=-1)
    aq = rms_norm(aq.reshape(b, t, 2 * DIFF_HEADS, HEAD_DIM), q_norm_a)
    ak = rms_norm(ak.reshape(b, t, 2 * DIFF_HEADS, HEAD_DIM), k_norm_a)
    cq = rms_norm(cq.reshape(b, t, GQA_HEADS, HEAD_DIM), q_norm_c)
    ck = rms_norm(ck.reshape(b, t, GQA_KV_HEADS, HEAD_DIM), k_norm_c)
    if rope is not None:
        cos, sin = rope
        aq = apply_axial_rope(aq, cos, sin)
        ak = apply_axial_rope(ak, cos, sin)
        cq = apply_axial_rope(cq, cos, sin)
        ck = apply_axial_rope(ck, cos, sin)
    av = av.reshape(b, t, DIFF_HEADS, DIFF_V_DIM)
    cv = cv.reshape(b, t, GQA_KV_HEADS, HEAD_DIM)
    return aq, ak, av, bx, by, cq, ck, cv, gate_logits


def mixer_sublayer(u_lat, u_ctx, rope, lambda_init, need_ctx_out, w_in, b_gate, q_norm_a, k_norm_a,
                   diff_lambda, sub_norm_a, q_norm_c, k_norm_c, conv_w, conv_b, lru_w_a, lru_b_a,
                   lru_w_x, lru_b_x, lru_lambda, w_branch_a, w_branch_b, w_branch_c, w_out):
    lam = (jnp.exp(jnp.sum(diff_lambda[0] * diff_lambda[1]).astype(F32))
           - jnp.exp(jnp.sum(diff_lambda[2] * diff_lambda[3]).astype(F32)) + lambda_init)
    aq_x, ak_x, av_x, bx_x, by_x, cq_x, ck_x, cv_x, gl_x = stream_projections(
        u_ctx, None, w_in, q_norm_a, k_norm_a, q_norm_c, k_norm_c)
    aq_l, ak_l, av_l, bx_l, by_l, cq_l, ck_l, cv_l, gl_l = stream_projections(
        u_lat, rope, w_in, q_norm_a, k_norm_a, q_norm_c, k_norm_c)

    xc_x = centred_depthwise_conv(bx_x, conv_w, conv_b)
    xc_l = centred_depthwise_conv(bx_l, conv_w, conv_b)
    zeros = jnp.zeros((u_ctx.shape[0], LRU_WIDTH), F32)
    hf_x = rglru_scan(xc_x, zeros, lru_w_a[0], lru_b_a[0], lru_w_x[0], lru_b_x[0], lru_lambda[0], False)
    hb_x = rglru_scan(xc_x, zeros, lru_w_a[1], lru_b_a[1], lru_w_x[1], lru_b_x[1], lru_lambda[1], True)
    hf_l = rglru_scan(xc_l, hf_x[:, -1], lru_w_a[0], lru_b_a[0], lru_w_x[0], lru_b_x[0], lru_lambda[0], False)
    hb_l = rglru_scan(xc_l, hb_x[:, 0], lru_w_a[1], lru_b_a[1], lru_w_x[1], lru_b_x[1], lru_lambda[1], True)
    yb_l = (hf_l + hb_l).astype(u_lat.dtype) * jax.nn.gelu(by_l)

    ka = jnp.concatenate([ak_x, ak_l], axis=1)
    va = jnp.concatenate([av_x, av_l], axis=1)
    ya_l = sweep_query_blocks(aq_l, lambda qb: diff_attention(qb, ka, va, lam, lambda_init, sub_norm_a))
    kc = jnp.concatenate([ck_x, ck_l], axis=1)
    vc = jnp.concatenate([cv_x, cv_l], axis=1)
    yc_l = sweep_query_blocks(cq_l, lambda qb: gqa_attention(qb, kc, vc))
    y_lat = merge_branches(ya_l, yb_l, yc_l, gl_l, b_gate, w_branch_a, w_branch_b, w_branch_c, w_out)
    if not need_ctx_out:
        return y_lat, None
    ya_x = diff_attention(aq_x, ak_x, av_x, lam, lambda_init, sub_norm_a)
    yc_x = gqa_attention(cq_x, ck_x, cv_x)
    yb_x = (hf_x + hb_x).astype(u_ctx.dtype) * jax.nn.gelu(by_x)
    y_ctx = merge_branches(ya_x, yb_x, yc_x, gl_x, b_gate, w_branch_a, w_branch_b, w_branch_c, w_out)
    return y_lat, y_ctx


def hierarchical_moe(t, w_group, b_group, w_route, b_route, w1, w3, w2):
    n = t.shape[0]
    gl = (t @ w_group).astype(F32) + b_group
    gp = jax.nn.softmax(gl, axis=-1)
    g_idx = jnp.argmax(gl, axis=-1)
    g_w = jnp.take_along_axis(gp, g_idx[:, None], axis=-1)
    el = ((t @ w_route).astype(F32) + b_route).reshape(n, N_GROUPS, EXPERTS_PER_GROUP)
    el_sel = jnp.take_along_axis(el, g_idx[:, None, None], axis=1)[:, 0]
    top_v, top_i = lax.top_k(el_sel, TOP_K)
    top_p = jax.nn.softmax(top_v, axis=-1) * g_w
    expert_id = g_idx[:, None] * EXPERTS_PER_GROUP + top_i
    combine = jnp.sum(jax.nn.one_hot(expert_id, N_EXPERTS, dtype=F32) * top_p[..., None], axis=1).astype(t.dtype)
    out = jnp.zeros_like(t)
    for e in range(N_EXPERTS):
        h = jax.nn.silu(t @ w1[e]) * (t @ w3[e])
        out = out + combine[:, e:e + 1] * (h @ w2[e])
    return out


def setup_inputs(seed: int = 0) -> dict:
    key = jax.random.key(seed)
    ks = list(jax.random.split(key, 40))

    def nrm(i, shape, scale):
        return jax.random.normal(ks[i], shape, F32) * scale

    L, D = DEPTH, D_MODEL
    u = jax.random.uniform(ks[39], (L, 2, LRU_WIDTH), F32, minval=0.9, maxval=0.999)
    a_base = u ** (1.0 / LRU_C)
    lru_lambda = jnp.log(a_base) - jnp.log1p(-a_base)
    return {
        "x": nrm(0, (BATCH, SEQ, D), 1.0),
        "c": nrm(1, (BATCH, D), 1.0),
        "ctx": nrm(2, (BATCH, CTX_LEN, D), 1.0),
        "c_ctx": nrm(3, (D,), 1.0),
        "w_ada": nrm(4, (L, D, N_MOD * D), 0.5 * D ** -0.5),
        "b_ada": nrm(5, (L, N_MOD * D), 0.01),
        "norm1_g": 1.0 + nrm(6, (L, D), 0.02),
        "norm2_g": 1.0 + nrm(7, (L, D), 0.02),
        "w_in": nrm(8, (L, D, IN_COLS), D ** -0.5),
        "b_gate": nrm(9, (L, N_BRANCH, D), 0.01),
        "q_norm_a": 1.0 + nrm(10, (L, HEAD_DIM), 0.02),
        "k_norm_a": 1.0 + nrm(11, (L, HEAD_DIM), 0.02),
        "diff_lambda": nrm(12, (L, 4, HEAD_DIM), 0.1),
        "sub_norm_a": 1.0 + nrm(13, (L, DIFF_V_DIM), 0.02),
        "q_norm_c": 1.0 + nrm(14, (L, HEAD_DIM), 0.02),
        "k_norm_c": 1.0 + nrm(15, (L, HEAD_DIM), 0.02),
        "conv_w": nrm(16, (L, CONV_W, LRU_WIDTH), CONV_W ** -0.5),
        "conv_b": nrm(17, (L, LRU_WIDTH), 0.01),
        "lru_w_a": nrm(18, (L, 2, LRU_BLOCKS, LRU_BLOCK_W, LRU_BLOCK_W), LRU_BLOCK_W ** -0.5),
        "lru_b_a": nrm(19, (L, 2, LRU_WIDTH), 0.01),
        "lru_w_x": nrm(20, (L, 2, LRU_BLOCKS, LRU_BLOCK_W, LRU_BLOCK_W), LRU_BLOCK_W ** -0.5),
        "lru_b_x": nrm(21, (L, 2, LRU_WIDTH), 0.01),
        "lru_lambda": lru_lambda,
        "w_branch_a": nrm(22, (L, BRANCH_W, D), BRANCH_W ** -0.5),
        "w_branch_b": nrm(23, (L, BRANCH_W, D), BRANCH_W ** -0.5),
        "w_branch_c": nrm(24, (L, BRANCH_W, D), BRANCH_W ** -0.5),
        "w_out": nrm(25, (L, D, D), D ** -0.5),
        "w_group": nrm(26, (L, D, N_GROUPS), D ** -0.5),
        "b_group": nrm(27, (L, N_GROUPS), 0.01),
        "w_route": nrm(28, (L, D, N_EXPERTS), D ** -0.5),
        "b_route": nrm(29, (L, N_EXPERTS), 0.01),
        "w1": nrm(30, (L, N_EXPERTS, D, D_EXPERT), D ** -0.5),
        "w3": nrm(31, (L, N_EXPERTS, D, D_EXPERT), D ** -0.5),
        "w2": nrm(32, (L, N_EXPERTS, D_EXPERT, D), D_EXPERT ** -0.5),
    }


def reference(x, c, ctx, c_ctx, w_ada, b_ada, norm1_g, norm2_g, w_in, b_gate, q_norm_a, k_norm_a,
              diff_lambda, sub_norm_a, q_norm_c, k_norm_c, conv_w, conv_b, lru_w_a, lru_b_a,
              lru_w_x, lru_b_x, lru_lambda, w_branch_a, w_branch_b, w_branch_c, w_out,
              w_group, b_group, w_route, b_route, w1, w3, w2):
    b, t, d = x.shape
    rope = axial_rope_tables(t)
    silu_c = jax.nn.silu(c)
    silu_cc = jax.nn.silu(c_ctx)
    h_lat, h_ctx = x, ctx
    for l in range(DEPTH):
        last = l == DEPTH - 1
        lambda_init = 0.8 - 0.6 * math.exp(-0.3 * l)
        mod_l = (silu_c @ w_ada[l] + b_ada[l]).reshape(b, N_MOD, 1, d)
        mod_x = (silu_cc @ w_ada[l] + b_ada[l]).reshape(N_MOD, d)
        u_lat = modulate(rms_norm(h_lat, norm1_g[l]), mod_l[:, 0], mod_l[:, 1])
        u_ctx = modulate(rms_norm(h_ctx, norm1_g[l]), mod_x[0], mod_x[1])
        y_lat, y_ctx = mixer_sublayer(
            u_lat, u_ctx, rope, lambda_init, not last, w_in[l], b_gate[l], q_norm_a[l], k_norm_a[l],
            diff_lambda[l], sub_norm_a[l], q_norm_c[l], k_norm_c[l], conv_w[l], conv_b[l],
            lru_w_a[l], lru_b_a[l], lru_w_x[l], lru_b_x[l], lru_lambda[l],
            w_branch_a[l], w_branch_b[l], w_branch_c[l], w_out[l])
        h_lat = h_lat + mod_l[:, 2] * y_lat
        v_lat = modulate(rms_norm(h_lat, norm2_g[l]), mod_l[:, 3], mod_l[:, 4])
        if last:
            out = hierarchical_moe(v_lat.reshape(-1, d), w_group[l], b_group[l], w_route[l], b_route[l],
                                   w1[l], w3[l], w2[l])
            h_lat = h_lat + mod_l[:, 5] * out.reshape(b, t, d)
        else:
            h_ctx = h_ctx + mod_x[2] * y_ctx
            v_ctx = modulate(rms_norm(h_ctx, norm2_g[l]), mod_x[3], mod_x[4])
            n_lat = b * t
            tokens = jnp.concatenate([v_lat.reshape(-1, d), v_ctx.reshape(-1, d)], axis=0)
            out = hierarchical_moe(tokens, w_group[l], b_group[l], w_route[l], b_route[l],
                                   w1[l], w3[l], w2[l])
            h_lat = h_lat + mod_l[:, 5] * out[:n_lat].reshape(b, t, d)
            h_ctx = h_ctx + mod_x[5] * out[n_lat:].reshape(h_ctx.shape)
    return h_lat
```

```cpp
#include <hip/hip_runtime.h>
#include <cstdio>
#include <cstdint>

#define GAS __attribute__((address_space(1)))
#define LAS __attribute__((address_space(3)))
typedef unsigned short bf16;
typedef unsigned v4u __attribute__((ext_vector_type(4)));
typedef unsigned v2u __attribute__((ext_vector_type(2)));
typedef float f32x4 __attribute__((ext_vector_type(4)));
typedef float f32x2 __attribute__((ext_vector_type(2)));
typedef short bf16x8 __attribute__((ext_vector_type(8)));
#define LDS_WAIT() asm volatile("s_waitcnt lgkmcnt(0)" ::: "memory")
#define VM_WAIT() asm volatile("s_waitcnt vmcnt(0)" ::: "memory")

constexpr int D = 2048, NB = 8, SEQ = 2048, CTXL = 256, TB = SEQ + CTXL, ROWS = NB * TB;
constexpr int INC = 12800;
constexpr int C_AQ = 0, C_AK = 1024, C_AV = 2048, C_BX = 3072, C_BY = 4096, C_CQ = 5120, C_CK = 6144, C_CV = 6400, C_G = 6656;
constexpr int NE = 32, DE = 512, NMOD = 6;
constexpr int MS = 45056;
constexpr int NCH = TB / 32;
constexpr float EPS = 1e-6f;

constexpr size_t MiB = 1u << 20;
constexpr size_t WS_CTL = 0, CTL_ZERO_BYTES = 1 * MiB;
constexpr size_t WS_MOD = 1 * MiB;
constexpr size_t WS_ROPE = 2 * MiB;
constexpr size_t WS_MISC = 3 * MiB;
constexpr size_t WS_LRUW = 4 * MiB;
constexpr size_t WS_ROUTE = 6 * MiB;
constexpr size_t WS_CARRY = 8 * MiB;
constexpr size_t WS_WIN = 24 * MiB;
constexpr size_t WS_WBR = 74 * MiB;
constexpr size_t WS_WOUT = 86 * MiB;
constexpr size_t WS_W13 = 94 * MiB;
constexpr size_t WS_W2 = 222 * MiB;
constexpr size_t WS_HC = 286 * MiB;
constexpr size_t WS_ACT = 302 * MiB;
constexpr size_t WS_PROJ = 374 * MiB;
constexpr size_t WS_BIG = 824 * MiB;
constexpr size_t WS_OA = 1000 * MiB;
constexpr size_t WS_YB = 1072 * MiB;
constexpr size_t WS_YC = 1108 * MiB;
constexpr size_t WS_END = 1144 * MiB;
constexpr int CW_BAR = 4096;
constexpr int CW_CNT = 8192;
constexpr size_t MISC_LAM = 0;
constexpr size_t MISC_TILE = 1024;
constexpr size_t MISC_WR = 4096;
constexpr size_t RT_E = 0, RT_POS = 256 * 1024, RT_P = 512 * 1024, RT_DEST = 768 * 1024;
constexpr size_t CARRY_N = (size_t)2 * NB * NCH * 1024;
constexpr int LDS_BYTES = 147456;
constexpr int LDS_MISC_OFF = 135168;

__device__ __forceinline__ float bf2f(unsigned short b) { return __uint_as_float(((unsigned)b) << 16); }
__device__ __forceinline__ float bflo(unsigned u) { return __uint_as_float(u << 16); }
__device__ __forceinline__ float bfhi(unsigned u) { return __uint_as_float(u & 0xffff0000u); }
__device__ __forceinline__ unsigned cvt_pk(float lo, float hi) { unsigned r; asm volatile("v_cvt_pk_bf16_f32 %0, %1, %2" : "=v"(r) : "v"(lo), "v"(hi)); return r; }
__device__ __forceinline__ float wave_sum(float v) {
#pragma unroll
    for (int o = 1; o < 64; o <<= 1) v += __shfl_xor(v, o);
    return v;
}
__device__ __forceinline__ float sigmoidf_(float x) { return 1.0f / (1.0f + __expf(-x)); }

namespace pg8 {
constexpr int BM = 256, BK = 64, HALF = 128, HTB = HALF * BK * 2, STAGE_BYTES = 8 * HTB, NXCD = 8, WGM = 8;
__host__ __device__ __forceinline__ int lds_byte(int r, int c) { const int st = (r >> 4) * 2 + (c >> 5), rr = r & 15, cc = c & 31, ob = rr * 64 + cc * 2; return st * 1024 + (ob ^ (((ob >> 9) & 1) << 5)); }
__host__ __device__ __forceinline__ void stage_rc(int b, int& R, int& C) { const int st = b / 1024, sb = b % 1024, swz = sb ^ (((sb >> 9) & 1) << 5); R = (st >> 1) * 16 + swz / 64; C = (st & 1) * 32 + (swz % 64) / 2; }
__host__ __device__ __forceinline__ int perm32(int rho) { const int n = rho >> 4, i = rho & 15; return 8 * (i >> 2) + 4 * n + (i & 3); }
struct Unit { int pm, pn; };
struct Gemm { const bf16* A; const bf16* Bt; int lda, ldb, K; };
struct StaticOrder {
    int nM, nN, nwg, G, c;
    __device__ void init(int M, int N, int G_, int c_) { nM = M / BM; nN = N / BM; nwg = nM * nN; G = G_; c = c_; }
    __device__ bool next(int i, Unit& u) const {
        const long L = (long)i * G + c; if (L >= nwg) return false;
        int wgid = (int)L; { const int q = nwg / NXCD, r = nwg % NXCD, xcd = wgid % NXCD, off = wgid / NXCD; wgid = (xcd < r ? xcd * (q + 1) : r * (q + 1) + (xcd - r) * q) + off; }
        const int nig = WGM * nN, gid = wgid / nig, fm = gid * WGM, gsz = (nM - fm) < WGM ? (nM - fm) : WGM;
        u.pm = fm + ((wgid % nig) % gsz); u.pn = (wgid % nig) / gsz; return true;
    }
};
struct MoeOrder {
    const int* tile_e; int ntiles, NT, G, c;
    __device__ bool next(int i, Unit& u) const {
        const long L = (long)i * G + c; if (L >= (long)ntiles * NT) return false;
        const int mt = (int)(L / NT), pnl = (int)(L % NT);
        u.pm = mt; u.pn = tile_e[mt] * NT + pnl; return true;
    }
};
struct EpiBf16 {
    static constexpr bool PERM = true;
    bf16* O; int ldc; int pn_mask;
    __device__ __forceinline__ void operator()(const f32x4 (&acc)[2][2][4][2], const Unit& u, int wr, int wc, int fr, int fq) const {
        const int row0 = u.pm * BM + wr * 64 + fr; const int col0 = (u.pn & pn_mask) * BM + wc * 32 + 8 * fq;
#pragma unroll
        for (int ai = 0; ai < 2; ++ai)
#pragma unroll
            for (int m = 0; m < 4; ++m) { bf16* rowp = O + (size_t)(row0 + ai * HALF + m * 16) * ldc + col0;
#pragma unroll
                for (int bj = 0; bj < 2; ++bj) { const f32x4 v0 = acc[ai][bj][m][0], v1 = acc[ai][bj][m][1];
                    v4u w; w.x = cvt_pk(v0[0], v0[1]); w.y = cvt_pk(v0[2], v0[3]); w.z = cvt_pk(v1[0], v1[1]); w.w = cvt_pk(v1[2], v1[3]);
                    *(v4u*)(rowp + bj * HALF) = w; } }
    }
};
template <int S> struct EpiBranch {
    static constexpr bool PERM = false;
    float* Mf; bf16* Mb; const bf16* proj; const float* bgate; int gcol0;
    __device__ __forceinline__ void operator()(const f32x4 (&acc)[2][2][4][2], const Unit& u, int wr, int wc, int fr, int fq) const {
        const int row0 = u.pm * BM + wr * 64 + fr, col0 = u.pn * BM + wc * 32 + 4 * fq;
#pragma unroll
        for (int ai = 0; ai < 2; ++ai)
#pragma unroll
            for (int m = 0; m < 4; ++m) { const size_t row = (size_t)(row0 + ai * HALF + m * 16);
#pragma unroll
                for (int bj = 0; bj < 2; ++bj)
#pragma unroll
                    for (int n = 0; n < 2; ++n) { const int col = col0 + bj * HALF + n * 16;
                        const v2u gr = *(const v2u*)(proj + row * INC + gcol0 + col); const f32x4 bg = *(const f32x4*)(bgate + col);
                        f32x4 g; g[0] = sigmoidf_(bflo(gr.x) + bg[0]); g[1] = sigmoidf_(bfhi(gr.x) + bg[1]); g[2] = sigmoidf_(bflo(gr.y) + bg[2]); g[3] = sigmoidf_(bfhi(gr.y) + bg[3]);
                        f32x4 v = g * acc[ai][bj][m][n];
                        float* mp = Mf + row * D + col;
                        if (S == 0) *(f32x4*)mp = v;
                        else if (S == 1) *(f32x4*)mp = *(const f32x4*)mp + v;
                        else { v = *(const f32x4*)mp + v; v2u w; w.x = cvt_pk(v[0], v[1]); w.y = cvt_pk(v[2], v[3]); *(v2u*)(Mb + row * D + col) = w; } }
                asm volatile("" ::: "memory"); }
    }
};
struct EpiWout {
    static constexpr bool PERM = false;
    const float* base_lat; const float* base_ctx; float* out_lat; float* out_ctx; const float* modl;
    __device__ __forceinline__ void operator()(const f32x4 (&acc)[2][2][4][2], const Unit& u, int wr, int wc, int fr, int fq) const {
        const int b = u.pm / 9, j = u.pm % 9; const bool ctx = (j == 0);
        const size_t r0 = ctx ? (size_t)b * CTXL : (size_t)b * SEQ + (size_t)(j - 1) * 256;
        const float* bp = (ctx ? base_ctx : base_lat) + r0 * D; float* op = (ctx ? out_ctx : out_lat) + r0 * D;
        const float* mg = modl + (size_t)(ctx ? 8 : b) * (NMOD * D) + 2 * D;
        const int rl0 = wr * 64 + fr, col0 = u.pn * BM + wc * 32 + 4 * fq;
#pragma unroll
        for (int ai = 0; ai < 2; ++ai)
#pragma unroll
            for (int m = 0; m < 4; ++m) { const size_t ro = (size_t)(rl0 + ai * HALF + m * 16) * D;
#pragma unroll
                for (int bj = 0; bj < 2; ++bj)
#pragma unroll
                    for (int n = 0; n < 2; ++n) { const int col = col0 + bj * HALF + n * 16;
                        const f32x4 g = *(const f32x4*)(mg + col); const f32x4 bs = *(const f32x4*)(bp + ro + col);
                        *(f32x4*)(op + ro + col) = bs + g * acc[ai][bj][m][n]; }
                asm volatile("" ::: "memory"); }
    }
};
struct EpiUp {
    static constexpr bool PERM = true;
    bf16* HB;
    __device__ __forceinline__ void operator()(const f32x4 (&acc)[2][2][4][2], const Unit& u, int wr, int wc, int fr, int fq) const {
        const int row0 = u.pm * BM + wr * 64 + fr; const int col0 = (u.pn & 3) * HALF + wc * 32 + 8 * fq;
#pragma unroll
        for (int ai = 0; ai < 2; ++ai)
#pragma unroll
            for (int m = 0; m < 4; ++m) { bf16* rowp = HB + (size_t)(row0 + ai * HALF + m * 16) * DE + col0;
                f32x4 h0, h1;
#pragma unroll
                for (int e = 0; e < 4; ++e) { const float a0 = acc[ai][0][m][0][e], a1 = acc[ai][0][m][1][e];
                    h0[e] = a0 * sigmoidf_(a0) * acc[ai][1][m][0][e]; h1[e] = a1 * sigmoidf_(a1) * acc[ai][1][m][1][e]; }
                v4u w; w.x = cvt_pk(h0[0], h0[1]); w.y = cvt_pk(h0[2], h0[3]); w.z = cvt_pk(h1[0], h1[1]); w.w = cvt_pk(h1[2], h1[3]);
                *(v4u*)rowp = w; }
    }
};

template <class Epi, class Sched>
__device__ __forceinline__ void gemm_phase(LAS unsigned char* lds, const Gemm g, const Sched& S, const Epi& E) {
    constexpr bool ALIGN_EPI = true;
    int tid_ = threadIdx.x; asm volatile("" : "+v"(tid_));
    const int tid = tid_, wid = __builtin_amdgcn_readfirstlane(tid >> 6), lane = tid & 63, wr = wid >> 2, wc = wid & 3, fr = lane & 15, fq = lane >> 4;
    const int K = g.K, nt = K / BK;
    unsigned voffA[2], voffB[2];
#pragma unroll
    for (int i = 0; i < 2; ++i) { int R, C; stage_rc(tid * 16 + i * 8192, R, C); const int Rb = Epi::PERM ? ((R & ~31) + perm32(R & 31)) : R;
        voffA[i] = (unsigned)(R * g.lda + C) * 2u; voffB[i] = (unsigned)(Rb * g.ldb + C) * 2u; }
    const size_t kstep = (size_t)(BK * 2);
    const size_t hstepA = (size_t)HALF * g.lda * 2, hstepB = (size_t)HALF * g.ldb * 2;
    const size_t tstepA = 2 * hstepA, tstepB = 2 * hstepB;
    const unsigned ldsw = (unsigned)wid * 1024u;
    const int aoff = lds_byte(wr * 64 + fr, fq * 8), boff = lds_byte(wc * 32 + fr, fq * 8);
#define PG8_SA(b, h) (((b) * 2 + (h)) * HTB)
#define PG8_SB(b, h) ((4 + (b) * 2 + (h)) * HTB)
#define PG8_STAGE(bufoff, gbase, voff) do { _Pragma("unroll") for (int _i = 0; _i < 2; ++_i) \
        __builtin_amdgcn_global_load_lds((const unsigned*)((const char*)(gbase) + (voff)[_i]), (LAS unsigned*)(lds + (bufoff) + ldsw + _i * 8192), 16, 0, 0); } while (0)
#define PG8_LDA(dst, b, h) do { _Pragma("unroll") for (int m = 0; m < 4; ++m) _Pragma("unroll") for (int k = 0; k < 2; ++k) dst[m][k] = *(const LAS bf16x8*)(lds + PG8_SA(b, h) + aoff + m * 2048 + k * 1024); } while (0)
#define PG8_LDB(dst, b, h) do { _Pragma("unroll") for (int n = 0; n < 2; ++n) _Pragma("unroll") for (int k = 0; k < 2; ++k) dst[n][k] = *(const LAS bf16x8*)(lds + PG8_SB(b, h) + boff + n * 2048 + k * 1024); } while (0)
#define PG8_MMA(ai, bj, At, Bt) do { __builtin_amdgcn_s_setprio(1); _Pragma("unroll") for (int m = 0; m < 4; ++m) _Pragma("unroll") for (int n = 0; n < 2; ++n) _Pragma("unroll") for (int k = 0; k < 2; ++k) \
        acc[ai][bj][m][n] = __builtin_amdgcn_mfma_f32_16x16x32_bf16(Bt[n][k], At[m][k], acc[ai][bj][m][n], 0, 0, 0); __builtin_amdgcn_s_setprio(0); } while (0)
#define PG8_WAIT_V(n) asm volatile("s_waitcnt vmcnt(" #n ")" ::: "memory")
#define PG8_WAIT_L(n) asm volatile("s_waitcnt lgkmcnt(" #n ")" ::: "memory")
#define PG8_BAR __builtin_amdgcn_s_barrier()
#define PG8_SCHED __builtin_amdgcn_sched_barrier(0)
    Unit cur, nxt; int ui = 0;
    if (!S.next(0, cur)) return;
    f32x4 acc[2][2][4][2];
#pragma unroll
    for (int a = 0; a < 2; ++a)
#pragma unroll
        for (int b = 0; b < 2; ++b)
#pragma unroll
            for (int m = 0; m < 4; ++m)
#pragma unroll
                for (int n = 0; n < 2; ++n) acc[a][b][m][n] = (f32x4){0.f, 0.f, 0.f, 0.f};
    bf16x8 At[4][2], B0[2][2], B1[2][2];
    const char* cA = (const char*)g.A + (size_t)cur.pm * tstepA; const char* cB = (const char*)g.Bt + (size_t)cur.pn * tstepB;
    PG8_STAGE(PG8_SB(0, 0), cB, voffB); PG8_STAGE(PG8_SB(0, 1), cB + hstepB, voffB); PG8_STAGE(PG8_SA(0, 0), cA, voffA); PG8_STAGE(PG8_SA(0, 1), cA + hstepA, voffA);
    if (wr == 1) PG8_BAR;
    PG8_WAIT_V(2); PG8_BAR;
    PG8_STAGE(PG8_SB(1, 0), cB + kstep, voffB); PG8_STAGE(PG8_SA(1, 0), cA + kstep, voffA); PG8_STAGE(PG8_SB(1, 1), cB + hstepB + kstep, voffB);
    PG8_WAIT_V(6); PG8_BAR;
    for (;;) {
        const bool has_next = S.next(ui + 1, nxt);
        const char* nA = has_next ? (const char*)g.A + (size_t)nxt.pm * tstepA : cA; const char* nB = has_next ? (const char*)g.Bt + (size_t)nxt.pn * tstepB : cB;
        for (int t = 0; t < nt; t += 2) {
            const bool last = (t == nt - 2);
            const char* a1 = cA + (size_t)(t + 1) * kstep;
            const char* a2 = last ? nA : cA + (size_t)(t + 2) * kstep; const char* b2 = last ? nB : cB + (size_t)(t + 2) * kstep;
            const char* a3 = a2 + kstep; const char* b3 = b2 + kstep;
            PG8_LDB(B0, 0, 0); PG8_LDB(B1, 0, 1); PG8_SCHED; PG8_LDA(At, 0, 0); PG8_STAGE(PG8_SA(1, 1), a1 + hstepA, voffA);
            PG8_WAIT_V(8); PG8_WAIT_L(0); PG8_BAR; PG8_MMA(0, 0, At, B0); PG8_MMA(0, 1, At, B1); PG8_BAR; PG8_SCHED;
            PG8_LDA(At, 0, 1); PG8_STAGE(PG8_SB(0, 0), b2, voffB); PG8_STAGE(PG8_SB(0, 1), b2 + hstepB, voffB); PG8_STAGE(PG8_SA(0, 0), a2, voffA);
            PG8_WAIT_V(8); PG8_WAIT_L(0); PG8_BAR; PG8_MMA(1, 0, At, B0); PG8_MMA(1, 1, At, B1); PG8_BAR; PG8_SCHED;
            PG8_LDB(B0, 1, 0); PG8_LDB(B1, 1, 1); PG8_SCHED; PG8_LDA(At, 1, 0); PG8_STAGE(PG8_SA(0, 1), a2 + hstepA, voffA);
            PG8_WAIT_V(8); PG8_WAIT_L(0); PG8_BAR; PG8_MMA(0, 0, At, B0); PG8_MMA(0, 1, At, B1); PG8_BAR; PG8_SCHED;
            PG8_LDA(At, 1, 1); PG8_STAGE(PG8_SB(1, 0), b3, voffB); PG8_STAGE(PG8_SB(1, 1), b3 + hstepB, voffB); PG8_STAGE(PG8_SA(1, 0), a3, voffA);
            PG8_WAIT_V(8); PG8_WAIT_L(0); PG8_BAR; PG8_MMA(1, 0, At, B0); PG8_MMA(1, 1, At, B1); PG8_BAR; PG8_SCHED;
        }
        if constexpr (ALIGN_EPI) { if (wr == 0) PG8_BAR; }
        { int fr2 = fr, fq2 = fq; asm volatile("" : "+v"(fr2), "+v"(fq2)); E(acc, cur, wr, wc, fr2, fq2); }
        if (!has_next) break;
#pragma unroll
        for (int a = 0; a < 2; ++a)
#pragma unroll
            for (int b = 0; b < 2; ++b)
#pragma unroll
                for (int m = 0; m < 4; ++m)
#pragma unroll
                    for (int n = 0; n < 2; ++n) acc[a][b][m][n] = (f32x4){0.f, 0.f, 0.f, 0.f};
        cur = nxt; cA = nA; cB = nB; ++ui;
        if constexpr (ALIGN_EPI) { if (wr == 1) PG8_BAR; }
    }
    PG8_WAIT_V(0);
    if constexpr (!ALIGN_EPI) { if (wr == 0) PG8_BAR; }
    PG8_BAR;
#undef PG8_SA
#undef PG8_SB
#undef PG8_STAGE
#undef PG8_LDA
#undef PG8_LDB
#undef PG8_MMA
#undef PG8_WAIT_V
#undef PG8_WAIT_L
#undef PG8_BAR
#undef PG8_SCHED
}
}

namespace att {
constexpr int AD = 128, NW = 8, QBLK = 32, KVBLK = 64;
constexpr float SCALE = 0.088388347648318440f;
constexpr float THR = 8.f;
constexpr int LDQ = INC, LDK = INC;
constexpr size_t SHM_V = KVBLK * AD * 2, SHM_K = KVBLK * AD * 2, SHM_ATTN = 2 * SHM_V + 2 * SHM_K + NW * 64 * 4;
using s16x4 = __attribute__((ext_vector_type(4))) short;
using f32x16 = __attribute__((ext_vector_type(16))) float;
#define KSWZ(row, colB) ((row) * 256 + ((colB) ^ (((row) & 7) << 4)))
#define SBAR() __builtin_amdgcn_sched_barrier(0)
__device__ __forceinline__ int crow(int r, int hi) { return (r & 3) + 8 * (r >> 2) + 4 * hi; }
__device__ __forceinline__ void partialSM(f32x16& p0, f32x16& p1, float& m_reg, float& mn, float& alpha) {
  constexpr float C = SCALE * 1.4426950408889634f;
  float pmax = p0[0]; for (int r = 1; r < 16; ++r) pmax = fmaxf(pmax, p0[r]); for (int r = 0; r < 16; ++r) pmax = fmaxf(pmax, p1[r]);
  { auto rr = __builtin_amdgcn_permlane32_swap(__float_as_uint(pmax), __float_as_uint(pmax), false, false);
    pmax = fmaxf(__uint_as_float(rr[0]), __uint_as_float(rr[1])); }
  if (__builtin_expect(__all(pmax - m_reg <= THR / SCALE), 1)) { mn = m_reg; alpha = 1.f; }
  else { mn = fmaxf(m_reg, pmax); alpha = __builtin_amdgcn_exp2f((m_reg - mn) * C); m_reg = mn; }
  float mnC = -mn * C;
  for (int r = 0; r < 16; ++r) p0[r] = fmaf(p0[r], C, mnC); for (int r = 0; r < 16; ++r) p1[r] = fmaf(p1[r], C, mnC);
  for (int r = 0; r < 16; ++r) p0[r] = __builtin_amdgcn_exp2f(p0[r]);
}
__device__ __forceinline__ void finishSM(f32x16& p0, f32x16& p1, float alpha, float& l_reg, bf16x8& pa0, bf16x8& pa1, bf16x8& pa2, bf16x8& pa3) {
  for (int r = 0; r < 16; ++r) p1[r] = __builtin_amdgcn_exp2f(p1[r]);
  float ps = 0; for (int r = 0; r < 16; ++r) ps += p0[r]; for (int r = 0; r < 16; ++r) ps += p1[r];
  { auto rr = __builtin_amdgcn_permlane32_swap(__float_as_uint(ps), __float_as_uint(ps), false, false);
    ps = __uint_as_float(rr[0]) + __uint_as_float(rr[1]); }
  l_reg = l_reg * alpha + ps;
#define PK4(P, BASE, OUT) do { unsigned a0 = cvt_pk(P[BASE + 0], P[BASE + 1]), a1 = cvt_pk(P[BASE + 2], P[BASE + 3]);   \
    unsigned b0 = cvt_pk(P[BASE + 4], P[BASE + 5]), b1 = cvt_pk(P[BASE + 6], P[BASE + 7]);                              \
    auto r0 = __builtin_amdgcn_permlane32_swap(a0, b0, false, false); auto r1 = __builtin_amdgcn_permlane32_swap(a1, b1, false, false); \
    v4u w = {r0[0], r1[0], r0[1], r1[1]}; OUT = *reinterpret_cast<bf16x8*>(&w); } while (0)
  PK4(p0, 0, pa0); PK4(p0, 8, pa1); PK4(p1, 0, pa2); PK4(p1, 8, pa3);
#undef PK4
}
__device__ __forceinline__ void qkt(f32x16& p0, f32x16& p1, const bf16* Ks, const bf16x8* qr, int r32, int hi) {
  p0 = f32x16{}; p1 = f32x16{};
  for (int d0 = 0; d0 < 8; ++d0) { int cb = (d0 * 16 + hi * 8) * 2;
    bf16x8 b0 = *reinterpret_cast<const bf16x8*>((const char*)Ks + KSWZ(r32, cb));
    bf16x8 b1 = *reinterpret_cast<const bf16x8*>((const char*)Ks + KSWZ(32 + r32, cb));
    p0 = __builtin_amdgcn_mfma_f32_32x32x16_bf16(b0, qr[d0], p0, 0, 0, 0);
    p1 = __builtin_amdgcn_mfma_f32_32x32x16_bf16(b1, qr[d0], p1, 0, 0, 0); }
}
__device__ __forceinline__ int v_st(int k, int c) { const int kk = (k & ~0xC) | ((k & 4) << 1) | ((k & 8) >> 1); return ((kk >> 3) * 4 + (c >> 5)) * 512 + ((kk & 7) * 32 + (c & 31)) * 2; }
__device__ __forceinline__ int v_rd_base(int lane) { return ((lane & 3) << 3) | (((lane >> 2) & 3) << 6) | (((lane >> 4) & 1) << 5) | (((lane >> 5) & 1) << 8); }
constexpr int v_rd_off(int d0, int ks, int half) { return d0 * 512 + ks * 4096 + half * 2048; }
template <int OFF> __device__ __forceinline__ s16x4 tr_read(int vb) {
  s16x4 r; asm volatile("ds_read_b64_tr_b16 %0, %1 offset:%2" : "=&v"(r) : "v"(vb), "i"(OFF) : "memory"); return r;
}
template <int D0> __device__ __forceinline__ void pv_one(f32x16& od, int vb, bf16x8 pa0, bf16x8 pa1, bf16x8 pa2, bf16x8 pa3) {
  const s16x4 l0 = tr_read<v_rd_off(D0, 0, 0)>(vb), h0 = tr_read<v_rd_off(D0, 0, 1)>(vb), l1 = tr_read<v_rd_off(D0, 1, 0)>(vb), h1 = tr_read<v_rd_off(D0, 1, 1)>(vb);
  const s16x4 l2 = tr_read<v_rd_off(D0, 2, 0)>(vb), h2 = tr_read<v_rd_off(D0, 2, 1)>(vb), l3 = tr_read<v_rd_off(D0, 3, 0)>(vb), h3 = tr_read<v_rd_off(D0, 3, 1)>(vb);
  asm volatile("s_waitcnt lgkmcnt(0)" ::: "memory"); SBAR();
#define PK(L, H) (bf16x8){L[0], L[1], L[2], L[3], H[0], H[1], H[2], H[3]}
  od = __builtin_amdgcn_mfma_f32_32x32x16_bf16(pa0, PK(l0, h0), od, 0, 0, 0);
  od = __builtin_amdgcn_mfma_f32_32x32x16_bf16(pa1, PK(l1, h1), od, 0, 0, 0);
  od = __builtin_amdgcn_mfma_f32_32x32x16_bf16(pa2, PK(l2, h2), od, 0, 0, 0);
  od = __builtin_amdgcn_mfma_f32_32x32x16_bf16(pa3, PK(l3, h3), od, 0, 0, 0);
#undef PK
}
__device__ __forceinline__ void pv_d0(f32x16* o, int vb, bf16x8 pa0, bf16x8 pa1, bf16x8 pa2, bf16x8 pa3) {
  pv_one<0>(o[0], vb, pa0, pa1, pa2, pa3); pv_one<1>(o[1], vb, pa0, pa1, pa2, pa3); pv_one<2>(o[2], vb, pa0, pa1, pa2, pa3); pv_one<3>(o[3], vb, pa0, pa1, pa2, pa3);
}
__device__ __forceinline__ void attn_dense_body(const bf16* __restrict__ Qb, const bf16* __restrict__ Kh, const bf16* __restrict__ Vh,
                                                bf16* __restrict__ Ob, int ldo, int seq, char* lds) {
  constexpr int SDEPTH = 2;
  int tid_ = threadIdx.x; asm volatile("" : "+v"(tid_));
  const int tid = tid_, wid = tid >> 6, lane = tid & 63, r32 = lane & 31, hi = lane >> 5;
  bf16* V_lds = (bf16*)lds; bf16* K_lds = (bf16*)(lds + 2 * SHM_V);
  float* ws = (float*)(lds + 2 * SHM_V + 2 * SHM_K) + wid * 64; float* li_l = ws; float* al_l = ws + 32;
  float m_reg = -1e30f, l_reg = 0; f32x16 o[4] = {}; bf16x8 qr[8];
  const bf16* Qw = Qb + (long)(wid * QBLK + r32) * LDQ + hi * 8;
#pragma unroll
  for (int d0 = 0; d0 < 8; ++d0) qr[d0] = *reinterpret_cast<const bf16x8*>(Qw + d0 * 16);
  const int sr = tid >> 4, sc = (tid & 15) * 8, vst0 = v_st(sr, sc), vst1 = v_st(32 + sr, sc);
  const int vb0 = (int)(uintptr_t)V_lds + v_rd_base(lane);
  struct { bf16x8 vs0, vs1, ks0, ks1; } sr_[SDEPTH];
#define SLOAD(i, k0) do { sr_[i].vs0 = *(const bf16x8*)(&Vh[(long)((k0) + sr) * LDK + sc]); sr_[i].vs1 = *(const bf16x8*)(&Vh[(long)((k0) + 32 + sr) * LDK + sc]); \
    sr_[i].ks0 = *(const bf16x8*)(&Kh[(long)((k0) + sr) * LDK + sc]); sr_[i].ks1 = *(const bf16x8*)(&Kh[(long)((k0) + 32 + sr) * LDK + sc]); } while (0)
#define SWRITE(b, i) do { *(bf16x8*)((char*)V_lds + (b) * SHM_V + vst0) = sr_[i].vs0;          \
    *(bf16x8*)((char*)V_lds + (b) * SHM_V + vst1) = sr_[i].vs1; int kc = sc * 2;               \
    *(bf16x8*)((char*)K_lds + (b) * SHM_K + KSWZ(sr, kc)) = sr_[i].ks0;                       \
    *(bf16x8*)((char*)K_lds + (b) * SHM_K + KSWZ(32 + sr, kc)) = sr_[i].ks1; } while (0)
#define SWAIT() asm volatile("s_waitcnt vmcnt(4)" ::: "memory")
#define RESC(a) do { if (__any((a) < 1.f)) { if (hi == 0) al_l[r32] = (a); asm volatile("s_waitcnt lgkmcnt(0)" ::: "memory"); \
    for (int d = 0; d < 4; ++d) for (int r = 0; r < 16; ++r) o[d][r] *= al_l[crow(r, hi)]; } } while (0)
  f32x16 pA0, pA1, pB0, pB1; float mnA, mnB, alA, alB; bf16x8 pa0, pa1, pa2, pa3; const int NT = seq / KVBLK;
  constexpr int SE = 0, SO = SDEPTH - 1;
  SLOAD(SE, 0); asm volatile("s_waitcnt vmcnt(0)" ::: "memory"); SWRITE(0, SE); __syncthreads();
  qkt(pA0, pA1, K_lds, qr, r32, hi); partialSM(pA0, pA1, m_reg, mnA, alA);
  SLOAD(SO, KVBLK); if (2 < NT) SLOAD(SE, 2 * KVBLK);
  SWAIT(); SWRITE(1, SO); __syncthreads();
  for (int j = 1; j + 1 < NT; j += 2) {
    SBAR(); qkt(pB0, pB1, (bf16*)((char*)K_lds + SHM_K), qr, r32, hi);
    finishSM(pA0, pA1, alA, l_reg, pa0, pa1, pa2, pa3); SBAR();
    SLOAD(SO, (j + SDEPTH) * KVBLK); SBAR();
    pv_d0(o, vb0, pa0, pa1, pa2, pa3); partialSM(pB0, pB1, m_reg, mnB, alB);
    __syncthreads(); SWAIT(); SWRITE(0, SE);
    RESC(alB); __syncthreads();
    SBAR(); qkt(pA0, pA1, K_lds, qr, r32, hi);
    finishSM(pB0, pB1, alB, l_reg, pa0, pa1, pa2, pa3); SBAR();
    if (j + 3 < NT) SLOAD(SE, (j + 1 + SDEPTH) * KVBLK); SBAR();
    pv_d0(o, vb0 + (int)SHM_V, pa0, pa1, pa2, pa3); partialSM(pA0, pA1, m_reg, mnA, alA);
    __syncthreads(); SWAIT(); SWRITE(1, SO);
    RESC(alA); __syncthreads();
  }
  SBAR(); qkt(pB0, pB1, (bf16*)((char*)K_lds + SHM_K), qr, r32, hi);
  finishSM(pA0, pA1, alA, l_reg, pa0, pa1, pa2, pa3); SBAR();
  pv_d0(o, vb0, pa0, pa1, pa2, pa3); partialSM(pB0, pB1, m_reg, mnB, alB);
  __syncthreads(); RESC(alB);
  finishSM(pB0, pB1, alB, l_reg, pa0, pa1, pa2, pa3); SBAR();
  pv_d0(o, vb0 + (int)SHM_V, pa0, pa1, pa2, pa3);
  if (hi == 0) li_l[r32] = l_reg; asm volatile("s_waitcnt lgkmcnt(0)" ::: "memory");
  float rli[16];
#pragma unroll
  for (int r = 0; r < 16; ++r) rli[r] = __builtin_amdgcn_rcpf(li_l[crow(r, hi)]);
  bf16* Ow = Ob + (long)(wid * QBLK) * ldo;
#pragma unroll
  for (int r = 0; r < 16; ++r) { int orow = crow(r, hi);
    for (int d0 = 0; d0 < 4; ++d0) Ow[(long)orow * ldo + d0 * 32 + r32] = (bf16)(cvt_pk(o[d0][r] * rli[r], 0.f) & 0xffffu); }
#undef SLOAD
#undef SWRITE
#undef SWAIT
#undef RESC
}
}

#define XB_TMO      128
#define XB_XCNT(j)  (256  + 64 * (j))
#define XB_XSUB(j)  (1280 + 64 * (j))
#define XB_XGEN(j)  (2304 + 64 * (j))
#define XB_TOP      3328
#define XB_TOPGEN   3392
#define XCD_BAR_WORDS 3456
#define XB_SPIN_CAP (1u << 18)
__device__ __forceinline__ unsigned xb_ld(unsigned* p)              { return __hip_atomic_load(p, __ATOMIC_RELAXED, __HIP_MEMORY_SCOPE_AGENT); }
__device__ __forceinline__ unsigned xb_add(unsigned* p, unsigned v) { return __hip_atomic_fetch_add(p, v, __ATOMIC_RELAXED, __HIP_MEMORY_SCOPE_AGENT); }
__device__ __forceinline__ unsigned xb_xcc_id() { return (unsigned)__builtin_amdgcn_s_getreg((3 << 11) | 20) & 0xFu; }
#define XB_SPIN(cond, bar) do { unsigned _sp = 0; while (cond) { __builtin_amdgcn_s_sleep(1); \
    if ((++_sp & 255u) == 0u) { if (xb_ld(&(bar)[XB_TMO])) break; if (_sp > XB_SPIN_CAP) { atomicAdd(&(bar)[XB_TMO], 1u); break; } } } } while (0)
struct XcdBarrier { unsigned* bar; unsigned x; volatile LAS unsigned* st; };
__device__ __forceinline__ XcdBarrier xcd_barrier_post(unsigned* bar, volatile LAS unsigned* st) {
    XcdBarrier b; b.bar = bar; b.x = xb_xcc_id(); b.st = st;
    if (threadIdx.x == 0) (void)xb_add(&bar[XB_XCNT(b.x)], 1u);
    return b;
}
__device__ __forceinline__ void xcd_barrier_complete(unsigned* bar, unsigned x, unsigned& nloc, unsigned& nx) {
    const unsigned G = gridDim.x * gridDim.y * gridDim.z;
    unsigned sum, cnt, mine, sp = 0u;
    for (;;) {
        sum = 0u; cnt = 0u; mine = 0u;
#pragma unroll
        for (unsigned j = 0; j < 16; ++j) { const unsigned c = xb_ld(&bar[XB_XCNT(j)]); sum += c; cnt += (c > 0u) ? 1u : 0u; mine = (j == x) ? c : mine; }
        if (sum == G) break;
        __builtin_amdgcn_s_sleep(1);
        if ((++sp & 255u) == 0u) { if (xb_ld(&bar[XB_TMO])) break; if (sp > XB_SPIN_CAP) { atomicAdd(&bar[XB_TMO], 1u); break; } }
    }
    nloc = mine > 0u ? mine : 1u; nx = cnt > 0u ? cnt : 1u;
}
__device__ __forceinline__ void xcd_barrier(const XcdBarrier& b) {
    asm volatile("s_waitcnt vmcnt(0)" ::: "memory");
    __syncthreads();
    if (threadIdx.x == 0) {
        unsigned* bar = b.bar;
        __builtin_amdgcn_s_waitcnt(0);
        unsigned nloc = b.st[0], nx = b.st[1];
        if (nloc == 0u) { xcd_barrier_complete(bar, b.x, nloc, nx); b.st[0] = nloc; b.st[1] = nx; }
        const unsigned old = xb_add(&bar[XB_XSUB(b.x)], 1u);
        const unsigned gen = old / nloc;
        if (old + 1u == (gen + 1u) * nloc) {
            __builtin_amdgcn_fence(__ATOMIC_RELEASE, "agent");
            asm volatile("s_waitcnt vmcnt(0)" ::: "memory");
            const unsigned og = xb_add(&bar[XB_TOP], 1u);
            const unsigned tg = og / nx;
            if (og + 1u == (tg + 1u) * nx) xb_add(&bar[XB_TOPGEN], 1u);
            else XB_SPIN(xb_ld(&bar[XB_TOPGEN]) == tg, bar);
            __builtin_amdgcn_fence(__ATOMIC_ACQUIRE, "agent");
            xb_add(&bar[XB_XGEN(b.x)], 1u);
            asm volatile("s_waitcnt vmcnt(0)" ::: "memory");
        } else {
            XB_SPIN(xb_ld(&bar[XB_XGEN(b.x)]) == gen, bar);
            __builtin_amdgcn_fence(__ATOMIC_ACQUIRE, "agent");
            asm volatile("s_waitcnt vmcnt(0)" ::: "memory");
        }
    }
    __syncthreads();
}

struct Args { const float* in[34]; float* out; unsigned char* ws; int ph_lo, ph_hi; };
typedef const __attribute__((address_space(4))) Args* KArgs;
template <class T> __device__ __forceinline__ T* as_global(T* p) { return (T*)(GAS T*)p; }
__device__ __forceinline__ KArgs kargs() { KArgs p = (KArgs)__builtin_amdgcn_kernarg_segment_ptr(); asm volatile("" : "+s"(p)); return p; }
__device__ __forceinline__ const float* ain(KArgs a, int i) { return as_global(a->in[i]); }
__device__ __forceinline__ float* aout(KArgs a) { return as_global(a->out); }
struct Frame {
    unsigned char* lds; unsigned char* lds0;
    LAS unsigned char* ldsl;
    unsigned char* ws;
    int tid, lane, wave, G, gw, NGW;
};
enum { I_X = 0, I_C, I_CTX, I_CCTX, I_WADA, I_BADA, I_N1G, I_N2G, I_WIN, I_BGATE, I_QNA, I_KNA, I_DLAM, I_SUBN, I_QNC, I_KNC, I_CONVW, I_CONVB,
       I_LWA, I_LBA, I_LWX, I_LBX, I_LLAM, I_WBA, I_WBB, I_WBC, I_WOUT, I_WGRP, I_BGRP, I_WRT, I_BRT, I_W1, I_W3, I_W2 };

__device__ __forceinline__ void phase_ids(Frame& F) {
    int t = threadIdx.x; asm volatile("" : "+v"(t)); F.tid = t; F.lane = t & 63; F.wave = __builtin_amdgcn_readfirstlane(t >> 6); F.gw = blockIdx.x * 8 + F.wave;
    GAS unsigned char* w = (GAS unsigned char*)kargs()->ws; asm volatile("" : "+s"(w)); F.ws = (unsigned char*)w; F.lds = F.lds0; F.ldsl = (LAS unsigned char*)F.lds0;
}
__device__ __forceinline__ int launder_s(int v) { asm volatile("" : "+s"(v)); return v; }
__device__ __forceinline__ void tr_item(const float* __restrict__ W, int N, bf16* __restrict__ WT, int K, int k0, int n0, int drow0, LAS float* scr, int lane) {
#pragma unroll 8
    for (int i = 0; i < 64; ++i) scr[i * 65 + lane] = W[(size_t)(k0 + i) * N + n0 + lane];
    LDS_WAIT();
    const int c = lane & 7;
#pragma unroll
    for (int j = 0; j < 8; ++j) { const int n = (lane >> 3) + 8 * j; const LAS float* s = scr + (8 * c) * 65 + n;
        v4u o; o.x = cvt_pk(s[0], s[65]); o.y = cvt_pk(s[130], s[195]); o.z = cvt_pk(s[260], s[325]); o.w = cvt_pk(s[390], s[455]);
        *(v4u*)(WT + (size_t)(drow0 + n) * K + k0 + 8 * c) = o; }
    LDS_WAIT();
}
__device__ __forceinline__ void conv_weights(Frame& F, int l) {
    phase_ids(F); l = launder_s(l); KArgs a = kargs();
    LAS float* scr = (LAS float*)(F.ldsl + F.wave * 16640);
    constexpr int I_IN = 32 * 200, I_BR = 16 * 32, I_OUT = 32 * 32, I_W = 32 * 256;
    constexpr int NIT = I_IN + 3 * I_BR + I_OUT + 3 * I_W;
    bf16* WIN = (bf16*)(F.ws + WS_WIN); bf16* WBR = (bf16*)(F.ws + WS_WBR); bf16* WOUT = (bf16*)(F.ws + WS_WOUT); bf16* W13 = (bf16*)(F.ws + WS_W13); bf16* W2 = (bf16*)(F.ws + WS_W2);
    for (int it = F.gw; it < NIT; it += F.NGW) {
        int r = it;
        if (r < I_IN) { const int kb = r / 200, nb = r % 200; tr_item(ain(a, I_WIN) + (size_t)l * D * INC, INC, WIN, D, kb * 64, nb * 64, nb * 64, scr, F.lane); continue; } r -= I_IN;
        if (r < 3 * I_BR) { const int br = r / I_BR, q = r % I_BR, kb = q / 32, nb = q % 32;
            tr_item(ain(a, I_WBA + br) + (size_t)l * 1024 * D, D, WBR + (size_t)br * D * 1024, 1024, kb * 64, nb * 64, nb * 64, scr, F.lane); continue; } r -= 3 * I_BR;
        if (r < I_OUT) { const int kb = r / 32, nb = r % 32; tr_item(ain(a, I_WOUT) + (size_t)l * D * D, D, WOUT, D, kb * 64, nb * 64, nb * 64, scr, F.lane); continue; } r -= I_OUT;
        if (r < 2 * I_W) { const int which = r / I_W, q = r % I_W, e = q / 256, q2 = q % 256, kb = q2 / 8, nb = q2 % 8;
            const int n0 = nb * 64; const int drow = e * 1024 + (n0 / 128) * 256 + (n0 % 128) + which * 128;
            tr_item(ain(a, which ? I_W3 : I_W1) + ((size_t)l * NE + e) * D * DE, DE, W13, D, kb * 64, n0, drow, scr, F.lane); continue; } r -= 2 * I_W;
        { const int e = r / 256, q2 = r % 256, kb = q2 / 32, nb = q2 % 32;
            tr_item(ain(a, I_W2) + ((size_t)l * NE + e) * DE * D, D, W2, DE, kb * 64, nb * 64, e * D + nb * 64, scr, F.lane); }
    }
}

__device__ __forceinline__ void p0_misc(Frame& F) {
    phase_ids(F); KArgs a = kargs();
    LAS float* sl = (LAS float*)F.ldsl;
    LAS float* red = sl + 9 * 2048;
    const float* c = ain(a, I_C); const float* cc = ain(a, I_CCTX);
    float* mod = (float*)(F.ws + WS_MOD);
    if (blockIdx.x < 192 || F.G < 192) {
        for (int idx = F.tid; idx < 9 * 2048; idx += 512) { const int b = idx >> 11, k = idx & 2047; const float v = b < 8 ? c[b * 2048 + k] : cc[k]; sl[idx] = v / (1.0f + expf(-v)); }
        __syncthreads();
        for (int it = blockIdx.x; it < 192; it += F.G) {
            const int l = it / 96, cb = it % 96, col = cb * 128 + 2 * F.lane;
            const float* wp = ain(a, I_WADA) + ((size_t)l * D + F.wave * 256) * (NMOD * D) + col;
            float ax[9], ay[9];
#pragma unroll
            for (int b = 0; b < 9; ++b) { ax[b] = 0.f; ay[b] = 0.f; }
            for (int k = 0; k < 256; k += 8) {
                f32x2 w[8];
#pragma unroll
                for (int u = 0; u < 8; ++u) w[u] = *(const f32x2*)(wp + (size_t)(k + u) * (NMOD * D));
#pragma unroll
                for (int u = 0; u < 8; ++u)
#pragma unroll
                    for (int b = 0; b < 9; ++b) { const float s = sl[b * 2048 + F.wave * 256 + k + u]; ax[b] += s * w[u].x; ay[b] += s * w[u].y; }
            }
#pragma unroll
            for (int b = 0; b < 9; ++b) { red[(F.wave * 9 + b) * 128 + 2 * F.lane] = ax[b]; red[(F.wave * 9 + b) * 128 + 2 * F.lane + 1] = ay[b]; }
            __syncthreads();
            for (int o = F.tid; o < 9 * 128; o += 512) { const int b = o >> 7, ci = o & 127; float s = 0.f;
#pragma unroll
                for (int w = 0; w < 8; ++w) s += red[(w * 9 + b) * 128 + ci];
                mod[((size_t)l * 9 + b) * (NMOD * D) + cb * 128 + ci] = s + ain(a, I_BADA)[(size_t)l * (NMOD * D) + cb * 128 + ci]; }
            __syncthreads();
        }
    }
    { float* rc = (float*)(F.ws + WS_ROPE); float* rs = rc + 2048 * 64;
      for (int idx = blockIdx.x * 512 + F.tid; idx < 2048 * 64; idx += F.G * 512) { const int t = idx >> 6, j = idx & 63, jj = j & 31;
          const float inv = 1.0f / powf(10000.0f, (float)(2 * jj) / 64.0f); const float pos = (float)(j < 32 ? (t >> 6) : (t & 63));
          float s, co; sincosf(pos * inv, &s, &co); rc[idx] = co; rs[idx] = s; } }
    if (blockIdx.x == 0 && F.wave < 2) { const int l = F.wave; const float* dl = ain(a, I_DLAM) + (size_t)l * 4 * 128;
        float s01 = dl[F.lane] * dl[128 + F.lane] + dl[64 + F.lane] * dl[192 + F.lane];
        float s23 = dl[256 + F.lane] * dl[384 + F.lane] + dl[320 + F.lane] * dl[448 + F.lane];
        s01 = wave_sum(s01); s23 = wave_sum(s23);
        const float li = l == 0 ? 0.2f : 0.3555090676f;
        if (F.lane == 0) ((float*)(F.ws + WS_MISC + MISC_LAM))[l] = expf(s01) - expf(s23) + li; }
    { bf16* wr = (bf16*)(F.ws + WS_MISC + MISC_WR);
      for (int idx = blockIdx.x * 512 + F.tid; idx < 2 * 48 * 2048; idx += F.G * 512) { const int l = idx / (48 * 2048), rem = idx % (48 * 2048), e = rem >> 11, k = rem & 2047;
          float w = 0.f; if (e < 4) w = ain(a, I_WGRP)[((size_t)l * D + k) * 4 + e]; else if (e < 36) w = ain(a, I_WRT)[((size_t)l * D + k) * 32 + (e - 4)];
          const unsigned hi = cvt_pk(w, 0.f) & 0xffffu; const float lo = w - bflo(hi);
          wr[((size_t)(l * 2 + 0) * 48 + e) * 2048 + k] = (bf16)hi; wr[((size_t)(l * 2 + 1) * 48 + e) * 2048 + k] = (bf16)(cvt_pk(lo, 0.f) & 0xffffu); } }
    { bf16* lw = (bf16*)(F.ws + WS_LRUW);
      for (int idx = blockIdx.x * 512 + F.tid; idx < 2 * 2 * 2 * 8 * 128 * 128; idx += F.G * 512) {
          const int cidx = idx & 127, d = (idx >> 7) & 127, n = (idx >> 14) & 7, dir = (idx >> 17) & 1, mat = (idx >> 18) & 1, l = idx >> 19;
          const float w = ain(a, mat ? I_LWX : I_LWA)[((((size_t)l * 2 + dir) * 8 + n) * 128 + cidx) * 128 + d];
          lw[idx] = (bf16)(cvt_pk(w, 0.f) & 0xffffu); } }
}

__device__ __forceinline__ void row_split(int r, int& b, int& i) { b = r / TB; i = r - b * TB; }
__device__ __forceinline__ size_t hrow_off(int b, int i, bool& ctx) { ctx = i < CTXL; return ctx ? ((size_t)b * CTXL + i) * D : ((size_t)b * SEQ + (i - CTXL)) * D; }

__device__ __forceinline__ void norm_mod(f32x4 (&v)[8], const float* g, const float* shift, const float* scale, int lane) {
    float ss = 0.f;
#pragma unroll
    for (int j = 0; j < 8; ++j) ss += (v[j][0] * v[j][0] + v[j][1] * v[j][1]) + (v[j][2] * v[j][2] + v[j][3] * v[j][3]);
    ss = wave_sum(ss);
    const float rs = rsqrtf(ss * (1.0f / D) + EPS);
#pragma unroll
    for (int j = 0; j < 8; ++j) { const int c = (lane + 64 * j) * 4; const f32x4 gg = *(const f32x4*)(g + c), sh = *(const f32x4*)(shift + c), sc = *(const f32x4*)(scale + c);
        v[j] = v[j] * rs * gg * (sc + 1.0f) + sh; }
}

__device__ __forceinline__ void pa_norm1(Frame& F, int l) {
    phase_ids(F); l = launder_s(l); KArgs a = kargs();
    const float* hl = l == 0 ? ain(a, I_X) : aout(a); const float* hc = l == 0 ? ain(a, I_CTX) : (const float*)(F.ws + WS_HC);
    const float* mod = (const float*)(F.ws + WS_MOD) + (size_t)l * 9 * (NMOD * D);
    const float* g = ain(a, I_N1G) + (size_t)l * D; bf16* U = (bf16*)(F.ws + WS_ACT);
    for (int r = F.gw; r < ROWS; r += F.NGW) {
        int b, i; row_split(r, b, i); bool ctx; const size_t off = hrow_off(b, i, ctx);
        const f32x4* xr = (const f32x4*)((ctx ? hc : hl) + off) + F.lane;
        f32x4 v[8];
#pragma unroll
        for (int j = 0; j < 8; ++j) v[j] = xr[64 * j];
        const float* mb = mod + (size_t)(ctx ? 8 : b) * (NMOD * D);
        norm_mod(v, g, mb, mb + D, F.lane);
        v2u* o = (v2u*)(U + (size_t)r * D) + F.lane;
#pragma unroll
        for (int j = 0; j < 8; ++j) { v2u w; w.x = cvt_pk(v[j][0], v[j][1]); w.y = cvt_pk(v[j][2], v[j][3]); o[64 * j] = w; }
    }
}

__device__ __forceinline__ void pc_qk(Frame& F, int l) {
    phase_ids(F); l = launder_s(l); KArgs a = kargs();
    bf16* PROJ = (bf16*)(F.ws + WS_PROJ);
    const float* rc = (const float*)(F.ws + WS_ROPE); const float* rs = rc + 2048 * 64;
    const float* qna = ain(a, I_QNA) + l * 128; const float* kna = ain(a, I_KNA) + l * 128; const float* qnc = ain(a, I_QNC) + l * 128; const float* knc = ain(a, I_KNC) + l * 128;
    const int half = F.lane >> 5, li = F.lane & 31;
    for (int r = F.gw; r < ROWS; r += F.NGW) {
        int b, i; row_split(r, b, i); const bool lat = i >= CTXL; const int t = i - CTXL;
        bf16* prow = PROJ + (size_t)r * INC;
        f32x4 cs = {1.f, 1.f, 1.f, 1.f}, sn = {0.f, 0.f, 0.f, 0.f};
        if (lat) { const int ti = t * 64 + (li >> 4) * 32 + 4 * (li & 7); cs = *(const f32x4*)(rc + ti); sn = *(const f32x4*)(rs + ti); }
        const float sgn = (li & 8) ? 1.0f : -1.0f;
        for (int it = 0; it < 13; ++it) {
            const int hidx = 2 * it + half; int colbase; const float* g;
            if (hidx < 8) { colbase = C_AQ + hidx * 128; g = qna; } else if (hidx < 16) { colbase = C_AK + (hidx - 8) * 128; g = kna; }
            else if (hidx < 24) { colbase = C_CQ + (hidx - 16) * 128; g = qnc; } else { colbase = C_CK + (hidx - 24) * 128; g = knc; }
            v2u* p = (v2u*)(prow + colbase + 4 * li); const v2u raw = *p;
            f32x4 x = {bflo(raw.x), bfhi(raw.x), bflo(raw.y), bfhi(raw.y)};
            float ss = (x[0] * x[0] + x[1] * x[1]) + (x[2] * x[2] + x[3] * x[3]);
#pragma unroll
            for (int o = 1; o < 32; o <<= 1) ss += __shfl_xor(ss, o);
            const float rn = rsqrtf(ss * (1.0f / 128.0f) + EPS);
            const f32x4 gg = *(const f32x4*)(g + 4 * li);
            f32x4 y = x * rn * gg;
            f32x4 pr; pr[0] = __shfl_xor(y[0], 8); pr[1] = __shfl_xor(y[1], 8); pr[2] = __shfl_xor(y[2], 8); pr[3] = __shfl_xor(y[3], 8);
            y = y * cs + pr * sn * sgn;
            v2u w; w.x = cvt_pk(y[0], y[1]); w.y = cvt_pk(y[2], y[3]); *p = w;
        }
    }
}

__device__ __forceinline__ void pc_lru(Frame& F, int l) {
    phase_ids(F); l = launder_s(l); KArgs a = kargs();
    const bf16* PROJ = (const bf16*)(F.ws + WS_PROJ);
    LAS bf16* xcb = (LAS bf16*)F.ldsl;
    LAS float* xcf = (LAS float*)(F.ldsl + 8704);
    LAS float* Sa = (LAS float*)(F.ldsl + 25600);
    LAS float* Sb = (LAS float*)(F.ldsl + 58368);
    bf16* hloc = (bf16*)(F.ws + WS_BIG); bf16* acum = hloc + (size_t)2 * ROWS * 1024;
    float* cA = (float*)(F.ws + WS_CARRY); float* cH = cA + CARRY_N;
    const bf16* LW = (const bf16*)(F.ws + WS_LRUW);
    const float* convw = ain(a, I_CONVW) + (size_t)l * 4 * 1024; const float* convb = ain(a, I_CONVB) + (size_t)l * 1024;
    const int dir = F.wave >> 2, cq = F.wave & 3, l15 = F.lane & 15, l4 = F.lane >> 4;
    for (int u = blockIdx.x; u < NB * NCH * 8; u += F.G) {
        const int n = u & 7, bc = u >> 3, c = bc % NCH, b = bc / NCH;
        const int r0 = b * TB + c * 32; const int seq_lo = (c < 8) ? b * TB : b * TB + CTXL, seq_hi = (c < 8) ? b * TB + CTXL : (b + 1) * TB;
        { const int t = F.tid >> 4, ch0 = (F.tid & 15) * 8; const int chg = n * 128 + ch0;
          float acc8[8];
          { const f32x4 b0 = *(const f32x4*)(convb + chg), b1 = *(const f32x4*)(convb + chg + 4);
#pragma unroll
            for (int e = 0; e < 4; ++e) { acc8[e] = b0[e]; acc8[4 + e] = b1[e]; } }
#pragma unroll
          for (int k = 0; k < 4; ++k) { const int rr = r0 + t - 2 + k;
              if (rr >= seq_lo && rr < seq_hi) { const v4u raw = *(const v4u*)(PROJ + (size_t)rr * INC + C_BX + chg);
                  const f32x4 w0 = *(const f32x4*)(convw + k * 1024 + chg), w1 = *(const f32x4*)(convw + k * 1024 + chg + 4);
                  acc8[0] += w0[0] * bflo(raw.x); acc8[1] += w0[1] * bfhi(raw.x); acc8[2] += w0[2] * bflo(raw.y); acc8[3] += w0[3] * bfhi(raw.y);
                  acc8[4] += w1[0] * bflo(raw.z); acc8[5] += w1[1] * bfhi(raw.z); acc8[6] += w1[2] * bflo(raw.w); acc8[7] += w1[3] * bfhi(raw.w); } }
          v4u pk; pk.x = cvt_pk(acc8[0], acc8[1]); pk.y = cvt_pk(acc8[2], acc8[3]); pk.z = cvt_pk(acc8[4], acc8[5]); pk.w = cvt_pk(acc8[6], acc8[7]);
          *(LAS v4u*)(xcb + t * 136 + ch0) = pk;
          *(LAS f32x4*)(xcf + t * 132 + ch0) = (f32x4){acc8[0], acc8[1], acc8[2], acc8[3]}; *(LAS f32x4*)(xcf + t * 132 + ch0 + 4) = (f32x4){acc8[4], acc8[5], acc8[6], acc8[7]}; }
        __syncthreads();
#pragma unroll
        for (int nt = 0; nt < 2; ++nt) {
            const int ch = cq * 32 + nt * 16 + l15, chg = n * 128 + ch;
            bf16x8 Ba[4], Bx[4];
#pragma unroll
            for (int k = 0; k < 4; ++k) {
                Ba[k] = *(const bf16x8*)(LW + ((((size_t)(l * 2 + 0) * 2 + dir) * 8 + n) * 128 + ch) * 128 + k * 32 + l4 * 8);
                Bx[k] = *(const bf16x8*)(LW + ((((size_t)(l * 2 + 1) * 2 + dir) * 8 + n) * 128 + ch) * 128 + k * 32 + l4 * 8); }
            const float ba = ain(a, I_LBA)[((size_t)l * 2 + dir) * 1024 + chg], bx = ain(a, I_LBX)[((size_t)l * 2 + dir) * 1024 + chg];
            const float lamv = ain(a, I_LLAM)[((size_t)l * 2 + dir) * 1024 + chg]; const float sp = log1pf(expf(-lamv));
#pragma unroll
            for (int mt = 0; mt < 2; ++mt) {
                f32x4 ra = {0.f, 0.f, 0.f, 0.f}, rx = {0.f, 0.f, 0.f, 0.f};
#pragma unroll
                for (int k = 0; k < 4; ++k) { const bf16x8 A = *(const LAS bf16x8*)(xcb + (mt * 16 + l15) * 136 + k * 32 + l4 * 8);
                    ra = __builtin_amdgcn_mfma_f32_16x16x32_bf16(A, Ba[k], ra, 0, 0, 0); rx = __builtin_amdgcn_mfma_f32_16x16x32_bf16(A, Bx[k], rx, 0, 0, 0); }
#pragma unroll
                for (int j = 0; j < 4; ++j) { const int tt = mt * 16 + l4 * 4 + j;
                    const float rg = 1.0f / (1.0f + expf(-(ra[j] + ba))), ig = 1.0f / (1.0f + expf(-(rx[j] + bx)));
                    const float la = -8.0f * rg * sp; const float av = expf(la); const float mult = sqrtf(-expm1f(2.0f * la));
                    Sa[(dir * 32 + tt) * 128 + ch] = av; Sb[(dir * 32 + tt) * 128 + ch] = mult * ig * xcf[tt * 132 + ch]; }
            }
        }
        __syncthreads();
        if (F.tid < 256) { const int d2 = F.tid >> 7, ch = F.tid & 127; float h = 0.f, A = 1.f;
            bf16* hp = hloc + ((size_t)d2 * ROWS + r0) * 1024 + n * 128 + ch; bf16* ap = acum + ((size_t)d2 * ROWS + r0) * 1024 + n * 128 + ch;
            for (int s = 0; s < 32; ++s) { const int t = d2 ? 31 - s : s; const float av = Sa[(d2 * 32 + t) * 128 + ch], bv = Sb[(d2 * 32 + t) * 128 + ch];
                h = av * h + bv; A *= av; hp[(size_t)t * 1024] = (bf16)(cvt_pk(h, 0.f) & 0xffffu); ap[(size_t)t * 1024] = (bf16)(cvt_pk(A, 0.f) & 0xffffu); }
            const size_t ci = (((size_t)d2 * NB + b) * NCH + c) * 1024 + n * 128 + ch; cA[ci] = A; cH[ci] = h; }
        __syncthreads();
    }
}

__device__ __forceinline__ void pd_chain(Frame& F) {
    phase_ids(F);
    const float* cA = (const float*)(F.ws + WS_CARRY); const float* cH = cA + CARRY_N; float* Hin = (float*)(F.ws + WS_CARRY) + 2 * CARRY_N;
    for (int blk = blockIdx.x; blk < 32; blk += F.G) {
        const int idx = blk * 512 + F.tid, dir = idx >> 13, b = (idx >> 10) & 7, ch = idx & 1023;
        const size_t base = (((size_t)dir * NB + b) * NCH) * 1024 + ch; float H = 0.f;
        if (dir == 0) { for (int c = 0; c < NCH; ++c) { Hin[base + (size_t)c * 1024] = H; H = cA[base + (size_t)c * 1024] * H + cH[base + (size_t)c * 1024]; } }
        else { for (int c = 7; c >= 0; --c) { Hin[base + (size_t)c * 1024] = H; H = cA[base + (size_t)c * 1024] * H + cH[base + (size_t)c * 1024]; }
               for (int c = NCH - 1; c >= 8; --c) { Hin[base + (size_t)c * 1024] = H; H = cA[base + (size_t)c * 1024] * H + cH[base + (size_t)c * 1024]; } }
    }
}
__device__ __forceinline__ void pd_attn(Frame& F) {
    phase_ids(F);
    const bf16* PROJ = (const bf16*)(F.ws + WS_PROJ); bf16* OA = (bf16*)(F.ws + WS_OA); bf16* YC = (bf16*)(F.ws + WS_YC);
    constexpr int NLAT = NB * 8 * 24, NCTX = NB * 24;
    for (int u = blockIdx.x; u < NLAT + NCTX; u += F.G) {
        int hh, b, q0row, seq;
        if (u < NLAT) { const int qb = u & 7; hh = (u >> 3) % 24; b = u / 192; q0row = b * TB + CTXL + qb * 256; seq = TB; }
        else { const int v = u - NLAT; hh = v % 24; b = v / 24; q0row = b * TB; seq = CTXL; }
        const bf16* kb = PROJ + (size_t)b * TB * INC; const bf16* qp = PROJ + (size_t)q0row * INC;
        const bf16 *Q, *K, *V; bf16* O; int ldo;
        if (hh < 16) { const int m = hh >> 1, vh = hh & 1; Q = qp + C_AQ + m * 128; K = kb + C_AK + m * 128; V = kb + C_AV + (m >> 1) * 256 + vh * 128; O = OA + (size_t)q0row * D + m * 256 + vh * 128; ldo = D; }
        else { const int hq = hh - 16; Q = qp + C_CQ + hq * 128; K = kb + C_CK + (hq >> 2) * 128; V = kb + C_CV + (hq >> 2) * 128; O = YC + (size_t)q0row * 1024 + hq * 128; ldo = 1024; }
        att::attn_dense_body(Q, K, V, O, ldo, seq, (char*)F.lds);
        __syncthreads();
    }
}

__device__ __forceinline__ void pe_combine(Frame& F, int l) {
    phase_ids(F); l = launder_s(l); KArgs a = kargs();
    bf16* OA = (bf16*)(F.ws + WS_OA); bf16* YB = (bf16*)(F.ws + WS_YB); const bf16* PROJ = (const bf16*)(F.ws + WS_PROJ);
    const bf16* hloc = (const bf16*)(F.ws + WS_BIG); const bf16* acum = hloc + (size_t)2 * ROWS * 1024;
    const float* Hin = (const float*)(F.ws + WS_CARRY) + 2 * CARRY_N;
    const float lam = ((const float*)(F.ws + WS_MISC + MISC_LAM))[l]; const float omli = 1.0f - (l == 0 ? 0.2f : 0.3555090676f);
    const f32x4 sg = *(const f32x4*)(ain(a, I_SUBN) + (size_t)l * 256 + 4 * F.lane);
    for (int r = F.gw; r < ROWS; r += F.NGW) {
        bf16* oa = OA + (size_t)r * D;
        v2u raw[8];
#pragma unroll
        for (int m = 0; m < 8; ++m) raw[m] = *(const v2u*)(oa + m * 256 + 4 * F.lane);
#pragma unroll
        for (int h = 0; h < 4; ++h) { const v2u p = raw[2 * h], q = raw[2 * h + 1];
            f32x4 o = {bflo(p.x) - lam * bflo(q.x), bfhi(p.x) - lam * bfhi(q.x), bflo(p.y) - lam * bflo(q.y), bfhi(p.y) - lam * bfhi(q.y)};
            float ss = (o[0] * o[0] + o[1] * o[1]) + (o[2] * o[2] + o[3] * o[3]); ss = wave_sum(ss);
            const float rn = rsqrtf(ss * (1.0f / 256.0f) + EPS) * omli;
            o = o * rn * sg; v2u w; w.x = cvt_pk(o[0], o[1]); w.y = cvt_pk(o[2], o[3]); *(v2u*)(oa + h * 256 + 4 * F.lane) = w; }
        int b, i; row_split(r, b, i); const int c = i >> 5;
        const size_t hf = ((size_t)(0 * NB + b) * NCH + c) * 1024, hb = ((size_t)(1 * NB + b) * NCH + c) * 1024;
#pragma unroll
        for (int hv = 0; hv < 2; ++hv) { const int ch = F.lane * 16 + hv * 8;
            const v4u lf = *(const v4u*)(hloc + (size_t)r * 1024 + ch), af = *(const v4u*)(acum + (size_t)r * 1024 + ch);
            const v4u lb = *(const v4u*)(hloc + ((size_t)ROWS + r) * 1024 + ch), ab = *(const v4u*)(acum + ((size_t)ROWS + r) * 1024 + ch);
            const v4u by = *(const v4u*)(PROJ + (size_t)r * INC + C_BY + ch);
            const f32x4 Hf0 = *(const f32x4*)(Hin + hf + ch), Hf1 = *(const f32x4*)(Hin + hf + ch + 4), Hb0 = *(const f32x4*)(Hin + hb + ch), Hb1 = *(const f32x4*)(Hin + hb + ch + 4);
            float y[8];
#define FIX(e, LF, AF, LB, AB, BY, HF, HB, GET) { const float hsum = GET(LF) + GET(AF) * HF + GET(LB) + GET(AB) * HB; const float x = GET(BY); \
                const float u2 = 0.7978845608f * (x + 0.044715f * x * x * x); const float th = 1.0f - 2.0f / (1.0f + __expf(2.0f * u2)); y[e] = hsum * 0.5f * x * (1.0f + th); }
            FIX(0, lf.x, af.x, lb.x, ab.x, by.x, Hf0[0], Hb0[0], bflo) FIX(1, lf.x, af.x, lb.x, ab.x, by.x, Hf0[1], Hb0[1], bfhi)
            FIX(2, lf.y, af.y, lb.y, ab.y, by.y, Hf0[2], Hb0[2], bflo) FIX(3, lf.y, af.y, lb.y, ab.y, by.y, Hf0[3], Hb0[3], bfhi)
            FIX(4, lf.z, af.z, lb.z, ab.z, by.z, Hf1[0], Hb1[0], bflo) FIX(5, lf.z, af.z, lb.z, ab.z, by.z, Hf1[1], Hb1[1], bfhi)
            FIX(6, lf.w, af.w, lb.w, ab.w, by.w, Hf1[2], Hb1[2], bflo) FIX(7, lf.w, af.w, lb.w, ab.w, by.w, Hf1[3], Hb1[3], bfhi)
#undef FIX
            v4u w; w.x = cvt_pk(y[0], y[1]); w.y = cvt_pk(y[2], y[3]); w.z = cvt_pk(y[4], y[5]); w.w = cvt_pk(y[6], y[7]);
            *(v4u*)(YB + (size_t)r * 1024 + ch) = w; }
    }
}

__device__ __forceinline__ void ph_norm2_route(Frame& F, int l) {
    phase_ids(F); l = launder_s(l); KArgs a = kargs();
    const float* hl = aout(a); const float* hc = (const float*)(F.ws + WS_HC);
    const float* mod = (const float*)(F.ws + WS_MOD) + (size_t)l * 9 * (NMOD * D);
    const float* g = ain(a, I_N2G) + (size_t)l * D; bf16* V = (bf16*)(F.ws + WS_ACT);
    LAS bf16* Thi = (LAS bf16*)F.ldsl; LAS bf16* Tlo = (LAS bf16*)(F.ldsl + 65792);
    LAS float* red = (LAS float*)F.ldsl;
    LAS float* logit = (LAS float*)(F.ldsl + 24576);
    const bf16* wr = (const bf16*)(F.ws + WS_MISC + MISC_WR) + (size_t)l * 2 * 48 * 2048;
    unsigned* cnt = (unsigned*)(F.ws + WS_CTL) + CW_CNT + 64 * l;
    int* tok_e = (int*)(F.ws + WS_ROUTE + RT_E); int* tok_pos = (int*)(F.ws + WS_ROUTE + RT_POS); float* tok_p = (float*)(F.ws + WS_ROUTE + RT_P);
    const int l15 = F.lane & 15, l4 = F.lane >> 4;
    for (int blk = blockIdx.x; blk < ROWS / 16; blk += F.G) {
#pragma unroll 1
        for (int rr = 0; rr < 2; ++rr) { const int lr = F.wave * 2 + rr, r = blk * 16 + lr;
            int b, i; row_split(r, b, i); bool ctx; const size_t off = hrow_off(b, i, ctx);
            const f32x4* xr = (const f32x4*)((ctx ? hc : hl) + off) + F.lane;
            f32x4 v[8];
#pragma unroll
            for (int j = 0; j < 8; ++j) v[j] = xr[64 * j];
            const float* mb = mod + (size_t)(ctx ? 8 : b) * (NMOD * D);
            norm_mod(v, g, mb + 3 * D, mb + 4 * D, F.lane);
            v2u* o = (v2u*)(V + (size_t)r * D) + F.lane;
#pragma unroll
            for (int j = 0; j < 8; ++j) { v2u w; w.x = cvt_pk(v[j][0], v[j][1]); w.y = cvt_pk(v[j][2], v[j][3]); o[64 * j] = w;
                v2u wl; wl.x = cvt_pk(v[j][0] - bflo(w.x), v[j][1] - bfhi(w.x)); wl.y = cvt_pk(v[j][2] - bflo(w.y), v[j][3] - bfhi(w.y));
                *(LAS v2u*)(Thi + lr * 2056 + (F.lane + 64 * j) * 4) = w; *(LAS v2u*)(Tlo + lr * 2056 + (F.lane + 64 * j) * 4) = wl; } }
        __syncthreads();
        f32x4 acc[3];
#pragma unroll
        for (int ct = 0; ct < 3; ++ct) acc[ct] = (f32x4){0.f, 0.f, 0.f, 0.f};
#pragma unroll 2
        for (int ks = 0; ks < 8; ++ks) { const int k0 = (F.wave * 8 + ks) * 32 + l4 * 8;
            const bf16x8 Ah = *(const LAS bf16x8*)(Thi + l15 * 2056 + k0), Al = *(const LAS bf16x8*)(Tlo + l15 * 2056 + k0);
#pragma unroll
            for (int ct = 0; ct < 3; ++ct) { const bf16x8 Bh = *(const bf16x8*)(wr + (size_t)(ct * 16 + l15) * 2048 + k0), Bl = *(const bf16x8*)(wr + (size_t)(48 + ct * 16 + l15) * 2048 + k0);
                acc[ct] = __builtin_amdgcn_mfma_f32_16x16x32_bf16(Ah, Bh, acc[ct], 0, 0, 0);
                acc[ct] = __builtin_amdgcn_mfma_f32_16x16x32_bf16(Ah, Bl, acc[ct], 0, 0, 0);
                acc[ct] = __builtin_amdgcn_mfma_f32_16x16x32_bf16(Al, Bh, acc[ct], 0, 0, 0); } }
        __syncthreads();
#pragma unroll
        for (int ct = 0; ct < 3; ++ct)
#pragma unroll
            for (int j = 0; j < 4; ++j) red[(F.wave * 16 + l4 * 4 + j) * 48 + ct * 16 + l15] = acc[ct][j];
        __syncthreads();
        for (int o = F.tid; o < 16 * 36; o += 512) { const int row = o / 36, e = o % 36; float s = 0.f;
#pragma unroll
            for (int w = 0; w < 8; ++w) s += red[(w * 16 + row) * 48 + e];
            s += e < 4 ? ain(a, I_BGRP)[l * 4 + e] : ain(a, I_BRT)[l * 32 + (e - 4)];
            logit[o] = s; }
        __syncthreads();
        if (F.tid < 16) { const LAS float* lg = logit + F.tid * 36; const int r = blk * 16 + F.tid;
            int gi = 0; float gm = lg[0];
            for (int e = 1; e < 4; ++e) { const float v = lg[e]; if (v > gm) { gm = v; gi = e; } }
            float gs = 0.f; for (int e = 0; e < 4; ++e) gs += expf(lg[e] - gm);
            const float gw = 1.0f / gs;
            const LAS float* el = lg + 4 + gi * 8;
            int i1 = 0; float v1 = el[0];
            for (int e = 1; e < 8; ++e) { const float v = el[e]; if (v > v1) { v1 = v; i1 = e; } }
            int i2 = -1; float v2 = -3.0e38f;
            for (int e = 0; e < 8; ++e) { const float v = el[e]; if (e != i1 && v > v2) { v2 = v; i2 = e; } }
            const float p1 = 1.0f / (1.0f + expf(v2 - v1)); const float p2 = 1.0f - p1;
            const int e1 = gi * 8 + i1, e2 = gi * 8 + i2;
            const unsigned pos1 = atomicAdd(&cnt[e1], 1u), pos2 = atomicAdd(&cnt[e2], 1u);
            tok_e[2 * r] = e1; tok_e[2 * r + 1] = e2; tok_pos[2 * r] = (int)pos1; tok_pos[2 * r + 1] = (int)pos2; tok_p[2 * r] = p1 * gw; tok_p[2 * r + 1] = p2 * gw; }
        __syncthreads();
    }
}

__device__ __forceinline__ void pi_scatter(Frame& F, int l) {
    phase_ids(F); l = launder_s(l);
    const unsigned* cnt = (const unsigned*)(F.ws + WS_CTL) + CW_CNT + 64 * l;
    LAS int* base = (LAS int*)F.ldsl;
    if (F.tid == 0) { int run = 0; for (int e = 0; e < NE; ++e) { base[e] = run; run += (int)((__hip_atomic_load(&cnt[e], __ATOMIC_RELAXED, __HIP_MEMORY_SCOPE_AGENT) + 255u) & ~255u); } base[NE] = run; }
    __syncthreads();
    const int* tok_e = (const int*)(F.ws + WS_ROUTE + RT_E); const int* tok_pos = (const int*)(F.ws + WS_ROUTE + RT_POS); int* tok_dest = (int*)(F.ws + WS_ROUTE + RT_DEST);
    const bf16* V = (const bf16*)(F.ws + WS_ACT); bf16* VS = (bf16*)(F.ws + WS_BIG);
    for (int s = F.gw; s < 2 * ROWS; s += F.NGW) { const int r = s >> 1; const int e = tok_e[s], pos = tok_pos[s]; const int dest = base[e] + pos;
        if (F.lane == 0) tok_dest[s] = dest;
        const v4u* src = (const v4u*)(V + (size_t)r * D) + F.lane; v4u* dst = (v4u*)(VS + (size_t)dest * D) + F.lane;
#pragma unroll
        for (int j = 0; j < 4; ++j) dst[64 * j] = src[64 * j]; }
    if (blockIdx.x == 0 && F.tid == 0) { int* tt = (int*)(F.ws + WS_MISC + MISC_TILE); int nt = 0;
        for (int e = 0; e < NE; ++e) { const int n = (base[e + 1] - base[e]) >> 8; for (int t = 0; t < n; ++t) tt[4 + nt++] = e; }
        tt[0] = nt; }
    __syncthreads();
}

__device__ __forceinline__ void pl_moe_combine(Frame& F, int l) {
    phase_ids(F); l = launder_s(l); KArgs a = kargs();
    float* hl = aout(a); float* hc = (float*)(F.ws + WS_HC);
    const float* mod = (const float*)(F.ws + WS_MOD) + (size_t)l * 9 * (NMOD * D);
    const bf16* YS = (const bf16*)(F.ws + WS_BIG);
    const int* tok_dest = (const int*)(F.ws + WS_ROUTE + RT_DEST); const float* tok_p = (const float*)(F.ws + WS_ROUTE + RT_P);
    for (int r = F.gw; r < ROWS; r += F.NGW) {
        int b, i; row_split(r, b, i); bool ctx; const size_t off = hrow_off(b, i, ctx);
        float* hp = (ctx ? hc : hl) + off; const float* mg = mod + (size_t)(ctx ? 8 : b) * (NMOD * D) + 5 * D;
        const int d0 = tok_dest[2 * r], d1 = tok_dest[2 * r + 1]; const float p0 = tok_p[2 * r], p1 = tok_p[2 * r + 1];
        const v2u* y0 = (const v2u*)(YS + (size_t)d0 * D) + F.lane; const v2u* y1 = (const v2u*)(YS + (size_t)d1 * D) + F.lane;
#pragma unroll
        for (int j = 0; j < 8; ++j) { const int c = (F.lane + 64 * j) * 4; const v2u u0 = y0[64 * j], u1 = y1[64 * j];
            const f32x4 g = *(const f32x4*)(mg + c); f32x4 h = *(const f32x4*)(hp + c);
            h[0] += g[0] * (p0 * bflo(u0.x) + p1 * bflo(u1.x)); h[1] += g[1] * (p0 * bfhi(u0.x) + p1 * bfhi(u1.x));
            h[2] += g[2] * (p0 * bflo(u0.y) + p1 * bflo(u1.y)); h[3] += g[3] * (p0 * bfhi(u0.y) + p1 * bfhi(u1.y));
            *(f32x4*)(hp + c) = h; }
    }
}

constexpr int PH_PER_LAYER = 12, N_PHASES = 1 + 2 * PH_PER_LAYER;
#ifndef PHMASK
#define PHMASK 0xffffffffu
#endif
#define EN(j) ((PHMASK >> (j)) & 1u)
#define IN(k) (lo <= (k) && (k) < hi)
#define SEAM(k) do { if (IN(k) && IN((k) + 1)) xcd_barrier(bar); } while (0)
template <int l> __device__ __forceinline__ void layer_phases(Frame& F, const int lo, const int hi, const XcdBarrier& bar) {
        constexpr int p = 1 + l * PH_PER_LAYER;
        if (EN(1) && IN(p + 0)) { pa_norm1(F, l); if (l > 0) { __syncthreads(); conv_weights(F, l); } }
        SEAM(p + 0);
        if (EN(2) && IN(p + 1)) { phase_ids(F); unsigned char* ws = F.ws;
            pg8::Gemm g{(const bf16*)(ws + WS_ACT), (const bf16*)(ws + WS_WIN), D, D, D}; pg8::StaticOrder S; S.init(ROWS, INC, F.G, (int)blockIdx.x);
            pg8::EpiBf16 E{(bf16*)(ws + WS_PROJ), INC, 0xffff}; pg8::gemm_phase(F.ldsl, g, S, E); }
        SEAM(p + 1);
        if (EN(3) && IN(p + 2)) { pc_qk(F, l); __syncthreads(); pc_lru(F, l); }
        SEAM(p + 2);
        if (EN(4) && IN(p + 3)) { pd_chain(F); pd_attn(F); }
        SEAM(p + 3);
        if (EN(5) && IN(p + 4)) { pe_combine(F, l); }
        SEAM(p + 4);
        if (EN(6) && IN(p + 5)) {
            { phase_ids(F); unsigned char* ws = F.ws; KArgs a = kargs(); const int ll = launder_s(l); pg8::StaticOrder S; S.init(ROWS, D, F.G, (int)blockIdx.x);
              pg8::Gemm g{(const bf16*)(ws + WS_OA), (const bf16*)(ws + WS_WBR), D, 1024, 1024};
              pg8::EpiBranch<0> E{(float*)(ws + WS_BIG), (bf16*)(ws + WS_ACT), (const bf16*)(ws + WS_PROJ), ain(a, I_BGATE) + (size_t)ll * 3 * D, C_G}; pg8::gemm_phase(F.ldsl, g, S, E); }
            { phase_ids(F); unsigned char* ws = F.ws; KArgs a = kargs(); const int ll = launder_s(l); pg8::StaticOrder S; S.init(ROWS, D, F.G, (int)blockIdx.x);
              pg8::Gemm g{(const bf16*)(ws + WS_YB), (const bf16*)(ws + WS_WBR) + (size_t)D * 1024, 1024, 1024, 1024};
              pg8::EpiBranch<1> E{(float*)(ws + WS_BIG), (bf16*)(ws + WS_ACT), (const bf16*)(ws + WS_PROJ), ain(a, I_BGATE) + (size_t)ll * 3 * D + D, C_G + D}; pg8::gemm_phase(F.ldsl, g, S, E); }
            { phase_ids(F); unsigned char* ws = F.ws; KArgs a = kargs(); const int ll = launder_s(l); pg8::StaticOrder S; S.init(ROWS, D, F.G, (int)blockIdx.x);
              pg8::Gemm g{(const bf16*)(ws + WS_YC), (const bf16*)(ws + WS_WBR) + (size_t)2 * D * 1024, 1024, 1024, 1024};
              pg8::EpiBranch<2> E{(float*)(ws + WS_BIG), (bf16*)(ws + WS_ACT), (const bf16*)(ws + WS_PROJ), ain(a, I_BGATE) + (size_t)ll * 3 * D + 2 * D, C_G + 2 * D}; pg8::gemm_phase(F.ldsl, g, S, E); }
        }
        SEAM(p + 5);
        if (EN(7) && IN(p + 6)) { phase_ids(F); unsigned char* ws = F.ws; KArgs a = kargs(); const int ll = launder_s(l);
            pg8::Gemm g{(const bf16*)(ws + WS_ACT), (const bf16*)(ws + WS_WOUT), D, D, D}; pg8::StaticOrder S; S.init(ROWS, D, F.G, (int)blockIdx.x);
            pg8::EpiWout E{ll == 0 ? ain(a, I_X) : (const float*)aout(a), ll == 0 ? ain(a, I_CTX) : (const float*)(ws + WS_HC), aout(a), (float*)(ws + WS_HC), (const float*)(ws + WS_MOD) + (size_t)ll * 9 * (NMOD * D)};
            pg8::gemm_phase(F.ldsl, g, S, E); }
        SEAM(p + 6);
        if (EN(8) && IN(p + 7)) { ph_norm2_route(F, l); }
        SEAM(p + 7);
        if (EN(9) && IN(p + 8)) { pi_scatter(F, l); }
        SEAM(p + 8);
        if (EN(10) && IN(p + 9)) { phase_ids(F); unsigned char* ws = F.ws; const int* tt = (const int*)(ws + WS_MISC + MISC_TILE);
            pg8::Gemm g{(const bf16*)(ws + WS_BIG), (const bf16*)(ws + WS_W13), D, D, D}; pg8::MoeOrder S{tt + 4, tt[0], 4, F.G, (int)blockIdx.x};
            pg8::EpiUp E{(bf16*)(ws + WS_OA)}; pg8::gemm_phase(F.ldsl, g, S, E); }
        SEAM(p + 9);
        if (EN(11) && IN(p + 10)) { phase_ids(F); unsigned char* ws = F.ws; const int* tt = (const int*)(ws + WS_MISC + MISC_TILE);
            pg8::Gemm g{(const bf16*)(ws + WS_OA), (const bf16*)(ws + WS_W2), DE, DE, DE}; pg8::MoeOrder S{tt + 4, tt[0], 8, F.G, (int)blockIdx.x};
            pg8::EpiBf16 E{(bf16*)(ws + WS_BIG), D, 7}; pg8::gemm_phase(F.ldsl, g, S, E); }
        SEAM(p + 10);
        if (EN(12) && IN(p + 11)) { pl_moe_combine(F, l); }
        SEAM(p + 11);
    }
__global__ void __launch_bounds__(512, 2) mega_fwd(Args args) {
    extern __shared__ __attribute__((aligned(16))) unsigned char lds[];
    Frame F;
    F.lds0 = lds; F.lds = lds; F.ldsl = (LAS unsigned char*)lds; F.ws = args.ws;
    F.tid = threadIdx.x; F.lane = F.tid & 63; F.wave = __builtin_amdgcn_readfirstlane(F.tid >> 6);
    F.G = gridDim.x; F.gw = blockIdx.x * 8 + F.wave; F.NGW = F.G * 8;
    volatile LAS unsigned* misc = (volatile LAS unsigned*)(F.ldsl + LDS_MISC_OFF);
    if (F.tid < 4) misc[F.tid] = 0u;
    __syncthreads();
    const int lo = args.ph_lo, hi = args.ph_hi;
    XcdBarrier bar; bar.bar = (unsigned*)(args.ws + WS_CTL) + CW_BAR; bar.x = 0; bar.st = misc;
    if (hi - lo > 1) bar = xcd_barrier_post((unsigned*)(args.ws + WS_CTL) + CW_BAR, misc);
    if (EN(0) && IN(0)) { p0_misc(F); __syncthreads(); conv_weights(F, 0); }
    SEAM(0);
    layer_phases<0>(F, lo, hi, bar);
    layer_phases<1>(F, lo, hi, bar);
#undef IN
#undef SEAM
}

#ifndef MK_SINGLE
#define MK_SINGLE 0
#endif
extern "C" void kernel_launch(void* const* d_in, const int* in_sizes, int n_in, void* d_out, int out_size, void* d_ws, size_t ws_size, hipStream_t stream) {
    static int grid = 0;
    if (grid == 0) {
        if (n_in != 34 || out_size != NB * SEQ * D || ws_size < WS_END) { fprintf(stderr, "kernel_launch: unexpected shapes (n_in %d out %d ws %zu, need ws >= %zu)\n", n_in, out_size, ws_size, (size_t)WS_END); grid = -1; return; }
        int dev = 0, cus = 0, per_cu = 0;
        if (hipGetDevice(&dev) != hipSuccess || hipDeviceGetAttribute(&cus, hipDeviceAttributeMultiprocessorCount, dev) != hipSuccess) { grid = -1; return; }
        if (hipFuncSetAttribute((const void*)mega_fwd, hipFuncAttributeMaxDynamicSharedMemorySize, LDS_BYTES) != hipSuccess) { fprintf(stderr, "kernel_launch: hipFuncSetAttribute failed\n"); grid = -1; return; }
        if (hipOccupancyMaxActiveBlocksPerMultiprocessor(&per_cu, (const void*)mega_fwd, 512, LDS_BYTES) != hipSuccess || per_cu < 1) fprintf(stderr, "kernel_launch: occupancy query says %d\n", per_cu);
        (void)hipGetLastError();
        grid = cus;
    }
    if (grid < 0) return;
    (void)hipMemsetAsync((char*)d_ws + WS_CTL, 0, CTL_ZERO_BYTES, stream);
    Args a{};
    for (int i = 0; i < 34; ++i) a.in[i] = (const float*)d_in[i];
    a.out = (float*)d_out; a.ws = (unsigned char*)d_ws;
#if MK_SINGLE
    a.ph_lo = 0; a.ph_hi = N_PHASES;
    hipLaunchKernelGGL(mega_fwd, dim3(grid), dim3(512), LDS_BYTES, stream, a);
#else
    for (int p = 0; p < N_PHASES; ++p) { a.ph_lo = p; a.ph_hi = p + 1; hipLaunchKernelGGL(mega_fwd, dim3(grid), dim3(512), LDS_BYTES, stream, a); }
#endif
    const hipError_t le = hipPeekAtLastError();
    if (le != hipSuccess) fprintf(stderr, "kernel_launch: launch failed: %s\n", hipGetErrorName(le));
}
```

```cpp
#include <hip/hip_runtime.h>
#include <cstdio>
#include <cstdint>

#define GAS __attribute__((address_space(1)))
#define LAS __attribute__((address_space(3)))
typedef unsigned short bf16;
typedef unsigned v4u __attribute__((ext_vector_type(4)));
typedef unsigned v2u __attribute__((ext_vector_type(2)));
typedef float f32x4 __attribute__((ext_vector_type(4)));
typedef float f32x2 __attribute__((ext_vector_type(2)));
typedef short bf16x8 __attribute__((ext_vector_type(8)));
#define LDS_WAIT() asm volatile("s_waitcnt lgkmcnt(0)" ::: "memory")
#define VM_WAIT() asm volatile("s_waitcnt vmcnt(0)" ::: "memory")

constexpr int D = 2048, NB = 8, SEQ = 2048, CTXL = 256, TB = SEQ + CTXL, ROWS = NB * TB;
constexpr int INC = 12800;
constexpr int C_AQ = 0, C_AK = 1024, C_AV = 2048, C_BX = 3072, C_BY = 4096, C_CQ = 5120, C_CK = 6144, C_CV = 6400, C_G = 6656;
constexpr int NE = 32, DE = 512, NMOD = 6;
constexpr int MS = 45056;
constexpr int NCH = TB / 32;
constexpr float EPS = 1e-6f;

constexpr size_t MiB = 1u << 20;
constexpr size_t WS_CTL = 0, CTL_ZERO_BYTES = 1 * MiB;
constexpr size_t WS_MOD = 1 * MiB;
constexpr size_t WS_ROPE = 2 * MiB;
constexpr size_t WS_MISC = 3 * MiB;
constexpr size_t WS_LRUW = 4 * MiB;
constexpr size_t WS_ROUTE = 6 * MiB;
constexpr size_t WS_CARRY = 8 * MiB;
constexpr size_t WS_WIN = 24 * MiB;
constexpr size_t WS_WBR = 74 * MiB;
constexpr size_t WS_WOUT = 86 * MiB;
constexpr size_t WS_W13 = 94 * MiB;
constexpr size_t WS_W2 = 222 * MiB;
constexpr size_t WS_HC = 286 * MiB;
constexpr size_t WS_ACT = 302 * MiB;
constexpr size_t WS_PROJ = 374 * MiB;
constexpr size_t WS_BIG = 824 * MiB;
constexpr size_t WS_OA = 1000 * MiB;
constexpr size_t WS_YB = 1072 * MiB;
constexpr size_t WS_YC = 1108 * MiB;
constexpr size_t WS_END = 1144 * MiB;
constexpr int CW_BAR = 4096;
constexpr int CW_CNT = 8192;
constexpr size_t MISC_LAM = 0;
constexpr size_t MISC_TILE = 1024;
constexpr size_t MISC_WR = 4096;
constexpr size_t RT_E = 0, RT_POS = 256 * 1024, RT_P = 512 * 1024, RT_DEST = 768 * 1024;
constexpr size_t CARRY_N = (size_t)2 * NB * NCH * 1024;
constexpr int LDS_BYTES = 147456;
constexpr int LDS_MISC_OFF = 135168;

__device__ __forceinline__ float bf2f(unsigned short b) { return __uint_as_float(((unsigned)b) << 16); }
__device__ __forceinline__ float bflo(unsigned u) { return __uint_as_float(u << 16); }
__device__ __forceinline__ float bfhi(unsigned u) { return __uint_as_float(u & 0xffff0000u); }
__device__ __forceinline__ unsigned cvt_pk(float lo, float hi) { unsigned r; asm volatile("v_cvt_pk_bf16_f32 %0, %1, %2" : "=v"(r) : "v"(lo), "v"(hi)); return r; }
__device__ __forceinline__ float wave_sum(float v) {
#pragma unroll
    for (int o = 1; o < 64; o <<= 1) v += __shfl_xor(v, o);
    return v;
}
__device__ __forceinline__ float sigmoidf_(float x) { return 1.0f / (1.0f + __expf(-x)); }

namespace pg8 {
constexpr int BM = 256, BK = 64, HALF = 128, HTB = HALF * BK * 2, STAGE_BYTES = 8 * HTB, NXCD = 8, WGM = 8;
__host__ __device__ __forceinline__ int lds_byte(int r, int c) { const int st = (r >> 4) * 2 + (c >> 5), rr = r & 15, cc = c & 31, ob = rr * 64 + cc * 2; return st * 1024 + (ob ^ (((ob >> 9) & 1) << 5)); }
__host__ __device__ __forceinline__ void stage_rc(int b, int& R, int& C) { const int st = b / 1024, sb = b % 1024, swz = sb ^ (((sb >> 9) & 1) << 5); R = (st >> 1) * 16 + swz / 64; C = (st & 1) * 32 + (swz % 64) / 2; }
__host__ __device__ __forceinline__ int perm32(int rho) { const int n = rho >> 4, i = rho & 15; return 8 * (i >> 2) + 4 * n + (i & 3); }
struct Unit { int pm, pn; };
struct Gemm { const bf16* A; const bf16* Bt; int lda, ldb, K; };
struct StaticOrder {
    int nM, nN, nwg, G, c;
    __device__ void init(int M, int N, int G_, int c_) { nM = M / BM; nN = N / BM; nwg = nM * nN; G = G_; c = c_; }
    __device__ bool next(int i, Unit& u) const {
        const long L = (long)i * G + c; if (L >= nwg) return false;
        int wgid = (int)L; { const int q = nwg / NXCD, r = nwg % NXCD, xcd = wgid % NXCD, off = wgid / NXCD; wgid = (xcd < r ? xcd * (q + 1) : r * (q + 1) + (xcd - r) * q) + off; }
        const int nig = WGM * nN, gid = wgid / nig, fm = gid * WGM, gsz = (nM - fm) < WGM ? (nM - fm) : WGM;
        u.pm = fm + ((wgid % nig) % gsz); u.pn = (wgid % nig) / gsz; return true;
    }
};
struct MoeOrder {
    const int* tile_e; int ntiles, NT, G, c;
    __device__ bool next(int i, Unit& u) const {
        const long L = (long)i * G + c; if (L >= (long)ntiles * NT) return false;
        const int mt = (int)(L / NT), pnl = (int)(L % NT);
        u.pm = mt; u.pn = tile_e[mt] * NT + pnl; return true;
    }
};
struct EpiBf16 {
    static constexpr bool PERM = true;
    bf16* O; int ldc; int pn_mask;
    __device__ __forceinline__ void operator()(const f32x4 (&acc)[2][2][4][2], const Unit& u, int wr, int wc, int fr, int fq) const {
        const int row0 = u.pm * BM + wr * 64 + fr; const int col0 = (u.pn & pn_mask) * BM + wc * 32 + 8 * fq;
#pragma unroll
        for (int ai = 0; ai < 2; ++ai)
#pragma unroll
            for (int m = 0; m < 4; ++m) { bf16* rowp = O + (size_t)(row0 + ai * HALF + m * 16) * ldc + col0;
#pragma unroll
                for (int bj = 0; bj < 2; ++bj) { const f32x4 v0 = acc[ai][bj][m][0], v1 = acc[ai][bj][m][1];
                    v4u w; w.x = cvt_pk(v0[0], v0[1]); w.y = cvt_pk(v0[2], v0[3]); w.z = cvt_pk(v1[0], v1[1]); w.w = cvt_pk(v1[2], v1[3]);
                    *(v4u*)(rowp + bj * HALF) = w; } }
    }
};
template <int S> struct EpiBranch {
    static constexpr bool PERM = false;
    float* Mf; bf16* Mb; const bf16* proj; const float* bgate; int gcol0;
    __device__ __forceinline__ void operator()(const f32x4 (&acc)[2][2][4][2], const Unit& u, int wr, int wc, int fr, int fq) const {
        const int row0 = u.pm * BM + wr * 64 + fr, col0 = u.pn * BM + wc * 32 + 4 * fq;
#pragma unroll
        for (int ai = 0; ai < 2; ++ai)
#pragma unroll
            for (int m = 0; m < 4; ++m) { const size_t row = (size_t)(row0 + ai * HALF + m * 16);
#pragma unroll
                for (int bj = 0; bj < 2; ++bj)
#pragma unroll
                    for (int n = 0; n < 2; ++n) { const int col = col0 + bj * HALF + n * 16;
                        const v2u gr = *(const v2u*)(proj + row * INC + gcol0 + col); const f32x4 bg = *(const f32x4*)(bgate + col);
                        f32x4 g; g[0] = sigmoidf_(bflo(gr.x) + bg[0]); g[1] = sigmoidf_(bfhi(gr.x) + bg[1]); g[2] = sigmoidf_(bflo(gr.y) + bg[2]); g[3] = sigmoidf_(bfhi(gr.y) + bg[3]);
                        f32x4 v = g * acc[ai][bj][m][n];
                        float* mp = Mf + row * D + col;
                        if (S == 0) *(f32x4*)mp = v;
                        else if (S == 1) *(f32x4*)mp = *(const f32x4*)mp + v;
                        else { v = *(const f32x4*)mp + v; v2u w; w.x = cvt_pk(v[0], v[1]); w.y = cvt_pk(v[2], v[3]); *(v2u*)(Mb + row * D + col) = w; } }
                asm volatile("" ::: "memory"); }
    }
};
struct EpiWout {
    static constexpr bool PERM = false;
    const float* base_lat; const float* base_ctx; float* out_lat; float* out_ctx; const float* modl;
    __device__ __forceinline__ void operator()(const f32x4 (&acc)[2][2][4][2], const Unit& u, int wr, int wc, int fr, int fq) const {
        const int b = u.pm / 9, j = u.pm % 9; const bool ctx = (j == 0);
        const size_t r0 = ctx ? (size_t)b * CTXL : (size_t)b * SEQ + (size_t)(j - 1) * 256;
        const float* bp = (ctx ? base_ctx : base_lat) + r0 * D; float* op = (ctx ? out_ctx : out_lat) + r0 * D;
        const float* mg = modl + (size_t)(ctx ? 8 : b) * (NMOD * D) + 2 * D;
        const int rl0 = wr * 64 + fr, col0 = u.pn * BM + wc * 32 + 4 * fq;
#pragma unroll
        for (int ai = 0; ai < 2; ++ai)
#pragma unroll
            for (int m = 0; m < 4; ++m) { const size_t ro = (size_t)(rl0 + ai * HALF + m * 16) * D;
#pragma unroll
                for (int bj = 0; bj < 2; ++bj)
#pragma unroll
                    for (int n = 0; n < 2; ++n) { const int col = col0 + bj * HALF + n * 16;
                        const f32x4 g = *(const f32x4*)(mg + col); const f32x4 bs = *(const f32x4*)(bp + ro + col);
                        *(f32x4*)(op + ro + col) = bs + g * acc[ai][bj][m][n]; }
                asm volatile("" ::: "memory"); }
    }
};
struct EpiUp {
    static constexpr bool PERM = true;
    bf16* HB;
    __device__ __forceinline__ void operator()(const f32x4 (&acc)[2][2][4][2], const Unit& u, int wr, int wc, int fr, int fq) const {
        const int row0 = u.pm * BM + wr * 64 + fr; const int col0 = (u.pn & 3) * HALF + wc * 32 + 8 * fq;
#pragma unroll
        for (int ai = 0; ai < 2; ++ai)
#pragma unroll
            for (int m = 0; m < 4; ++m) { bf16* rowp = HB + (size_t)(row0 + ai * HALF + m * 16) * DE + col0;
                f32x4 h0, h1;
#pragma unroll
                for (int e = 0; e < 4; ++e) { const float a0 = acc[ai][0][m][0][e], a1 = acc[ai][0][m][1][e];
                    h0[e] = a0 * sigmoidf_(a0) * acc[ai][1][m][0][e]; h1[e] = a1 * sigmoidf_(a1) * acc[ai][1][m][1][e]; }
                v4u w; w.x = cvt_pk(h0[0], h0[1]); w.y = cvt_pk(h0[2], h0[3]); w.z = cvt_pk(h1[0], h1[1]); w.w = cvt_pk(h1[2], h1[3]);
                *(v4u*)rowp = w; }
    }
};

template <class Epi, class Sched>
__device__ __forceinline__ void gemm_phase(LAS unsigned char* lds, const Gemm g, const Sched& S, const Epi& E) {
    constexpr bool ALIGN_EPI = true;
    int tid_ = threadIdx.x; asm volatile("" : "+v"(tid_));
    const int tid = tid_, wid = __builtin_amdgcn_readfirstlane(tid >> 6), lane = tid & 63, wr = wid >> 2, wc = wid & 3, fr = lane & 15, fq = lane >> 4;
    const int K = g.K, nt = K / BK;
    unsigned voffA[2], voffB[2];
#pragma unroll
    for (int i = 0; i < 2; ++i) { int R, C; stage_rc(tid * 16 + i * 8192, R, C); const int Rb = Epi::PERM ? ((R & ~31) + perm32(R & 31)) : R;
        voffA[i] = (unsigned)(R * g.lda + C) * 2u; voffB[i] = (unsigned)(Rb * g.ldb + C) * 2u; }
    const size_t kstep = (size_t)(BK * 2);
    const size_t hstepA = (size_t)HALF * g.lda * 2, hstepB = (size_t)HALF * g.ldb * 2;
    const size_t tstepA = 2 * hstepA, tstepB = 2 * hstepB;
    const unsigned ldsw = (unsigned)wid * 1024u;
    const int aoff = lds_byte(wr * 64 + fr, fq * 8), boff = lds_byte(wc * 32 + fr, fq * 8);
#define PG8_SA(b, h) (((b) * 2 + (h)) * HTB)
#define PG8_SB(b, h) ((4 + (b) * 2 + (h)) * HTB)
#define PG8_STAGE(bufoff, gbase, voff) do { _Pragma("unroll") for (int _i = 0; _i < 2; ++_i) \
        __builtin_amdgcn_global_load_lds((const unsigned*)((const char*)(gbase) + (voff)[_i]), (LAS unsigned*)(lds + (bufoff) + ldsw + _i * 8192), 16, 0, 0); } while (0)
#define PG8_LDA(dst, b, h) do { _Pragma("unroll") for (int m = 0; m < 4; ++m) _Pragma("unroll") for (int k = 0; k < 2; ++k) dst[m][k] = *(const LAS bf16x8*)(lds + PG8_SA(b, h) + aoff + m * 2048 + k * 1024); } while (0)
#define PG8_LDB(dst, b, h) do { _Pragma("unroll") for (int n = 0; n < 2; ++n) _Pragma("unroll") for (int k = 0; k < 2; ++k) dst[n][k] = *(const LAS bf16x8*)(lds + PG8_SB(b, h) + boff + n * 2048 + k * 1024); } while (0)
#define PG8_MMA(ai, bj, At, Bt) do { __builtin_amdgcn_s_setprio(1); _Pragma("unroll") for (int m = 0; m < 4; ++m) _Pragma("unroll") for (int n = 0; n < 2; ++n) _Pragma("unroll") for (int k = 0; k < 2; ++k) \
        acc[ai][bj][m][n] = __builtin_amdgcn_mfma_f32_16x16x32_bf16(Bt[n][k], At[m][k], acc[ai][bj][m][n], 0, 0, 0); __builtin_amdgcn_s_setprio(0); } while (0)
#define PG8_WAIT_V(n) asm volatile("s_waitcnt vmcnt(" #n ")" ::: "memory")
#define PG8_WAIT_L(n) asm volatile("s_waitcnt lgkmcnt(" #n ")" ::: "memory")
#define PG8_BAR __builtin_amdgcn_s_barrier()
#define PG8_SCHED __builtin_amdgcn_sched_barrier(0)
    Unit cur, nxt; int ui = 0;
    if (!S.next(0, cur)) return;
    f32x4 acc[2][2][4][2];
#pragma unroll
    for (int a = 0; a < 2; ++a)
#pragma unroll
        for (int b = 0; b < 2; ++b)
#pragma unroll
            for (int m = 0; m < 4; ++m)
#pragma unroll
                for (int n = 0; n < 2; ++n) acc[a][b][m][n] = (f32x4){0.f, 0.f, 0.f, 0.f};
    bf16x8 At[4][2], B0[2][2], B1[2][2];
    const char* cA = (const char*)g.A + (size_t)cur.pm * tstepA; const char* cB = (const char*)g.Bt + (size_t)cur.pn * tstepB;
    PG8_STAGE(PG8_SB(0, 0), cB, voffB); PG8_STAGE(PG8_SB(0, 1), cB + hstepB, voffB); PG8_STAGE(PG8_SA(0, 0), cA, voffA); PG8_STAGE(PG8_SA(0, 1), cA + hstepA, voffA);
    if (wr == 1) PG8_BAR;
    PG8_WAIT_V(2); PG8_BAR;
    PG8_STAGE(PG8_SB(1, 0), cB + kstep, voffB); PG8_STAGE(PG8_SA(1, 0), cA + kstep, voffA); PG8_STAGE(PG8_SB(1, 1), cB + hstepB + kstep, voffB);
    PG8_WAIT_V(6); PG8_BAR;
    for (;;) {
        const bool has_next = S.next(ui + 1, nxt);
        const char* nA = has_next ? (const char*)g.A + (size_t)nxt.pm * tstepA : cA; const char* nB = has_next ? (const char*)g.Bt + (size_t)nxt.pn * tstepB : cB;
        for (int t = 0; t < nt; t += 2) {
            const bool last = (t == nt - 2);
            const char* a1 = cA + (size_t)(t + 1) * kstep;
            const char* a2 = last ? nA : cA + (size_t)(t + 2) * kstep; const char* b2 = last ? nB : cB + (size_t)(t + 2) * kstep;
            const char* a3 = a2 + kstep; const char* b3 = b2 + kstep;
            PG8_LDB(B0, 0, 0); PG8_LDB(B1, 0, 1); PG8_SCHED; PG8_LDA(At, 0, 0); PG8_STAGE(PG8_SA(1, 1), a1 + hstepA, voffA);
            PG8_WAIT_V(8); PG8_WAIT_L(0); PG8_BAR; PG8_MMA(0, 0, At, B0); PG8_MMA(0, 1, At, B1); PG8_BAR; PG8_SCHED;
            PG8_LDA(At, 0, 1); PG8_STAGE(PG8_SB(0, 0), b2, voffB); PG8_STAGE(PG8_SB(0, 1), b2 + hstepB, voffB); PG8_STAGE(PG8_SA(0, 0), a2, voffA);
            PG8_WAIT_V(8); PG8_WAIT_L(0); PG8_BAR; PG8_MMA(1, 0, At, B0); PG8_MMA(1, 1, At, B1); PG8_BAR; PG8_SCHED;
            PG8_LDB(B0, 1, 0); PG8_LDB(B1, 1, 1); PG8_SCHED; PG8_LDA(At, 1, 0); PG8_STAGE(PG8_SA(0, 1), a2 + hstepA, voffA);
            PG8_WAIT_V(8); PG8_WAIT_L(0); PG8_BAR; PG8_MMA(0, 0, At, B0); PG8_MMA(0, 1, At, B1); PG8_BAR; PG8_SCHED;
            PG8_LDA(At, 1, 1); PG8_STAGE(PG8_SB(1, 0), b3, voffB); PG8_STAGE(PG8_SB(1, 1), b3 + hstepB, voffB); PG8_STAGE(PG8_SA(1, 0), a3, voffA);
            PG8_WAIT_V(8); PG8_WAIT_L(0); PG8_BAR; PG8_MMA(1, 0, At, B0); PG8_MMA(1, 1, At, B1); PG8_BAR; PG8_SCHED;
        }
        if constexpr (ALIGN_EPI) { if (wr == 0) PG8_BAR; }
        { int fr2 = fr, fq2 = fq; asm volatile("" : "+v"(fr2), "+v"(fq2)); E(acc, cur, wr, wc, fr2, fq2); }
        if (!has_next) break;
#pragma unroll
        for (int a = 0; a < 2; ++a)
#pragma unroll
            for (int b = 0; b < 2; ++b)
#pragma unroll
                for (int m = 0; m < 4; ++m)
#pragma unroll
                    for (int n = 0; n < 2; ++n) acc[a][b][m][n] = (f32x4){0.f, 0.f, 0.f, 0.f};
        cur = nxt; cA = nA; cB = nB; ++ui;
        if constexpr (ALIGN_EPI) { if (wr == 1) PG8_BAR; }
    }
    PG8_WAIT_V(0);
    if constexpr (!ALIGN_EPI) { if (wr == 0) PG8_BAR; }
    PG8_BAR;
#undef PG8_SA
#undef PG8_SB
#undef PG8_STAGE
#undef PG8_LDA
#undef PG8_LDB
#undef PG8_MMA
#undef PG8_WAIT_V
#undef PG8_WAIT_L
#undef PG8_BAR
#undef PG8_SCHED
}
}

namespace att {
constexpr int AD = 128, NW = 8, QBLK = 32, KVBLK = 64;
constexpr float SCALE = 0.088388347648318440f;
constexpr float THR = 8.f;
constexpr int LDQ = INC, LDK = INC;
constexpr size_t SHM_V = KVBLK * AD * 2, SHM_K = KVBLK * AD * 2, SHM_ATTN = 2 * SHM_V + 2 * SHM_K + NW * 64 * 4;
using s16x4 = __attribute__((ext_vector_type(4))) short;
using f32x16 = __attribute__((ext_vector_type(16))) float;
#define KSWZ(row, colB) ((row) * 256 + ((colB) ^ (((row) & 7) << 4)))
#define SBAR() __builtin_amdgcn_sched_barrier(0)
__device__ __forceinline__ int crow(int r, int hi) { return (r & 3) + 8 * (r >> 2) + 4 * hi; }
__device__ __forceinline__ void partialSM(f32x16& p0, f32x16& p1, float& m_reg, float& mn, float& alpha) {
  constexpr float C = SCALE * 1.4426950408889634f;
  float pmax = p0[0]; for (int r = 1; r < 16; ++r) pmax = fmaxf(pmax, p0[r]); for (int r = 0; r < 16; ++r) pmax = fmaxf(pmax, p1[r]);
  { auto rr = __builtin_amdgcn_permlane32_swap(__float_as_uint(pmax), __float_as_uint(pmax), false, false);
    pmax = fmaxf(__uint_as_float(rr[0]), __uint_as_float(rr[1])); }
  if (__builtin_expect(__all(pmax - m_reg <= THR / SCALE), 1)) { mn = m_reg; alpha = 1.f; }
  else { mn = fmaxf(m_reg, pmax); alpha = __builtin_amdgcn_exp2f((m_reg - mn) * C); m_reg = mn; }
  float mnC = -mn * C;
  for (int r = 0; r < 16; ++r) p0[r] = fmaf(p0[r], C, mnC); for (int r = 0; r < 16; ++r) p1[r] = fmaf(p1[r], C, mnC);
  for (int r = 0; r < 16; ++r) p0[r] = __builtin_amdgcn_exp2f(p0[r]);
}
__device__ __forceinline__ void finishSM(f32x16& p0, f32x16& p1, float alpha, float& l_reg, bf16x8& pa0, bf16x8& pa1, bf16x8& pa2, bf16x8& pa3) {
  for (int r = 0; r < 16; ++r) p1[r] = __builtin_amdgcn_exp2f(p1[r]);
  float ps = 0; for (int r = 0; r < 16; ++r) ps += p0[r]; for (int r = 0; r < 16; ++r) ps += p1[r];
  { auto rr = __builtin_amdgcn_permlane32_swap(__float_as_uint(ps), __float_as_uint(ps), false, false);
    ps = __uint_as_float(rr[0]) + __uint_as_float(rr[1]); }
  l_reg = l_reg * alpha + ps;
#define PK4(P, BASE, OUT) do { unsigned a0 = cvt_pk(P[BASE + 0], P[BASE + 1]), a1 = cvt_pk(P[BASE + 2], P[BASE + 3]);   \
    unsigned b0 = cvt_pk(P[BASE + 4], P[BASE + 5]), b1 = cvt_pk(P[BASE + 6], P[BASE + 7]);                              \
    auto r0 = __builtin_amdgcn_permlane32_swap(a0, b0, false, false); auto r1 = __builtin_amdgcn_permlane32_swap(a1, b1, false, false); \
    v4u w = {r0[0], r1[0], r0[1], r1[1]}; OUT = *reinterpret_cast<bf16x8*>(&w); } while (0)
  PK4(p0, 0, pa0); PK4(p0, 8, pa1); PK4(p1, 0, pa2); PK4(p1, 8, pa3);
#undef PK4
}
__device__ __forceinline__ void qkt(f32x16& p0, f32x16& p1, const bf16* Ks, const bf16x8* qr, int r32, int hi) {
  p0 = f32x16{}; p1 = f32x16{};
  for (int d0 = 0; d0 < 8; ++d0) { int cb = (d0 * 16 + hi * 8) * 2;
    bf16x8 b0 = *reinterpret_cast<const bf16x8*>((const char*)Ks + KSWZ(r32, cb));
    bf16x8 b1 = *reinterpret_cast<const bf16x8*>((const char*)Ks + KSWZ(32 + r32, cb));
    p0 = __builtin_amdgcn_mfma_f32_32x32x16_bf16(b0, qr[d0], p0, 0, 0, 0);
    p1 = __builtin_amdgcn_mfma_f32_32x32x16_bf16(b1, qr[d0], p1, 0, 0, 0); }
}
__device__ __forceinline__ int v_st(int k, int c) { const int kk = (k & ~0xC) | ((k & 4) << 1) | ((k & 8) >> 1); return ((kk >> 3) * 4 + (c >> 5)) * 512 + ((kk & 7) * 32 + (c & 31)) * 2; }
__device__ __forceinline__ int v_rd_base(int lane) { return ((lane & 3) << 3) | (((lane >> 2) & 3) << 6) | (((lane >> 4) & 1) << 5) | (((lane >> 5) & 1) << 8); }
constexpr int v_rd_off(int d0, int ks, int half) { return d0 * 512 + ks * 4096 + half * 2048; }
template <int OFF> __device__ __forceinline__ s16x4 tr_read(int vb) {
  s16x4 r; asm volatile("ds_read_b64_tr_b16 %0, %1 offset:%2" : "=&v"(r) : "v"(vb), "i"(OFF) : "memory"); return r;
}
template <int D0> __device__ __forceinline__ void pv_one(f32x16& od, int vb, bf16x8 pa0, bf16x8 pa1, bf16x8 pa2, bf16x8 pa3) {
  const s16x4 l0 = tr_read<v_rd_off(D0, 0, 0)>(vb), h0 = tr_read<v_rd_off(D0, 0, 1)>(vb), l1 = tr_read<v_rd_off(D0, 1, 0)>(vb), h1 = tr_read<v_rd_off(D0, 1, 1)>(vb);
  const s16x4 l2 = tr_read<v_rd_off(D0, 2, 0)>(vb), h2 = tr_read<v_rd_off(D0, 2, 1)>(vb), l3 = tr_read<v_rd_off(D0, 3, 0)>(vb), h3 = tr_read<v_rd_off(D0, 3, 1)>(vb);
  asm volatile("s_waitcnt lgkmcnt(0)" ::: "memory"); SBAR();
#define PK(L, H) (bf16x8){L[0], L[1], L[2], L[3], H[0], H[1], H[2], H[3]}
  od = __builtin_amdgcn_mfma_f32_32x32x16_bf16(pa0, PK(l0, h0), od, 0, 0, 0);
  od = __builtin_amdgcn_mfma_f32_32x32x16_bf16(pa1, PK(l1, h1), od, 0, 0, 0);
  od = __builtin_amdgcn_mfma_f32_32x32x16_bf16(pa2, PK(l2, h2), od, 0, 0, 0);
  od = __builtin_amdgcn_mfma_f32_32x32x16_bf16(pa3, PK(l3, h3), od, 0, 0, 0);
#undef PK
}
__device__ __forceinline__ void pv_d0(f32x16* o, int vb, bf16x8 pa0, bf16x8 pa1, bf16x8 pa2, bf16x8 pa3) {
  pv_one<0>(o[0], vb, pa0, pa1, pa2, pa3); pv_one<1>(o[1], vb, pa0, pa1, pa2, pa3); pv_one<2>(o[2], vb, pa0, pa1, pa2, pa3); pv_one<3>(o[3], vb, pa0, pa1, pa2, pa3);
}
__device__ __forceinline__ void attn_dense_body(const bf16* __restrict__ Qb, const bf16* __restrict__ Kh, const bf16* __restrict__ Vh,
                                                bf16* __restrict__ Ob, int ldo, int seq, char* lds) {
  constexpr int SDEPTH = 2;
  int tid_ = threadIdx.x; asm volatile("" : "+v"(tid_));
  const int tid = tid_, wid = tid >> 6, lane = tid & 63, r32 = lane & 31, hi = lane >> 5;
  bf16* V_lds = (bf16*)lds; bf16* K_lds = (bf16*)(lds + 2 * SHM_V);
  float* ws = (float*)(lds + 2 * SHM_V + 2 * SHM_K) + wid * 64; float* li_l = ws; float* al_l = ws + 32;
  float m_reg = -1e30f, l_reg = 0; f32x16 o[4] = {}; bf16x8 qr[8];
  const bf16* Qw = Qb + (long)(wid * QBLK + r32) * LDQ + hi * 8;
#pragma unroll
  for (int d0 = 0; d0 < 8; ++d0) qr[d0] = *reinterpret_cast<const bf16x8*>(Qw + d0 * 16);
  const int sr = tid >> 4, sc = (tid & 15) * 8, vst0 = v_st(sr, sc), vst1 = v_st(32 + sr, sc);
  const int vb0 = (int)(uintptr_t)V_lds + v_rd_base(lane);
  struct { bf16x8 vs0, vs1, ks0, ks1; } sr_[SDEPTH];
#define SLOAD(i, k0) do { sr_[i].vs0 = *(const bf16x8*)(&Vh[(long)((k0) + sr) * LDK + sc]); sr_[i].vs1 = *(const bf16x8*)(&Vh[(long)((k0) + 32 + sr) * LDK + sc]); \
    sr_[i].ks0 = *(const bf16x8*)(&Kh[(long)((k0) + sr) * LDK + sc]); sr_[i].ks1 = *(const bf16x8*)(&Kh[(long)((k0) + 32 + sr) * LDK + sc]); } while (0)
#define SWRITE(b, i) do { *(bf16x8*)((char*)V_lds + (b) * SHM_V + vst0) = sr_[i].vs0;          \
    *(bf16x8*)((char*)V_lds + (b) * SHM_V + vst1) = sr_[i].vs1; int kc = sc * 2;               \
    *(bf16x8*)((char*)K_lds + (b) * SHM_K + KSWZ(sr, kc)) = sr_[i].ks0;                       \
    *(bf16x8*)((char*)K_lds + (b) * SHM_K + KSWZ(32 + sr, kc)) = sr_[i].ks1; } while (0)
#define SWAIT() asm volatile("s_waitcnt vmcnt(4)" ::: "memory")
#define RESC(a) do { if (__any((a) < 1.f)) { if (hi == 0) al_l[r32] = (a); asm volatile("s_waitcnt lgkmcnt(0)" ::: "memory"); \
    for (int d = 0; d < 4; ++d) for (int r = 0; r < 16; ++r) o[d][r] *= al_l[crow(r, hi)]; } } while (0)
  f32x16 pA0, pA1, pB0, pB1; float mnA, mnB, alA, alB; bf16x8 pa0, pa1, pa2, pa3; const int NT = seq / KVBLK;
  constexpr int SE = 0, SO = SDEPTH - 1;
  SLOAD(SE, 0); asm volatile("s_waitcnt vmcnt(0)" ::: "memory"); SWRITE(0, SE); __syncthreads();
  qkt(pA0, pA1, K_lds, qr, r32, hi); partialSM(pA0, pA1, m_reg, mnA, alA);
  SLOAD(SO, KVBLK); if (2 < NT) SLOAD(SE, 2 * KVBLK);
  SWAIT(); SWRITE(1, SO); __syncthreads();
  for (int j = 1; j + 1 < NT; j += 2) {
    SBAR(); qkt(pB0, pB1, (bf16*)((char*)K_lds + SHM_K), qr, r32, hi);
    finishSM(pA0, pA1, alA, l_reg, pa0, pa1, pa2, pa3); SBAR();
    SLOAD(SO, (j + SDEPTH) * KVBLK); SBAR();
    pv_d0(o, vb0, pa0, pa1, pa2, pa3); partialSM(pB0, pB1, m_reg, mnB, alB);
    __syncthreads(); SWAIT(); SWRITE(0, SE);
    RESC(alB); __syncthreads();
    SBAR(); qkt(pA0, pA1, K_lds, qr, r32, hi);
    finishSM(pB0, pB1, alB, l_reg, pa0, pa1, pa2, pa3); SBAR();
    if (j + 3 < NT) SLOAD(SE, (j + 1 + SDEPTH) * KVBLK); SBAR();
    pv_d0(o, vb0 + (int)SHM_V, pa0, pa1, pa2, pa3); partialSM(pA0, pA1, m_reg, mnA, alA);
    __syncthreads(); SWAIT(); SWRITE(1, SO);
    RESC(alA); __syncthreads();
  }
  SBAR(); qkt(pB0, pB1, (bf16*)((char*)K_lds + SHM_K), qr, r32, hi);
  finishSM(pA0, pA1, alA, l_reg, pa0, pa1, pa2, pa3); SBAR();
  pv_d0(o, vb0, pa0, pa1, pa2, pa3); partialSM(pB0, pB1, m_reg, mnB, alB);
  __syncthreads(); RESC(alB);
  finishSM(pB0, pB1, alB, l_reg, pa0, pa1, pa2, pa3); SBAR();
  pv_d0(o, vb0 + (int)SHM_V, pa0, pa1, pa2, pa3);
  if (hi == 0) li_l[r32] = l_reg; asm volatile("s_waitcnt lgkmcnt(0)" ::: "memory");
  float rli[16];
#pragma unroll
  for (int r = 0; r < 16; ++r) rli[r] = __builtin_amdgcn_rcpf(li_l[crow(r, hi)]);
  bf16* Ow = Ob + (long)(wid * QBLK) * ldo;
#pragma unroll
  for (int r = 0; r < 16; ++r) { int orow = crow(r, hi);
    for (int d0 = 0; d0 < 4; ++d0) Ow[(long)orow * ldo + d0 * 32 + r32] = (bf16)(cvt_pk(o[d0][r] * rli[r], 0.f) & 0xffffu); }
#undef SLOAD
#undef SWRITE
#undef SWAIT
#undef RESC
}
}

#define XB_TMO      128
#define XB_XCNT(j)  (256  + 64 * (j))
#define XB_XSUB(j)  (1280 + 64 * (j))
#define XB_XGEN(j)  (2304 + 64 * (j))
#define XB_TOP      3328
#define XB_TOPGEN   3392
#define XCD_BAR_WORDS 3456
#define XB_SPIN_CAP (1u << 18)
__device__ __forceinline__ unsigned xb_ld(unsigned* p)              { return __hip_atomic_load(p, __ATOMIC_RELAXED, __HIP_MEMORY_SCOPE_AGENT); }
__device__ __forceinline__ unsigned xb_add(unsigned* p, unsigned v) { return __hip_atomic_fetch_add(p, v, __ATOMIC_RELAXED, __HIP_MEMORY_SCOPE_AGENT); }
__device__ __forceinline__ unsigned xb_xcc_id() { return (unsigned)__builtin_amdgcn_s_getreg((3 << 11) | 20) & 0xFu; }
#define XB_SPIN(cond, bar) do { unsigned _sp = 0; while (cond) { __builtin_amdgcn_s_sleep(1); \
    if ((++_sp & 255u) == 0u) { if (xb_ld(&(bar)[XB_TMO])) break; if (_sp > XB_SPIN_CAP) { atomicAdd(&(bar)[XB_TMO], 1u); break; } } } } while (0)
struct XcdBarrier { unsigned* bar; unsigned x; volatile LAS unsigned* st; };
__device__ __forceinline__ XcdBarrier xcd_barrier_post(unsigned* bar, volatile LAS unsigned* st) {
    XcdBarrier b; b.bar = bar; b.x = xb_xcc_id(); b.st = st;
    if (threadIdx.x == 0) (void)xb_add(&bar[XB_XCNT(b.x)], 1u);
    return b;
}
__device__ __forceinline__ void xcd_barrier_complete(unsigned* bar, unsigned x, unsigned& nloc, unsigned& nx) {
    const unsigned G = gridDim.x * gridDim.y * gridDim.z;
    unsigned sum, cnt, mine, sp = 0u;
    for (;;) {
        sum = 0u; cnt = 0u; mine = 0u;
#pragma unroll
        for (unsigned j = 0; j < 16; ++j) { const unsigned c = xb_ld(&bar[XB_XCNT(j)]); sum += c; cnt += (c > 0u) ? 1u : 0u; mine = (j == x) ? c : mine; }
        if (sum == G) break;
        __builtin_amdgcn_s_sleep(1);
        if ((++sp & 255u) == 0u) { if (xb_ld(&bar[XB_TMO])) break; if (sp > XB_SPIN_CAP) { atomicAdd(&bar[XB_TMO], 1u); break; } }
    }
    nloc = mine > 0u ? mine : 1u; nx = cnt > 0u ? cnt : 1u;
}
__device__ __forceinline__ void xcd_barrier(const XcdBarrier& b) {
    asm volatile("s_waitcnt vmcnt(0)" ::: "memory");
    __syncthreads();
    if (threadIdx.x == 0) {
        unsigned* bar = b.bar;
        __builtin_amdgcn_s_waitcnt(0);
        unsigned nloc = b.st[0], nx = b.st[1];
        if (nloc == 0u) { xcd_barrier_complete(bar, b.x, nloc, nx); b.st[0] = nloc; b.st[1] = nx; }
        const unsigned old = xb_add(&bar[XB_XSUB(b.x)], 1u);
        const unsigned gen = old / nloc;
        if (old + 1u == (gen + 1u) * nloc) {
            __builtin_amdgcn_fence(__ATOMIC_RELEASE, "agent");
            asm volatile("s_waitcnt vmcnt(0)" ::: "memory");
            const unsigned og = xb_add(&bar[XB_TOP], 1u);
            const unsigned tg = og / nx;
            if (og + 1u == (tg + 1u) * nx) xb_add(&bar[XB_TOPGEN], 1u);
            else XB_SPIN(xb_ld(&bar[XB_TOPGEN]) == tg, bar);
            __builtin_amdgcn_fence(__ATOMIC_ACQUIRE, "agent");
            xb_add(&bar[XB_XGEN(b.x)], 1u);
            asm volatile("s_waitcnt vmcnt(0)" ::: "memory");
        } else {
            XB_SPIN(xb_ld(&bar[XB_XGEN(b.x)]) == gen, bar);
            __builtin_amdgcn_fence(__ATOMIC_ACQUIRE, "agent");
            asm volatile("s_waitcnt vmcnt(0)" ::: "memory");
        }
    }
    __syncthreads();
}

struct Args { const float* in[34]; float* out; unsigned char* ws; int ph_lo, ph_hi; };
typedef const __attribute__((address_space(4))) Args* KArgs;
template <class T> __device__ __forceinline__ T* as_global(T* p) { return (T*)(GAS T*)p; }
__device__ __forceinline__ KArgs kargs() { KArgs p = (KArgs)__builtin_amdgcn_kernarg_segment_ptr(); asm volatile("" : "+s"(p)); return p; }
__device__ __forceinline__ const float* ain(KArgs a, int i) { return as_global(a->in[i]); }
__device__ __forceinline__ float* aout(KArgs a) { return as_global(a->out); }
struct Frame {
    unsigned char* lds; unsigned char* lds0;
    LAS unsigned char* ldsl;
    unsigned char* ws;
    int tid, lane, wave, G, gw, NGW;
};
enum { I_X = 0, I_C, I_CTX, I_CCTX, I_WADA, I_BADA, I_N1G, I_N2G, I_WIN, I_BGATE, I_QNA, I_KNA, I_DLAM, I_SUBN, I_QNC, I_KNC, I_CONVW, I_CONVB,
       I_LWA, I_LBA, I_LWX, I_LBX, I_LLAM, I_WBA, I_WBB, I_WBC, I_WOUT, I_WGRP, I_BGRP, I_WRT, I_BRT, I_W1, I_W3, I_W2 };

__device__ __forceinline__ void phase_ids(Frame& F) {
    int t = threadIdx.x; asm volatile("" : "+v"(t)); F.tid = t; F.lane = t & 63; F.wave = __builtin_amdgcn_readfirstlane(t >> 6); F.gw = blockIdx.x * 8 + F.wave;
    GAS unsigned char* w = (GAS unsigned char*)kargs()->ws; asm volatile("" : "+s"(w)); F.ws = (unsigned char*)w; F.lds = F.lds0; F.ldsl = (LAS unsigned char*)F.lds0;
}
__device__ __forceinline__ int launder_s(int v) { asm volatile("" : "+s"(v)); return v; }
__device__ __forceinline__ void tr_item(const float* __restrict__ W, int N, bf16* __restrict__ WT, int K, int k0, int n0, int drow0, LAS float* scr, int lane) {
#pragma unroll 8
    for (int i = 0; i < 64; ++i) scr[i * 65 + lane] = W[(size_t)(k0 + i) * N + n0 + lane];
    LDS_WAIT();
    const int c = lane & 7;
#pragma unroll
    for (int j = 0; j < 8; ++j) { const int n = (lane >> 3) + 8 * j; const LAS float* s = scr + (8 * c) * 65 + n;
        v4u o; o.x = cvt_pk(s[0], s[65]); o.y = cvt_pk(s[130], s[195]); o.z = cvt_pk(s[260], s[325]); o.w = cvt_pk(s[390], s[455]);
        *(v4u*)(WT + (size_t)(drow0 + n) * K + k0 + 8 * c) = o; }
    LDS_WAIT();
}
__device__ __forceinline__ void conv_weights(Frame& F, int l) {
    phase_ids(F); l = launder_s(l); KArgs a = kargs();
    LAS float* scr = (LAS float*)(F.ldsl + F.wave * 16640);
    constexpr int I_IN = 32 * 200, I_BR = 16 * 32, I_OUT = 32 * 32, I_W = 32 * 256;
    constexpr int NIT = I_IN + 3 * I_BR + I_OUT + 3 * I_W;
    bf16* WIN = (bf16*)(F.ws + WS_WIN); bf16* WBR = (bf16*)(F.ws + WS_WBR); bf16* WOUT = (bf16*)(F.ws + WS_WOUT); bf16* W13 = (bf16*)(F.ws + WS_W13); bf16* W2 = (bf16*)(F.ws + WS_W2);
    for (int it = F.gw; it < NIT; it += F.NGW) {
        int r = it;
        if (r < I_IN) { const int kb = r / 200, nb = r % 200; tr_item(ain(a, I_WIN) + (size_t)l * D * INC, INC, WIN, D, kb * 64, nb * 64, nb * 64, scr, F.lane); continue; } r -= I_IN;
        if (r < 3 * I_BR) { const int br = r / I_BR, q = r % I_BR, kb = q / 32, nb = q % 32;
            tr_item(ain(a, I_WBA + br) + (size_t)l * 1024 * D, D, WBR + (size_t)br * D * 1024, 1024, kb * 64, nb * 64, nb * 64, scr, F.lane); continue; } r -= 3 * I_BR;
        if (r < I_OUT) { const int kb = r / 32, nb = r % 32; tr_item(ain(a, I_WOUT) + (size_t)l * D * D, D, WOUT, D, kb * 64, nb * 64, nb * 64, scr, F.lane); continue; } r -= I_OUT;
        if (r < 2 * I_W) { const int which = r / I_W, q = r % I_W, e = q / 256, q2 = q % 256, kb = q2 / 8, nb = q2 % 8;
            const int n0 = nb * 64; const int drow = e * 1024 + (n0 / 128) * 256 + (n0 % 128) + which * 128;
            tr_item(ain(a, which ? I_W3 : I_W1) + ((size_t)l * NE + e) * D * DE, DE, W13, D, kb * 64, n0, drow, scr, F.lane); continue; } r -= 2 * I_W;
        { const int e = r / 256, q2 = r % 256, kb = q2 / 32, nb = q2 % 32;
            tr_item(ain(a, I_W2) + ((size_t)l * NE + e) * DE * D, D, W2, DE, kb * 64, nb * 64, e * D + nb * 64, scr, F.lane); }
    }
}

__device__ __forceinline__ void p0_misc(Frame& F) {
    phase_ids(F); KArgs a = kargs();
    LAS float* sl = (LAS float*)F.ldsl;
    LAS float* red = sl + 9 * 2048;
    const float* c = ain(a, I_C); const float* cc = ain(a, I_CCTX);
    float* mod = (float*)(F.ws + WS_MOD);
    if (blockIdx.x < 192 || F.G < 192) {
        for (int idx = F.tid; idx < 9 * 2048; idx += 512) { const int b = idx >> 11, k = idx & 2047; const float v = b < 8 ? c[b * 2048 + k] : cc[k]; sl[idx] = v / (1.0f + expf(-v)); }
        __syncthreads();
        for (int it = blockIdx.x; it < 192; it += F.G) {
            const int l = it / 96, cb = it % 96, col = cb * 128 + 2 * F.lane;
            const float* wp = ain(a, I_WADA) + ((size_t)l * D + F.wave * 256) * (NMOD * D) + col;
            float ax[9], ay[9];
#pragma unroll
            for (int b = 0; b < 9; ++b) { ax[b] = 0.f; ay[b] = 0.f; }
            for (int k = 0; k < 256; k += 8) {
                f32x2 w[8];
#pragma unroll
                for (int u = 0; u < 8; ++u) w[u] = *(const f32x2*)(wp + (size_t)(k + u) * (NMOD * D));
#pragma unroll
                for (int u = 0; u < 8; ++u)
#pragma unroll
                    for (int b = 0; b < 9; ++b) { const float s = sl[b * 2048 + F.wave * 256 + k + u]; ax[b] += s * w[u].x; ay[b] += s * w[u].y; }
            }
#pragma unroll
            for (int b = 0; b < 9; ++b) { red[(F.wave * 9 + b) * 128 + 2 * F.lane] = ax[b]; red[(F.wave * 9 + b) * 128 + 2 * F.lane + 1] = ay[b]; }
            __syncthreads();
            for (int o = F.tid; o < 9 * 128; o += 512) { const int b = o >> 7, ci = o & 127; float s = 0.f;
#pragma unroll
                for (int w = 0; w < 8; ++w) s += red[(w * 9 + b) * 128 + ci];
                mod[((size_t)l * 9 + b) * (NMOD * D) + cb * 128 + ci] = s + ain(a, I_BADA)[(size_t)l * (NMOD * D) + cb * 128 + ci]; }
            __syncthreads();
        }
    }
    { float* rc = (float*)(F.ws + WS_ROPE); float* rs = rc + 2048 * 64;
      for (int idx = blockIdx.x * 512 + F.tid; idx < 2048 * 64; idx += F.G * 512) { const int t = idx >> 6, j = idx & 63, jj = j & 31;
          const float inv = 1.0f / powf(10000.0f, (float)(2 * jj) / 64.0f); const float pos = (float)(j < 32 ? (t >> 6) : (t & 63));
          float s, co; sincosf(pos * inv, &s, &co); rc[idx] = co; rs[idx] = s; } }
    if (blockIdx.x == 0 && F.wave < 2) { const int l = F.wave; const float* dl = ain(a, I_DLAM) + (size_t)l * 4 * 128;
        float s01 = dl[F.lane] * dl[128 + F.lane] + dl[64 + F.lane] * dl[192 + F.lane];
        float s23 = dl[256 + F.lane] * dl[384 + F.lane] + dl[320 + F.lane] * dl[448 + F.lane];
        s01 = wave_sum(s01); s23 = wave_sum(s23);
        const float li = l == 0 ? 0.2f : 0.3555090676f;
        if (F.lane == 0) ((float*)(F.ws + WS_MISC + MISC_LAM))[l] = expf(s01) - expf(s23) + li; }
    { bf16* wr = (bf16*)(F.ws + WS_MISC + MISC_WR);
      for (int idx = blockIdx.x * 512 + F.tid; idx < 2 * 48 * 2048; idx += F.G * 512) { const int l = idx / (48 * 2048), rem = idx % (48 * 2048), e = rem >> 11, k = rem & 2047;
          float w = 0.f; if (e < 4) w = ain(a, I_WGRP)[((size_t)l * D + k) * 4 + e]; else if (e < 36) w = ain(a, I_WRT)[((size_t)l * D + k) * 32 + (e - 4)];
          const unsigned hi = cvt_pk(w, 0.f) & 0xffffu; const float lo = w - bflo(hi);
          wr[((size_t)(l * 2 + 0) * 48 + e) * 2048 + k] = (bf16)hi; wr[((size_t)(l * 2 + 1) * 48 + e) * 2048 + k] = (bf16)(cvt_pk(lo, 0.f) & 0xffffu); } }
    { bf16* lw = (bf16*)(F.ws + WS_LRUW);
      for (int idx = blockIdx.x * 512 + F.tid; idx < 2 * 2 * 2 * 8 * 128 * 128; idx += F.G * 512) {
          const int cidx = idx & 127, d = (idx >> 7) & 127, n = (idx >> 14) & 7, dir = (idx >> 17) & 1, mat = (idx >> 18) & 1, l = idx >> 19;
          const float w = ain(a, mat ? I_LWX : I_LWA)[((((size_t)l * 2 + dir) * 8 + n) * 128 + cidx) * 128 + d];
          lw[idx] = (bf16)(cvt_pk(w, 0.f) & 0xffffu); } }
}

__device__ __forceinline__ void row_split(int r, int& b, int& i) { b = r / TB; i = r - b * TB; }
__device__ __forceinline__ size_t hrow_off(int b, int i, bool& ctx) { ctx = i < CTXL; return ctx ? ((size_t)b * CTXL + i) * D : ((size_t)b * SEQ + (i - CTXL)) * D; }

__device__ __forceinline__ void norm_mod(f32x4 (&v)[8], const float* g, const float* shift, const float* scale, int lane) {
    float ss = 0.f;
#pragma unroll
    for (int j = 0; j < 8; ++j) ss += (v[j][0] * v[j][0] + v[j][1] * v[j][1]) + (v[j][2] * v[j][2] + v[j][3] * v[j][3]);
    ss = wave_sum(ss);
    const float rs = rsqrtf(ss * (1.0f / D) + EPS);
#pragma unroll
    for (int j = 0; j < 8; ++j) { const int c = (lane + 64 * j) * 4; const f32x4 gg = *(const f32x4*)(g + c), sh = *(const f32x4*)(shift + c), sc = *(const f32x4*)(scale + c);
        v[j] = v[j] * rs * gg * (sc + 1.0f) + sh; }
}

__device__ __forceinline__ void pa_norm1(Frame& F, int l) {
    phase_ids(F); l = launder_s(l); KArgs a = kargs();
    const float* hl = l == 0 ? ain(a, I_X) : aout(a); const float* hc = l == 0 ? ain(a, I_CTX) : (const float*)(F.ws + WS_HC);
    const float* mod = (const float*)(F.ws + WS_MOD) + (size_t)l * 9 * (NMOD * D);
    const float* g = ain(a, I_N1G) + (size_t)l * D; bf16* U = (bf16*)(F.ws + WS_ACT);
    for (int r = F.gw; r < ROWS; r += F.NGW) {
        int b, i; row_split(r, b, i); bool ctx; const size_t off = hrow_off(b, i, ctx);
        const f32x4* xr = (const f32x4*)((ctx ? hc : hl) + off) + F.lane;
        f32x4 v[8];
#pragma unroll
        for (int j = 0; j < 8; ++j) v[j] = xr[64 * j];
        const float* mb = mod + (size_t)(ctx ? 8 : b) * (NMOD * D);
        norm_mod(v, g, mb, mb + D, F.lane);
        v2u* o = (v2u*)(U + (size_t)r * D) + F.lane;
#pragma unroll
        for (int j = 0; j < 8; ++j) { v2u w; w.x = cvt_pk(v[j][0], v[j][1]); w.y = cvt_pk(v[j][2], v[j][3]); o[64 * j] = w; }
    }
}

__device__ __forceinline__ void pc_qk(Frame& F, int l) {
    phase_ids(F); l = launder_s(l); KArgs a = kargs();
    bf16* PROJ = (bf16*)(F.ws + WS_PROJ);
    const float* rc = (const float*)(F.ws + WS_ROPE); const float* rs = rc + 2048 * 64;
    const float* qna = ain(a, I_QNA) + l * 128; const float* kna = ain(a, I_KNA) + l * 128; const float* qnc = ain(a, I_QNC) + l * 128; const float* knc = ain(a, I_KNC) + l * 128;
    const int half = F.lane >> 5, li = F.lane & 31;
    for (int r = F.gw; r < ROWS; r += F.NGW) {
        int b, i; row_split(r, b, i); const bool lat = i >= CTXL; const int t = i - CTXL;
        bf16* prow = PROJ + (size_t)r * INC;
        f32x4 cs = {1.f, 1.f, 1.f, 1.f}, sn = {0.f, 0.f, 0.f, 0.f};
        if (lat) { const int ti = t * 64 + (li >> 4) * 32 + 4 * (li & 7); cs = *(const f32x4*)(rc + ti); sn = *(const f32x4*)(rs + ti); }
        const float sgn = (li & 8) ? 1.0f : -1.0f;
        for (int it = 0; it < 13; ++it) {
            const int hidx = 2 * it + half; int colbase; const float* g;
            if (hidx < 8) { colbase = C_AQ + hidx * 128; g = qna; } else if (hidx < 16) { colbase = C_AK + (hidx - 8) * 128; g = kna; }
            else if (hidx < 24) { colbase = C_CQ + (hidx - 16) * 128; g = qnc; } else { colbase = C_CK + (hidx - 24) * 128; g = knc; }
            v2u* p = (v2u*)(prow + colbase + 4 * li); const v2u raw = *p;
            f32x4 x = {bflo(raw.x), bfhi(raw.x), bflo(raw.y), bfhi(raw.y)};
            float ss = (x[0] * x[0] + x[1] * x[1]) + (x[2] * x[2] + x[3] * x[3]);
#pragma unroll
            for (int o = 1; o < 32; o <<= 1) ss += __shfl_xor(ss, o);
            const float rn = rsqrtf(ss * (1.0f / 128.0f) + EPS);
            const f32x4 gg = *(const f32x4*)(g + 4 * li);
            f32x4 y = x * rn * gg;
            f32x4 pr; pr[0] = __shfl_xor(y[0], 8); pr[1] = __shfl_xor(y[1], 8); pr[2] = __shfl_xor(y[2], 8); pr[3] = __shfl_xor(y[3], 8);
            y = y * cs + pr * sn * sgn;
            v2u w; w.x = cvt_pk(y[0], y[1]); w.y = cvt_pk(y[2], y[3]); *p = w;
        }
    }
}

__device__ __forceinline__ void pc_lru(Frame& F, int l) {
    phase_ids(F); l = launder_s(l); KArgs a = kargs();
    const bf16* PROJ = (const bf16*)(F.ws + WS_PROJ);
    LAS bf16* xcb = (LAS bf16*)F.ldsl;
    LAS float* xcf = (LAS float*)(F.ldsl + 8704);
    LAS float* Sa = (LAS float*)(F.ldsl + 25600);
    LAS float* Sb = (LAS float*)(F.ldsl + 58368);
    bf16* hloc = (bf16*)(F.ws + WS_BIG); bf16* acum = hloc + (size_t)2 * ROWS * 1024;
    float* cA = (float*)(F.ws + WS_CARRY); float* cH = cA + CARRY_N;
    const bf16* LW = (const bf16*)(F.ws + WS_LRUW);
    const float* convw = ain(a, I_CONVW) + (size_t)l * 4 * 1024; const float* convb = ain(a, I_CONVB) + (size_t)l * 1024;
    const int dir = F.wave >> 2, cq = F.wave & 3, l15 = F.lane & 15, l4 = F.lane >> 4;
    for (int u = blockIdx.x; u < NB * NCH * 8; u += F.G) {
        const int n = u & 7, bc = u >> 3, c = bc % NCH, b = bc / NCH;
        const int r0 = b * TB + c * 32; const int seq_lo = (c < 8) ? b * TB : b * TB + CTXL, seq_hi = (c < 8) ? b * TB + CTXL : (b + 1) * TB;
        { const int t = F.tid >> 4, ch0 = (F.tid & 15) * 8; const int chg = n * 128 + ch0;
          float acc8[8];
          { const f32x4 b0 = *(const f32x4*)(convb + chg), b1 = *(const f32x4*)(convb + chg + 4);
#pragma unroll
            for (int e = 0; e < 4; ++e) { acc8[e] = b0[e]; acc8[4 + e] = b1[e]; } }
#pragma unroll
          for (int k = 0; k < 4; ++k) { const int rr = r0 + t - 2 + k;
              if (rr >= seq_lo && rr < seq_hi) { const v4u raw = *(const v4u*)(PROJ + (size_t)rr * INC + C_BX + chg);
                  const f32x4 w0 = *(const f32x4*)(convw + k * 1024 + chg), w1 = *(const f32x4*)(convw + k * 1024 + chg + 4);
                  acc8[0] += w0[0] * bflo(raw.x); acc8[1] += w0[1] * bfhi(raw.x); acc8[2] += w0[2] * bflo(raw.y); acc8[3] += w0[3] * bfhi(raw.y);
                  acc8[4] += w1[0] * bflo(raw.z); acc8[5] += w1[1] * bfhi(raw.z); acc8[6] += w1[2] * bflo(raw.w); acc8[7] += w1[3] * bfhi(raw.w); } }
          v4u pk; pk.x = cvt_pk(acc8[0], acc8[1]); pk.y = cvt_pk(acc8[2], acc8[3]); pk.z = cvt_pk(acc8[4], acc8[5]); pk.w = cvt_pk(acc8[6], acc8[7]);
          *(LAS v4u*)(xcb + t * 136 + ch0) = pk;
          *(LAS f32x4*)(xcf + t * 132 + ch0) = (f32x4){acc8[0], acc8[1], acc8[2], acc8[3]}; *(LAS f32x4*)(xcf + t * 132 + ch0 + 4) = (f32x4){acc8[4], acc8[5], acc8[6], acc8[7]}; }
        __syncthreads();
#pragma unroll
        for (int nt = 0; nt < 2; ++nt) {
            const int ch = cq * 32 + nt * 16 + l15, chg = n * 128 + ch;
            bf16x8 Ba[4], Bx[4];
#pragma unroll
            for (int k = 0; k < 4; ++k) {
                Ba[k] = *(const bf16x8*)(LW + ((((size_t)(l * 2 + 0) * 2 + dir) * 8 + n) * 128 + ch) * 128 + k * 32 + l4 * 8);
                Bx[k] = *(const bf16x8*)(LW + ((((size_t)(l * 2 + 1) * 2 + dir) * 8 + n) * 128 + ch) * 128 + k * 32 + l4 * 8); }
            const float ba = ain(a, I_LBA)[((size_t)l * 2 + dir) * 1024 + chg], bx = ain(a, I_LBX)[((size_t)l * 2 + dir) * 1024 + chg];
            const float lamv = ain(a, I_LLAM)[((size_t)l * 2 + dir) * 1024 + chg]; const float sp = log1pf(expf(-lamv));
#pragma unroll
            for (int mt = 0; mt < 2; ++mt) {
                f32x4 ra = {0.f, 0.f, 0.f, 0.f}, rx = {0.f, 0.f, 0.f, 0.f};
#pragma unroll
                for (int k = 0; k < 4; ++k) { const bf16x8 A = *(const LAS bf16x8*)(xcb + (mt * 16 + l15) * 136 + k * 32 + l4 * 8);
                    ra = __builtin_amdgcn_mfma_f32_16x16x32_bf16(A, Ba[k], ra, 0, 0, 0); rx = __builtin_amdgcn_mfma_f32_16x16x32_bf16(A, Bx[k], rx, 0, 0, 0); }
#pragma unroll
                for (int j = 0; j < 4; ++j) { const int tt = mt * 16 + l4 * 4 + j;
                    const float rg = 1.0f / (1.0f + expf(-(ra[j] + ba))), ig = 1.0f / (1.0f + expf(-(rx[j] + bx)));
                    const float la = -8.0f * rg * sp; const float av = expf(la); const float mult = sqrtf(-expm1f(2.0f * la));
                    Sa[(dir * 32 + tt) * 128 + ch] = av; Sb[(dir * 32 + tt) * 128 + ch] = mult * ig * xcf[tt * 132 + ch]; }
            }
        }
        __syncthreads();
        if (F.tid < 256) { const int d2 = F.tid >> 7, ch = F.tid & 127; float h = 0.f, A = 1.f;
            bf16* hp = hloc + ((size_t)d2 * ROWS + r0) * 1024 + n * 128 + ch; bf16* ap = acum + ((size_t)d2 * ROWS + r0) * 1024 + n * 128 + ch;
            for (int s = 0; s < 32; ++s) { const int t = d2 ? 31 - s : s; const float av = Sa[(d2 * 32 + t) * 128 + ch], bv = Sb[(d2 * 32 + t) * 128 + ch];
                h = av * h + bv; A *= av; hp[(size_t)t * 1024] = (bf16)(cvt_pk(h, 0.f) & 0xffffu); ap[(size_t)t * 1024] = (bf16)(cvt_pk(A, 0.f) & 0xffffu); }
            const size_t ci = (((size_t)d2 * NB + b) * NCH + c) * 1024 + n * 128 + ch; cA[ci] = A; cH[ci] = h; }
        __syncthreads();
    }
}

__device__ __forceinline__ void pd_chain(Frame& F) {
    phase_ids(F);
    const float* cA = (const float*)(F.ws + WS_CARRY); const float* cH = cA + CARRY_N; float* Hin = (float*)(F.ws + WS_CARRY) + 2 * CARRY_N;
    for (int blk = blockIdx.x; blk < 32; blk += F.G) {
        const int idx = blk * 512 + F.tid, dir = idx >> 13, b = (idx >> 10) & 7, ch = idx & 1023;
        const size_t base = (((size_t)dir * NB + b) * NCH) * 1024 + ch; float H = 0.f;
        if (dir == 0) { for (int c = 0; c < NCH; ++c) { Hin[base + (size_t)c * 1024] = H; H = cA[base + (size_t)c * 1024] * H + cH[base + (size_t)c * 1024]; } }
        else { for (int c = 7; c >= 0; --c) { Hin[base + (size_t)c * 1024] = H; H = cA[base + (size_t)c * 1024] * H + cH[base + (size_t)c * 1024]; }
               for (int c = NCH - 1; c >= 8; --c) { Hin[base + (size_t)c * 1024] = H; H = cA[base + (size_t)c * 1024] * H + cH[base + (size_t)c * 1024]; } }
    }
}
__device__ __forceinline__ void pd_attn(Frame& F) {
    phase_ids(F);
    const bf16* PROJ = (const bf16*)(F.ws + WS_PROJ); bf16* OA = (bf16*)(F.ws + WS_OA); bf16* YC = (bf16*)(F.ws + WS_YC);
    constexpr int NLAT = NB * 8 * 24, NCTX = NB * 24;
    for (int u = blockIdx.x; u < NLAT + NCTX; u += F.G) {
        int hh, b, q0row, seq;
        if (u < NLAT) { const int qb = u & 7; hh = (u >> 3) % 24; b = u / 192; q0row = b * TB + CTXL + qb * 256; seq = TB; }
        else { const int v = u - NLAT; hh = v % 24; b = v / 24; q0row = b * TB; seq = CTXL; }
        const bf16* kb = PROJ + (size_t)b * TB * INC; const bf16* qp = PROJ + (size_t)q0row * INC;
        const bf16 *Q, *K, *V; bf16* O; int ldo;
        if (hh < 16) { const int m = hh >> 1, vh = hh & 1; Q = qp + C_AQ + m * 128; K = kb + C_AK + m * 128; V = kb + C_AV + (m >> 1) * 256 + vh * 128; O = OA + (size_t)q0row * D + m * 256 + vh * 128; ldo = D; }
        else { const int hq = hh - 16; Q = qp + C_CQ + hq * 128; K = kb + C_CK + (hq >> 2) * 128; V = kb + C_CV + (hq >> 2) * 128; O = YC + (size_t)q0row * 1024 + hq * 128; ldo = 1024; }
        att::attn_dense_body(Q, K, V, O, ldo, seq, (char*)F.lds);
        __syncthreads();
    }
}

__device__ __forceinline__ void pe_combine(Frame& F, int l) {
    phase_ids(F); l = launder_s(l); KArgs a = kargs();
    bf16* OA = (bf16*)(F.ws + WS_OA); bf16* YB = (bf16*)(F.ws + WS_YB); const bf16* PROJ = (const bf16*)(F.ws + WS_PROJ);
    const bf16* hloc = (const bf16*)(F.ws + WS_BIG); const bf16* acum = hloc + (size_t)2 * ROWS * 1024;
    const float* Hin = (const float*)(F.ws + WS_CARRY) + 2 * CARRY_N;
    const float lam = ((const float*)(F.ws + WS_MISC + MISC_LAM))[l]; const float omli = 1.0f - (l == 0 ? 0.2f : 0.3555090676f);
    const f32x4 sg = *(const f32x4*)(ain(a, I_SUBN) + (size_t)l * 256 + 4 * F.lane);
    for (int r = F.gw; r < ROWS; r += F.NGW) {
        bf16* oa = OA + (size_t)r * D;
        v2u raw[8];
#pragma unroll
        for (int m = 0; m < 8; ++m) raw[m] = *(const v2u*)(oa + m * 256 + 4 * F.lane);
#pragma unroll
        for (int h = 0; h < 4; ++h) { const v2u p = raw[2 * h], q = raw[2 * h + 1];
            f32x4 o = {bflo(p.x) - lam * bflo(q.x), bfhi(p.x) - lam * bfhi(q.x), bflo(p.y) - lam * bflo(q.y), bfhi(p.y) - lam * bfhi(q.y)};
            float ss = (o[0] * o[0] + o[1] * o[1]) + (o[2] * o[2] + o[3] * o[3]); ss = wave_sum(ss);
            const float rn = rsqrtf(ss * (1.0f / 256.0f) + EPS) * omli;
            o = o * rn * sg; v2u w; w.x = cvt_pk(o[0], o[1]); w.y = cvt_pk(o[2], o[3]); *(v2u*)(oa + h * 256 + 4 * F.lane) = w; }
        int b, i; row_split(r, b, i); const int c = i >> 5;
        const size_t hf = ((size_t)(0 * NB + b) * NCH + c) * 1024, hb = ((size_t)(1 * NB + b) * NCH + c) * 1024;
#pragma unroll
        for (int hv = 0; hv < 2; ++hv) { const int ch = F.lane * 16 + hv * 8;
            const v4u lf = *(const v4u*)(hloc + (size_t)r * 1024 + ch), af = *(const v4u*)(acum + (size_t)r * 1024 + ch);
            const v4u lb = *(const v4u*)(hloc + ((size_t)ROWS + r) * 1024 + ch), ab = *(const v4u*)(acum + ((size_t)ROWS + r) * 1024 + ch);
            const v4u by = *(const v4u*)(PROJ + (size_t)r * INC + C_BY + ch);
            const f32x4 Hf0 = *(const f32x4*)(Hin + hf + ch), Hf1 = *(const f32x4*)(Hin + hf + ch + 4), Hb0 = *(const f32x4*)(Hin + hb + ch), Hb1 = *(const f32x4*)(Hin + hb + ch + 4);
            float y[8];
#define FIX(e, LF, AF, LB, AB, BY, HF, HB, GET) { const float hsum = GET(LF) + GET(AF) * HF + GET(LB) + GET(AB) * HB; const float x = GET(BY); \
                const float u2 = 0.7978845608f * (x + 0.044715f * x * x * x); const float th = 1.0f - 2.0f / (1.0f + __expf(2.0f * u2)); y[e] = hsum * 0.5f * x * (1.0f + th); }
            FIX(0, lf.x, af.x, lb.x, ab.x, by.x, Hf0[0], Hb0[0], bflo) FIX(1, lf.x, af.x, lb.x, ab.x, by.x, Hf0[1], Hb0[1], bfhi)
            FIX(2, lf.y, af.y, lb.y, ab.y, by.y, Hf0[2], Hb0[2], bflo) FIX(3, lf.y, af.y, lb.y, ab.y, by.y, Hf0[3], Hb0[3], bfhi)
            FIX(4, lf.z, af.z, lb.z, ab.z, by.z, Hf1[0], Hb1[0], bflo) FIX(5, lf.z, af.z, lb.z, ab.z, by.z, Hf1[1], Hb1[1], bfhi)
            FIX(6, lf.w, af.w, lb.w, ab.w, by.w, Hf1[2], Hb1[2], bflo) FIX(7, lf.w, af.w, lb.w, ab.w, by.w, Hf1[3], Hb1[3], bfhi)
#undef FIX
            v4u w; w.x = cvt_pk(y[0], y[1]); w.y = cvt_pk(y[2], y[3]); w.z = cvt_pk(y[4], y[5]); w.w = cvt_pk(y[6], y[7]);
            *(v4u*)(YB + (size_t)r * 1024 + ch) = w; }
    }
}

__device__ __forceinline__ void ph_norm2_route(Frame& F, int l) {
    phase_ids(F); l = launder_s(l); KArgs a = kargs();
    const float* hl = aout(a); const float* hc = (const float*)(F.ws + WS_HC);
    const float* mod = (const float*)(F.ws + WS_MOD) + (size_t)l * 9 * (NMOD * D);
    const float* g = ain(a, I_N2G) + (size_t)l * D; bf16* V = (bf16*)(F.ws + WS_ACT);
    LAS bf16* Thi = (LAS bf16*)F.ldsl; LAS bf16* Tlo = (LAS bf16*)(F.ldsl + 65792);
    LAS float* red = (LAS float*)F.ldsl;
    LAS float* logit = (LAS float*)(F.ldsl + 24576);
    const bf16* wr = (const bf16*)(F.ws + WS_MISC + MISC_WR) + (size_t)l * 2 * 48 * 2048;
    unsigned* cnt = (unsigned*)(F.ws + WS_CTL) + CW_CNT + 64 * l;
    int* tok_e = (int*)(F.ws + WS_ROUTE + RT_E); int* tok_pos = (int*)(F.ws + WS_ROUTE + RT_POS); float* tok_p = (float*)(F.ws + WS_ROUTE + RT_P);
    const int l15 = F.lane & 15, l4 = F.lane >> 4;
    for (int blk = blockIdx.x; blk < ROWS / 16; blk += F.G) {
#pragma unroll 1
        for (int rr = 0; rr < 2; ++rr) { const int lr = F.wave * 2 + rr, r = blk * 16 + lr;
            int b, i; row_split(r, b, i); bool ctx; const size_t off = hrow_off(b, i, ctx);
            const f32x4* xr = (const f32x4*)((ctx ? hc : hl) + off) + F.lane;
            f32x4 v[8];
#pragma unroll
            for (int j = 0; j < 8; ++j) v[j] = xr[64 * j];
            const float* mb = mod + (size_t)(ctx ? 8 : b) * (NMOD * D);
            norm_mod(v, g, mb + 3 * D, mb + 4 * D, F.lane);
            v2u* o = (v2u*)(V + (size_t)r * D) + F.lane;
#pragma unroll
            for (int j = 0; j < 8; ++j) { v2u w; w.x = cvt_pk(v[j][0], v[j][1]); w.y = cvt_pk(v[j][2], v[j][3]); o[64 * j] = w;
                v2u wl; wl.x = cvt_pk(v[j][0] - bflo(w.x), v[j][1] - bfhi(w.x)); wl.y = cvt_pk(v[j][2] - bflo(w.y), v[j][3] - bfhi(w.y));
                *(LAS v2u*)(Thi + lr * 2056 + (F.lane + 64 * j) * 4) = w; *(LAS v2u*)(Tlo + lr * 2056 + (F.lane + 64 * j) * 4) = wl; } }
        __syncthreads();
        f32x4 acc[3];
#pragma unroll
        for (int ct = 0; ct < 3; ++ct) acc[ct] = (f32x4){0.f, 0.f, 0.f, 0.f};
#pragma unroll 2
        for (int ks = 0; ks < 8; ++ks) { const int k0 = (F.wave * 8 + ks) * 32 + l4 * 8;
            const bf16x8 Ah = *(const LAS bf16x8*)(Thi + l15 * 2056 + k0), Al = *(const LAS bf16x8*)(Tlo + l15 * 2056 + k0);
#pragma unroll
            for (int ct = 0; ct < 3; ++ct) { const bf16x8 Bh = *(const bf16x8*)(wr + (size_t)(ct * 16 + l15) * 2048 + k0), Bl = *(const bf16x8*)(wr + (size_t)(48 + ct * 16 + l15) * 2048 + k0);
                acc[ct] = __builtin_amdgcn_mfma_f32_16x16x32_bf16(Ah, Bh, acc[ct], 0, 0, 0);
                acc[ct] = __builtin_amdgcn_mfma_f32_16x16x32_bf16(Ah, Bl, acc[ct], 0, 0, 0);
                acc[ct] = __builtin_amdgcn_mfma_f32_16x16x32_bf16(Al, Bh, acc[ct], 0, 0, 0); } }
        __syncthreads();
#pragma unroll
        for (int ct = 0; ct < 3; ++ct)
#pragma unroll
            for (int j = 0; j < 4; ++j) red[(F.wave * 16 + l4 * 4 + j) * 48 + ct * 16 + l15] = acc[ct][j];
        __syncthreads();
        for (int o = F.tid; o < 16 * 36; o += 512) { const int row = o / 36, e = o % 36; float s = 0.f;
#pragma unroll
            for (int w = 0; w < 8; ++w) s += red[(w * 16 + row) * 48 + e];
            s += e < 4 ? ain(a, I_BGRP)[l * 4 + e] : ain(a, I_BRT)[l * 32 + (e - 4)];
            logit[o] = s; }
        __syncthreads();
        if (F.tid < 16) { const LAS float* lg = logit + F.tid * 36; const int r = blk * 16 + F.tid;
            int gi = 0; float gm = lg[0];
            for (int e = 1; e < 4; ++e) { const float v = lg[e]; if (v > gm) { gm = v; gi = e; } }
            float gs = 0.f; for (int e = 0; e < 4; ++e) gs += expf(lg[e] - gm);
            const float gw = 1.0f / gs;
            const LAS float* el = lg + 4 + gi * 8;
            int i1 = 0; float v1 = el[0];
            for (int e = 1; e < 8; ++e) { const float v = el[e]; if (v > v1) { v1 = v; i1 = e; } }
            int i2 = -1; float v2 = -3.0e38f;
            for (int e = 0; e < 8; ++e) { const float v = el[e]; if (e != i1 && v > v2) { v2 = v; i2 = e; } }
            const float p1 = 1.0f / (1.0f + expf(v2 - v1)); const float p2 = 1.0f - p1;
            const int e1 = gi * 8 + i1, e2 = gi * 8 + i2;
            const unsigned pos1 = atomicAdd(&cnt[e1], 1u), pos2 = atomicAdd(&cnt[e2], 1u);
            tok_e[2 * r] = e1; tok_e[2 * r + 1] = e2; tok_pos[2 * r] = (int)pos1; tok_pos[2 * r + 1] = (int)pos2; tok_p[2 * r] = p1 * gw; tok_p[2 * r + 1] = p2 * gw; }
        __syncthreads();
    }
}

__device__ __forceinline__ void pi_scatter(Frame& F, int l) {
    phase_ids(F); l = launder_s(l);
    const unsigned* cnt = (const unsigned*)(F.ws + WS_CTL) + CW_CNT + 64 * l;
    LAS int* base = (LAS int*)F.ldsl;
    if (F.tid == 0) { int run = 0; for (int e = 0; e < NE; ++e) { base[e] = run; run += (int)((__hip_atomic_load(&cnt[e], __ATOMIC_RELAXED, __HIP_MEMORY_SCOPE_AGENT) + 255u) & ~255u); } base[NE] = run; }
    __syncthreads();
    const int* tok_e = (const int*)(F.ws + WS_ROUTE + RT_E); const int* tok_pos = (const int*)(F.ws + WS_ROUTE + RT_POS); int* tok_dest = (int*)(F.ws + WS_ROUTE + RT_DEST);
    const bf16* V = (const bf16*)(F.ws + WS_ACT); bf16* VS = (bf16*)(F.ws + WS_BIG);
    for (int s = F.gw; s < 2 * ROWS; s += F.NGW) { const int r = s >> 1; const int e = tok_e[s], pos = tok_pos[s]; const int dest = base[e] + pos;
        if (F.lane == 0) tok_dest[s] = dest;
        const v4u* src = (const v4u*)(V + (size_t)r * D) + F.lane; v4u* dst = (v4u*)(VS + (size_t)dest * D) + F.lane;
#pragma unroll
        for (int j = 0; j < 4; ++j) dst[64 * j] = src[64 * j]; }
    if (blockIdx.x == 0 && F.tid == 0) { int* tt = (int*)(F.ws + WS_MISC + MISC_TILE); int nt = 0;
        for (int e = 0; e < NE; ++e) { const int n = (base[e + 1] - base[e]) >> 8; for (int t = 0; t < n; ++t) tt[4 + nt++] = e; }
        tt[0] = nt; }
    __syncthreads();
}

__device__ __forceinline__ void pl_moe_combine(Frame& F, int l) {
    phase_ids(F); l = launder_s(l); KArgs a = kargs();
    float* hl = aout(a); float* hc = (float*)(F.ws + WS_HC);
    const float* mod = (const float*)(F.ws + WS_MOD) + (size_t)l * 9 * (NMOD * D);
    const bf16* YS = (const bf16*)(F.ws + WS_BIG);
    const int* tok_dest = (const int*)(F.ws + WS_ROUTE + RT_DEST); const float* tok_p = (const float*)(F.ws + WS_ROUTE + RT_P);
    for (int r = F.gw; r < ROWS; r += F.NGW) {
        int b, i; row_split(r, b, i); bool ctx; const size_t off = hrow_off(b, i, ctx);
        float* hp = (ctx ? hc : hl) + off; const float* mg = mod + (size_t)(ctx ? 8 : b) * (NMOD * D) + 5 * D;
        const int d0 = tok_dest[2 * r], d1 = tok_dest[2 * r + 1]; const float p0 = tok_p[2 * r], p1 = tok_p[2 * r + 1];
        const v2u* y0 = (const v2u*)(YS + (size_t)d0 * D) + F.lane; const v2u* y1 = (const v2u*)(YS + (size_t)d1 * D) + F.lane;
#pragma unroll
        for (int j = 0; j < 8; ++j) { const int c = (F.lane + 64 * j) * 4; const v2u u0 = y0[64 * j], u1 = y1[64 * j];
            const f32x4 g = *(const f32x4*)(mg + c); f32x4 h = *(const f32x4*)(hp + c);
            h[0] += g[0] * (p0 * bflo(u0.x) + p1 * bflo(u1.x)); h[1] += g[1] * (p0 * bfhi(u0.x) + p1 * bfhi(u1.x));
            h[2] += g[2] * (p0 * bflo(u0.y) + p1 * bflo(u1.y)); h[3] += g[3] * (p0 * bfhi(u0.y) + p1 * bfhi(u1.y));
            *(f32x4*)(hp + c) = h; }
    }
}

constexpr int PH_PER_LAYER = 12, N_PHASES = 1 + 2 * PH_PER_LAYER;
#ifndef PHMASK
#define PHMASK 0xffffffffu
#endif
#define EN(j) ((PHMASK >> (j)) & 1u)
#define IN(k) (lo <= (k) && (k) < hi)
#define SEAM(k) do { if (IN(k) && IN((k) + 1)) xcd_barrier(bar); } while (0)
template <int l> __device__ __forceinline__ void layer_phases(Frame& F, const int lo, const int hi, const XcdBarrier& bar) {
        constexpr int p = 1 + l * PH_PER_LAYER;
        if (EN(1) && IN(p + 0)) { pa_norm1(F, l); if (l > 0) { __syncthreads(); conv_weights(F, l); } }
        SEAM(p + 0);
        if (EN(2) && IN(p + 1)) { phase_ids(F); unsigned char* ws = F.ws;
            pg8::Gemm g{(const bf16*)(ws + WS_ACT), (const bf16*)(ws + WS_WIN), D, D, D}; pg8::StaticOrder S; S.init(ROWS, INC, F.G, (int)blockIdx.x);
            pg8::EpiBf16 E{(bf16*)(ws + WS_PROJ), INC, 0xffff}; pg8::gemm_phase(F.ldsl, g, S, E); }
        SEAM(p + 1);
        if (EN(3) && IN(p + 2)) { pc_qk(F, l); __syncthreads(); pc_lru(F, l); }
        SEAM(p + 2);
        if (EN(4) && IN(p + 3)) { pd_chain(F); pd_attn(F); }
        SEAM(p + 3);
        if (EN(5) && IN(p + 4)) { pe_combine(F, l); }
        SEAM(p + 4);
        if (EN(6) && IN(p + 5)) {
            { phase_ids(F); unsigned char* ws = F.ws; KArgs a = kargs(); const int ll = launder_s(l); pg8::StaticOrder S; S.init(ROWS, D, F.G, (int)blockIdx.x);
              pg8::Gemm g{(const bf16*)(ws + WS_OA), (const bf16*)(ws + WS_WBR), D, 1024, 1024};
              pg8::EpiBranch<0> E{(float*)(ws + WS_BIG), (bf16*)(ws + WS_ACT), (const bf16*)(ws + WS_PROJ), ain(a, I_BGATE) + (size_t)ll * 3 * D, C_G}; pg8::gemm_phase(F.ldsl, g, S, E); }
            { phase_ids(F); unsigned char* ws = F.ws; KArgs a = kargs(); const int ll = launder_s(l); pg8::StaticOrder S; S.init(ROWS, D, F.G, (int)blockIdx.x);
              pg8::Gemm g{(const bf16*)(ws + WS_YB), (const bf16*)(ws + WS_WBR) + (size_t)D * 1024, 1024, 1024, 1024};
              pg8::EpiBranch<1> E{(float*)(ws + WS_BIG), (bf16*)(ws + WS_ACT), (const bf16*)(ws + WS_PROJ), ain(a, I_BGATE) + (size_t)ll * 3 * D + D, C_G + D}; pg8::gemm_phase(F.ldsl, g, S, E); }
            { phase_ids(F); unsigned char* ws = F.ws; KArgs a = kargs(); const int ll = launder_s(l); pg8::StaticOrder S; S.init(ROWS, D, F.G, (int)blockIdx.x);
              pg8::Gemm g{(const bf16*)(ws + WS_YC), (const bf16*)(ws + WS_WBR) + (size_t)2 * D * 1024, 1024, 1024, 1024};
              pg8::EpiBranch<2> E{(float*)(ws + WS_BIG), (bf16*)(ws + WS_ACT), (const bf16*)(ws + WS_PROJ), ain(a, I_BGATE) + (size_t)ll * 3 * D + 2 * D, C_G + 2 * D}; pg8::gemm_phase(F.ldsl, g, S, E); }
        }
        SEAM(p + 5);
        if (EN(7) && IN(p + 6)) { phase_ids(F); unsigned char* ws = F.ws; KArgs a = kargs(); const int ll = launder_s(l);
            pg8::Gemm g{(const bf16*)(ws + WS_ACT), (const bf16*)(ws + WS_WOUT), D, D, D}; pg8::StaticOrder S; S.init(ROWS, D, F.G, (int)blockIdx.x);
            pg8::EpiWout E{ll == 0 ? ain(a, I_X) : (const float*)aout(a), ll == 0 ? ain(a, I_CTX) : (const float*)(ws + WS_HC), aout(a), (float*)(ws + WS_HC), (const float*)(ws + WS_MOD) + (size_t)ll * 9 * (NMOD * D)};
            pg8::gemm_phase(F.ldsl, g, S, E); }
        SEAM(p + 6);
        if (EN(8) && IN(p + 7)) { ph_norm2_route(F, l); }
        SEAM(p + 7);
        if (EN(9) && IN(p + 8)) { pi_scatter(F, l); }
        SEAM(p + 8);
        if (EN(10) && IN(p + 9)) { phase_ids(F); unsigned char* ws = F.ws; const int* tt = (const int*)(ws + WS_MISC + MISC_TILE);
            pg8::Gemm g{(const bf16*)(ws + WS_BIG), (const bf16*)(ws + WS_W13), D, D, D}; pg8::MoeOrder S{tt + 4, tt[0], 4, F.G, (int)blockIdx.x};
            pg8::EpiUp E{(bf16*)(ws + WS_OA)}; pg8::gemm_phase(F.ldsl, g, S, E); }
        SEAM(p + 9);
        if (EN(11) && IN(p + 10)) { phase_ids(F); unsigned char* ws = F.ws; const int* tt = (const int*)(ws + WS_MISC + MISC_TILE);
            pg8::Gemm g{(const bf16*)(ws + WS_OA), (const bf16*)(ws + WS_W2), DE, DE, DE}; pg8::MoeOrder S{tt + 4, tt[0], 8, F.G, (int)blockIdx.x};
            pg8::EpiBf16 E{(bf16*)(ws + WS_BIG), D, 7}; pg8::gemm_phase(F.ldsl, g, S, E); }
        SEAM(p + 10);
        if (EN(12) && IN(p + 11)) { pl_moe_combine(F, l); }
        SEAM(p + 11);
    }
__global__ void __launch_bounds__(512, 2) mega_fwd(Args args) {
    extern __shared__ __attribute__((aligned(16))) unsigned char lds[];
    Frame F;
    F.lds0 = lds; F.lds = lds; F.ldsl = (LAS unsigned char*)lds; F.ws = args.ws;
    F.tid = threadIdx.x; F.lane = F.tid & 63; F.wave = __builtin_amdgcn_readfirstlane(F.tid >> 6);
    F.G = gridDim.x; F.gw = blockIdx.x * 8 + F.wave; F.NGW = F.G * 8;
    volatile LAS unsigned* misc = (volatile LAS unsigned*)(F.ldsl + LDS_MISC_OFF);
    if (F.tid < 4) misc[F.tid] = 0u;
    __syncthreads();
    const int lo = args.ph_lo, hi = args.ph_hi;
    XcdBarrier bar; bar.bar = (unsigned*)(args.ws + WS_CTL) + CW_BAR; bar.x = 0; bar.st = misc;
    if (hi - lo > 1) bar = xcd_barrier_post((unsigned*)(args.ws + WS_CTL) + CW_BAR, misc);
    if (EN(0) && IN(0)) { p0_misc(F); __syncthreads(); conv_weights(F, 0); }
    SEAM(0);
    layer_phases<0>(F, lo, hi, bar);
    layer_phases<1>(F, lo, hi, bar);
#undef IN
#undef SEAM
}

#ifndef MK_SINGLE
#define MK_SINGLE 1
#endif
extern "C" void kernel_launch(void* const* d_in, const int* in_sizes, int n_in, void* d_out, int out_size, void* d_ws, size_t ws_size, hipStream_t stream) {
    static int grid = 0;
    if (grid == 0) {
        if (n_in != 34 || out_size != NB * SEQ * D || ws_size < WS_END) { fprintf(stderr, "kernel_launch: unexpected shapes (n_in %d out %d ws %zu, need ws >= %zu)\n", n_in, out_size, ws_size, (size_t)WS_END); grid = -1; return; }
        int dev = 0, cus = 0, per_cu = 0;
        if (hipGetDevice(&dev) != hipSuccess || hipDeviceGetAttribute(&cus, hipDeviceAttributeMultiprocessorCount, dev) != hipSuccess) { grid = -1; return; }
        if (hipFuncSetAttribute((const void*)mega_fwd, hipFuncAttributeMaxDynamicSharedMemorySize, LDS_BYTES) != hipSuccess) { fprintf(stderr, "kernel_launch: hipFuncSetAttribute failed\n"); grid = -1; return; }
        if (hipOccupancyMaxActiveBlocksPerMultiprocessor(&per_cu, (const void*)mega_fwd, 512, LDS_BYTES) != hipSuccess || per_cu < 1) fprintf(stderr, "kernel_launch: occupancy query says %d\n", per_cu);
        (void)hipGetLastError();
        grid = cus;
    }
    if (grid < 0) return;
    (void)hipMemsetAsync((char*)d_ws + WS_CTL, 0, CTL_ZERO_BYTES, stream);
    Args a{};
    for (int i = 0; i < 34; ++i) a.in[i] = (const float*)d_in[i];
    a.out = (float*)d_out; a.ws = (unsigned char*)d_ws;
#if MK_SINGLE
    a.ph_lo = 0; a.ph_hi = N_PHASES;
    hipLaunchKernelGGL(mega_fwd, dim3(grid), dim3(512), LDS_BYTES, stream, a);
#else
    for (int p = 0; p < N_PHASES; ++p) { a.ph_lo = p; a.ph_hi = p + 1; hipLaunchKernelGGL(mega_fwd, dim3(grid), dim3(512), LDS_BYTES, stream, a); }
#endif
    const hipError_t le = hipPeekAtLastError();
    if (le != hipSuccess) fprintf(stderr, "kernel_launch: launch failed: %s\n", hipGetErrorName(le));
}
```

```cpp
#include <hip/hip_runtime.h>
#include <cstdio>
#include <cstdint>

#define GAS __attribute__((address_space(1)))
#define LAS __attribute__((address_space(3)))
typedef unsigned short bf16;
typedef unsigned v4u __attribute__((ext_vector_type(4)));
typedef unsigned v2u __attribute__((ext_vector_type(2)));
typedef float f32x4 __attribute__((ext_vector_type(4)));
typedef float f32x2 __attribute__((ext_vector_type(2)));
typedef short bf16x8 __attribute__((ext_vector_type(8)));
#define LDS_WAIT() asm volatile("s_waitcnt lgkmcnt(0)" ::: "memory")
#define VM_WAIT() asm volatile("s_waitcnt vmcnt(0)" ::: "memory")

constexpr int D = 2048, NB = 8, SEQ = 2048, CTXL = 256, TB = SEQ + CTXL, ROWS = NB * TB;
constexpr int INC = 12800;
constexpr int C_AQ = 0, C_AK = 1024, C_AV = 2048, C_BX = 3072, C_BY = 4096, C_CQ = 5120, C_CK = 6144, C_CV = 6400, C_G = 6656;
constexpr int NE = 32, DE = 512, NMOD = 6;
constexpr int MS = 45056;
constexpr int NCH = TB / 32;
constexpr float EPS = 1e-6f;

constexpr size_t MiB = 1u << 20;
constexpr size_t WS_CTL = 0, CTL_ZERO_BYTES = 1 * MiB;
constexpr size_t WS_MOD = 1 * MiB;
constexpr size_t WS_ROPE = 2 * MiB;
constexpr size_t WS_MISC = 3 * MiB;
constexpr size_t WS_LRUW = 4 * MiB;
constexpr size_t WS_ROUTE = 6 * MiB;
constexpr size_t WS_CARRY = 8 * MiB;
constexpr size_t WS_WIN = 24 * MiB;
constexpr size_t WS_WBR = 74 * MiB;
constexpr size_t WS_WOUT = 86 * MiB;
constexpr size_t WS_W13 = 94 * MiB;
constexpr size_t WS_W2 = 222 * MiB;
constexpr size_t WS_HC = 286 * MiB;
constexpr size_t WS_ACT = 302 * MiB;
constexpr size_t WS_PROJ = 374 * MiB;
constexpr size_t WS_BIG = 824 * MiB;
constexpr size_t WS_OA = 1000 * MiB;
constexpr size_t WS_YA = 1072 * MiB;
constexpr size_t WS_YB = 1108 * MiB;
constexpr size_t WS_YC = 1144 * MiB;
constexpr size_t WS_END = 1180 * MiB;
constexpr int CW_BAR = 4096;
constexpr int CW_CNT = 8192;
constexpr size_t MISC_LAM = 0;
constexpr size_t MISC_TILE = 1024;
constexpr size_t MISC_WR = 4096;
constexpr size_t RT_E = 0, RT_POS = 256 * 1024, RT_P = 512 * 1024, RT_DEST = 768 * 1024;
constexpr size_t CARRY_N = (size_t)2 * NB * NCH * 1024;
constexpr int LDS_BYTES = 147456;
constexpr int LDS_MISC_OFF = 135168;

__device__ __forceinline__ float bf2f(unsigned short b) { return __uint_as_float(((unsigned)b) << 16); }
__device__ __forceinline__ float bflo(unsigned u) { return __uint_as_float(u << 16); }
__device__ __forceinline__ float bfhi(unsigned u) { return __uint_as_float(u & 0xffff0000u); }
__device__ __forceinline__ unsigned cvt_pk(float lo, float hi) { unsigned r; asm volatile("v_cvt_pk_bf16_f32 %0, %1, %2" : "=v"(r) : "v"(lo), "v"(hi)); return r; }
__device__ __forceinline__ float wave_sum(float v) {
#pragma unroll
    for (int o = 1; o < 64; o <<= 1) v += __shfl_xor(v, o);
    return v;
}
__device__ __forceinline__ float sigmoidf_(float x) { return 1.0f / (1.0f + __expf(-x)); }

namespace pg8 {
constexpr int BM = 256, BK = 64, HALF = 128, HTB = HALF * BK * 2, STAGE_BYTES = 8 * HTB, NXCD = 8, WGM = 8;
__host__ __device__ __forceinline__ int lds_byte(int r, int c) { const int st = (r >> 4) * 2 + (c >> 5), rr = r & 15, cc = c & 31, ob = rr * 64 + cc * 2; return st * 1024 + (ob ^ (((ob >> 9) & 1) << 5)); }
__host__ __device__ __forceinline__ void stage_rc(int b, int& R, int& C) { const int st = b / 1024, sb = b % 1024, swz = sb ^ (((sb >> 9) & 1) << 5); R = (st >> 1) * 16 + swz / 64; C = (st & 1) * 32 + (swz % 64) / 2; }
__host__ __device__ __forceinline__ int perm32(int rho) { const int n = rho >> 4, i = rho & 15; return 8 * (i >> 2) + 4 * n + (i & 3); }
struct Unit { int pm, pn, fl; };
struct GB { const char* A; const char* B; size_t tA, tB; };
__device__ __forceinline__ GB make_gb(const bf16* A, int lda, const bf16* B, int ldb) { GB g; g.A = (const char*)A; g.B = (const char*)B; g.tA = (size_t)BM * lda * 2; g.tB = (size_t)BM * ldb * 2; return g; }
__device__ __forceinline__ void static_tile(int nM, int nN, int L, int& pm, int& pn) {
    const int nwg = nM * nN; int wgid = L; { const int q = nwg / NXCD, r = nwg % NXCD, xcd = wgid % NXCD, off = wgid / NXCD; wgid = (xcd < r ? xcd * (q + 1) : r * (q + 1) + (xcd - r) * q) + off; }
    const int nig = WGM * nN, gid = wgid / nig, fm = gid * WGM, gsz = (nM - fm) < WGM ? (nM - fm) : WGM;
    pm = fm + ((wgid % nig) % gsz); pn = (wgid % nig) / gsz;
}
__device__ __forceinline__ int lat_panel(int pl) { return (pl >> 3) * 9 + 1 + (pl & 7); }
struct StaticOrder {
    GB gb; int nM, nN, G, c, lat;
    __device__ __forceinline__ bool next(int i, Unit& u) const {
        const long L = (long)i * G + c; if (L >= (long)nM * nN) return false;
        int pm, pn; static_tile(nM, nN, (int)L, pm, pn); u.pm = lat ? lat_panel(pm) : pm; u.pn = pn; u.fl = 0; return true;
    }
    __device__ __forceinline__ const char* a_base(const Unit& u) const { return gb.A + (size_t)u.pm * gb.tA; }
    __device__ __forceinline__ const char* b_base(const Unit& u) const { return gb.B + (size_t)u.pn * gb.tB; }
    __device__ __forceinline__ bool zero_after(const Unit&) const { return true; }
};
struct Gemm1Order {
    GB gb; int G, c, l1;
    __device__ __forceinline__ bool next(int i, Unit& u) const {
        const long L = (long)i * G + c; int pm, pn; u.fl = 0;
        if (!l1) { if (L >= 72 * 50) return false; static_tile(72, 50, (int)L, pm, pn); }
        else if (L < 64 * 50) { static_tile(64, 50, (int)L, pm, pn); pm = lat_panel(pm); }
        else { const int q = (int)L - 64 * 50; if (q >= 8 * 14) return false; const int k = q % 14; pm = (q / 14) * 9; pn = k < 12 ? 4 + k : 12 + k; }
        u.pm = pm; u.pn = pn; return true;
    }
    __device__ __forceinline__ const char* a_base(const Unit& u) const { return gb.A + (size_t)u.pm * gb.tA; }
    __device__ __forceinline__ const char* b_base(const Unit& u) const { return gb.B + (size_t)u.pn * gb.tB; }
    __device__ __forceinline__ bool zero_after(const Unit&) const { return true; }
};
struct BranchOrder {
    StaticOrder so; size_t astride;
    __device__ __forceinline__ bool next(int i, Unit& u) const { if (!so.next(i / 3, u)) return false; u.fl = i % 3; return true; }
    __device__ __forceinline__ const char* a_base(const Unit& u) const { return so.gb.A + (size_t)u.fl * astride + (size_t)u.pm * so.gb.tA; }
    __device__ __forceinline__ const char* b_base(const Unit& u) const { return so.gb.B + (size_t)u.fl * ((size_t)D * 1024 * 2) + (size_t)u.pn * so.gb.tB; }
    __device__ __forceinline__ bool zero_after(const Unit& u) const { return u.fl == 2; }
};
struct MoeOrder {
    GB gb; const int* tile_e; int ntiles, NT, G, c;
    __device__ __forceinline__ bool next(int i, Unit& u) const {
        const long L = (long)i * G + c; if (L >= (long)ntiles * NT) return false;
        const int mt = (int)(L / NT), pnl = (int)(L % NT);
        u.pm = mt; u.pn = tile_e[mt] * NT + pnl; u.fl = 0; return true;
    }
    __device__ __forceinline__ const char* a_base(const Unit& u) const { return gb.A + (size_t)u.pm * gb.tA; }
    __device__ __forceinline__ const char* b_base(const Unit& u) const { return gb.B + (size_t)u.pn * gb.tB; }
    __device__ __forceinline__ bool zero_after(const Unit&) const { return true; }
};
template <bool GATE> struct EpiBf16T {
    static constexpr bool PERM = true;
    bf16* O; int ldc; int pn_mask; const float* bgate;
    __device__ __forceinline__ void operator()(f32x4 (&acc)[2][2][4][2], const Unit& u, int wr, int wc, int fr, int fq) const {
        const int row0 = u.pm * BM + wr * 64 + fr; const int col0 = (u.pn & pn_mask) * BM + wc * 32 + 8 * fq;
        const bool gate = GATE && (u.pn >= C_G / BM);
        f32x4 bg[2][2];
        if (gate) {
#pragma unroll
            for (int bj = 0; bj < 2; ++bj) { bg[bj][0] = *(const f32x4*)(bgate + (col0 - C_G) + bj * HALF); bg[bj][1] = *(const f32x4*)(bgate + (col0 - C_G) + bj * HALF + 4); } }
#pragma unroll
        for (int ai = 0; ai < 2; ++ai)
#pragma unroll
            for (int m = 0; m < 4; ++m) { bf16* rowp = O + (size_t)(row0 + ai * HALF + m * 16) * ldc + col0;
#pragma unroll
                for (int bj = 0; bj < 2; ++bj) { f32x4 v0 = acc[ai][bj][m][0], v1 = acc[ai][bj][m][1];
                    if (gate) {
#pragma unroll
                        for (int e = 0; e < 4; ++e) { v0[e] = sigmoidf_(v0[e] + bg[bj][0][e]); v1[e] = sigmoidf_(v1[e] + bg[bj][1][e]); } }
                    v4u w; w.x = cvt_pk(v0[0], v0[1]); w.y = cvt_pk(v0[2], v0[3]); w.z = cvt_pk(v1[0], v1[1]); w.w = cvt_pk(v1[2], v1[3]);
                    *(v4u*)(rowp + bj * HALF) = w; } }
    }
};
typedef EpiBf16T<false> EpiBf16;
struct EpiChain {
    static constexpr bool PERM = false;
    bf16* Mb; const bf16* proj;
    __device__ __forceinline__ void operator()(f32x4 (&acc)[2][2][4][2], const Unit& u, int wr, int wc, int fr, int fq) const {
        const int row0 = u.pm * BM + wr * 64 + fr, col0 = u.pn * BM + wc * 32 + 4 * fq; const int br = u.fl;
        const bf16* gp = proj + C_G + br * D + col0;
#pragma unroll
        for (int ai = 0; ai < 2; ++ai)
#pragma unroll
            for (int m = 0; m < 4; ++m) { const size_t row = (size_t)(row0 + ai * HALF + m * 16);
                v2u ga[2][2], gb[2][2];
#pragma unroll
                for (int bj = 0; bj < 2; ++bj)
#pragma unroll
                    for (int n = 0; n < 2; ++n) { ga[bj][n] = *(const v2u*)(gp + row * INC + bj * HALF + n * 16); if (br < 2) gb[bj][n] = *(const v2u*)(gp + row * INC + D + bj * HALF + n * 16); }
#pragma unroll
                for (int bj = 0; bj < 2; ++bj)
#pragma unroll
                    for (int n = 0; n < 2; ++n) { const v2u a = ga[bj][n]; f32x4 g = {bflo(a.x), bfhi(a.x), bflo(a.y), bfhi(a.y)};
                        if (br < 2) { const v2u b = gb[bj][n]; g[0] *= __builtin_amdgcn_rcpf(bflo(b.x)); g[1] *= __builtin_amdgcn_rcpf(bfhi(b.x)); g[2] *= __builtin_amdgcn_rcpf(bflo(b.y)); g[3] *= __builtin_amdgcn_rcpf(bfhi(b.y));
                            acc[ai][bj][m][n] *= g; }
                        else { const f32x4 v = acc[ai][bj][m][n] * g; v2u w; w.x = cvt_pk(v[0], v[1]); w.y = cvt_pk(v[2], v[3]); *(v2u*)(Mb + row * D + col0 + bj * HALF + n * 16) = w; } }
                asm volatile("" ::: "memory"); }
    }
};
struct EpiWout {
    static constexpr bool PERM = false;
    const float* base_lat; const float* base_ctx; float* out_lat; float* out_ctx; const float* modl;
    __device__ __forceinline__ void operator()(f32x4 (&acc)[2][2][4][2], const Unit& u, int wr, int wc, int fr, int fq) const {
        const int b = u.pm / 9, j = u.pm % 9; const bool ctx = (j == 0);
        const size_t r0 = ctx ? (size_t)b * CTXL : (size_t)b * SEQ + (size_t)(j - 1) * 256;
        const float* bp = (ctx ? base_ctx : base_lat) + r0 * D; float* op = (ctx ? out_ctx : out_lat) + r0 * D;
        const float* mg = modl + (size_t)(ctx ? 8 : b) * (NMOD * D) + 2 * D;
        const int rl0 = wr * 64 + fr, col0 = u.pn * BM + wc * 32 + 4 * fq;
#pragma unroll
        for (int ai = 0; ai < 2; ++ai)
#pragma unroll
            for (int m = 0; m < 4; ++m) { const size_t ro = (size_t)(rl0 + ai * HALF + m * 16) * D;
#pragma unroll
                for (int bj = 0; bj < 2; ++bj)
#pragma unroll
                    for (int n = 0; n < 2; ++n) { const int col = col0 + bj * HALF + n * 16;
                        const f32x4 g = *(const f32x4*)(mg + col); const f32x4 bs = *(const f32x4*)(bp + ro + col);
                        *(f32x4*)(op + ro + col) = bs + g * acc[ai][bj][m][n]; }
                asm volatile("" ::: "memory"); }
    }
};
struct EpiUp {
    static constexpr bool PERM = true;
    bf16* HB;
    __device__ __forceinline__ void operator()(f32x4 (&acc)[2][2][4][2], const Unit& u, int wr, int wc, int fr, int fq) const {
        const int row0 = u.pm * BM + wr * 64 + fr; const int col0 = (u.pn & 3) * HALF + wc * 32 + 8 * fq;
#pragma unroll
        for (int ai = 0; ai < 2; ++ai)
#pragma unroll
            for (int m = 0; m < 4; ++m) { bf16* rowp = HB + (size_t)(row0 + ai * HALF + m * 16) * DE + col0;
                f32x4 h0, h1;
#pragma unroll
                for (int e = 0; e < 4; ++e) { const float a0 = acc[ai][0][m][0][e], a1 = acc[ai][0][m][1][e];
                    h0[e] = a0 * sigmoidf_(a0) * acc[ai][1][m][0][e]; h1[e] = a1 * sigmoidf_(a1) * acc[ai][1][m][1][e]; }
                v4u w; w.x = cvt_pk(h0[0], h0[1]); w.y = cvt_pk(h0[2], h0[3]); w.z = cvt_pk(h1[0], h1[1]); w.w = cvt_pk(h1[2], h1[3]);
                *(v4u*)rowp = w; }
    }
};

template <class Epi, class Sched>
__device__ __forceinline__ void gemm_phase(LAS unsigned char* lds, const int lda, const int ldb, const int K, const Sched& S, const Epi& E) {
    constexpr bool ALIGN_EPI = true;
    int tid_ = threadIdx.x; asm volatile("" : "+v"(tid_));
    const int tid = tid_, wid = __builtin_amdgcn_readfirstlane(tid >> 6), lane = tid & 63, wr = wid >> 2, wc = wid & 3, fr = lane & 15, fq = lane >> 4;
    const int nt = K / BK;
    unsigned voffA[2], voffB[2];
#pragma unroll
    for (int i = 0; i < 2; ++i) { int R, C; stage_rc(tid * 16 + i * 8192, R, C); const int Rb = Epi::PERM ? ((R & ~31) + perm32(R & 31)) : R;
        voffA[i] = (unsigned)(R * lda + C) * 2u; voffB[i] = (unsigned)(Rb * ldb + C) * 2u; }
    const size_t kstep = (size_t)(BK * 2);
    const size_t hstepA = (size_t)HALF * lda * 2, hstepB = (size_t)HALF * ldb * 2;
    const unsigned ldsw = (unsigned)wid * 1024u;
    const int aoff = lds_byte(wr * 64 + fr, fq * 8), boff = lds_byte(wc * 32 + fr, fq * 8);
#define PG8_SA(b, h) (((b) * 2 + (h)) * HTB)
#define PG8_SB(b, h) ((4 + (b) * 2 + (h)) * HTB)
#define PG8_STAGE(bufoff, gbase, voff) do { _Pragma("unroll") for (int _i = 0; _i < 2; ++_i) \
        __builtin_amdgcn_global_load_lds((const unsigned*)((const char*)(gbase) + (voff)[_i]), (LAS unsigned*)(lds + (bufoff) + ldsw + _i * 8192), 16, 0, 0); } while (0)
#define PG8_LDA(dst, b, h) do { _Pragma("unroll") for (int m = 0; m < 4; ++m) _Pragma("unroll") for (int k = 0; k < 2; ++k) dst[m][k] = *(const LAS bf16x8*)(lds + PG8_SA(b, h) + aoff + m * 2048 + k * 1024); } while (0)
#define PG8_LDB(dst, b, h) do { _Pragma("unroll") for (int n = 0; n < 2; ++n) _Pragma("unroll") for (int k = 0; k < 2; ++k) dst[n][k] = *(const LAS bf16x8*)(lds + PG8_SB(b, h) + boff + n * 2048 + k * 1024); } while (0)
#define PG8_MMA(ai, bj, At, Bt) do { __builtin_amdgcn_s_setprio(1); _Pragma("unroll") for (int m = 0; m < 4; ++m) _Pragma("unroll") for (int n = 0; n < 2; ++n) _Pragma("unroll") for (int k = 0; k < 2; ++k) \
        acc[ai][bj][m][n] = __builtin_amdgcn_mfma_f32_16x16x32_bf16(Bt[n][k], At[m][k], acc[ai][bj][m][n], 0, 0, 0); __builtin_amdgcn_s_setprio(0); } while (0)
#define PG8_WAIT_V(n) asm volatile("s_waitcnt vmcnt(" #n ")" ::: "memory")
#define PG8_WAIT_L(n) asm volatile("s_waitcnt lgkmcnt(" #n ")" ::: "memory")
#define PG8_BAR __builtin_amdgcn_s_barrier()
#define PG8_SCHED __builtin_amdgcn_sched_barrier(0)
    Unit cur, nxt; int ui = 0;
    if (!S.next(0, cur)) return;
    f32x4 acc[2][2][4][2];
#pragma unroll
    for (int a = 0; a < 2; ++a)
#pragma unroll
        for (int b = 0; b < 2; ++b)
#pragma unroll
            for (int m = 0; m < 4; ++m)
#pragma unroll
                for (int n = 0; n < 2; ++n) acc[a][b][m][n] = (f32x4){0.f, 0.f, 0.f, 0.f};
    bf16x8 At[4][2], B0[2][2], B1[2][2];
    const char* cA = S.a_base(cur); const char* cB = S.b_base(cur);
    PG8_STAGE(PG8_SB(0, 0), cB, voffB); PG8_STAGE(PG8_SB(0, 1), cB + hstepB, voffB); PG8_STAGE(PG8_SA(0, 0), cA, voffA); PG8_STAGE(PG8_SA(0, 1), cA + hstepA, voffA);
    if (wr == 1) PG8_BAR;
    PG8_WAIT_V(2); PG8_BAR;
    PG8_STAGE(PG8_SB(1, 0), cB + kstep, voffB); PG8_STAGE(PG8_SA(1, 0), cA + kstep, voffA); PG8_STAGE(PG8_SB(1, 1), cB + hstepB + kstep, voffB);
    PG8_WAIT_V(6); PG8_BAR;
    for (;;) {
        const bool has_next = S.next(ui + 1, nxt);
        const char* nA = has_next ? S.a_base(nxt) : cA; const char* nB = has_next ? S.b_base(nxt) : cB;
        for (int t = 0; t < nt; t += 2) {
            const bool last = (t == nt - 2);
            const char* a1 = cA + (size_t)(t + 1) * kstep;
            const char* a2 = last ? nA : cA + (size_t)(t + 2) * kstep; const char* b2 = last ? nB : cB + (size_t)(t + 2) * kstep;
            const char* a3 = a2 + kstep; const char* b3 = b2 + kstep;
            PG8_LDB(B0, 0, 0); PG8_LDB(B1, 0, 1); PG8_SCHED; PG8_LDA(At, 0, 0); PG8_STAGE(PG8_SA(1, 1), a1 + hstepA, voffA);
            PG8_WAIT_V(8); PG8_WAIT_L(0); PG8_BAR; PG8_MMA(0, 0, At, B0); PG8_MMA(0, 1, At, B1); PG8_BAR; PG8_SCHED;
            PG8_LDA(At, 0, 1); PG8_STAGE(PG8_SB(0, 0), b2, voffB); PG8_STAGE(PG8_SB(0, 1), b2 + hstepB, voffB); PG8_STAGE(PG8_SA(0, 0), a2, voffA);
            PG8_WAIT_V(8); PG8_WAIT_L(0); PG8_BAR; PG8_MMA(1, 0, At, B0); PG8_MMA(1, 1, At, B1); PG8_BAR; PG8_SCHED;
            PG8_LDB(B0, 1, 0); PG8_LDB(B1, 1, 1); PG8_SCHED; PG8_LDA(At, 1, 0); PG8_STAGE(PG8_SA(0, 1), a2 + hstepA, voffA);
            PG8_WAIT_V(8); PG8_WAIT_L(0); PG8_BAR; PG8_MMA(0, 0, At, B0); PG8_MMA(0, 1, At, B1); PG8_BAR; PG8_SCHED;
            PG8_LDA(At, 1, 1); PG8_STAGE(PG8_SB(1, 0), b3, voffB); PG8_STAGE(PG8_SB(1, 1), b3 + hstepB, voffB); PG8_STAGE(PG8_SA(1, 0), a3, voffA);
            PG8_WAIT_V(8); PG8_WAIT_L(0); PG8_BAR; PG8_MMA(1, 0, At, B0); PG8_MMA(1, 1, At, B1); PG8_BAR; PG8_SCHED;
        }
        if constexpr (ALIGN_EPI) { if (wr == 0) PG8_BAR; }
        { int fr2 = fr, fq2 = fq; asm volatile("" : "+v"(fr2), "+v"(fq2)); E(acc, cur, wr, wc, fr2, fq2); }
        if (!has_next) break;
        if (S.zero_after(cur)) {
#pragma unroll
        for (int a = 0; a < 2; ++a)
#pragma unroll
            for (int b = 0; b < 2; ++b)
#pragma unroll
                for (int m = 0; m < 4; ++m)
#pragma unroll
                    for (int n = 0; n < 2; ++n) acc[a][b][m][n] = (f32x4){0.f, 0.f, 0.f, 0.f}; }
        cur = nxt; cA = nA; cB = nB; ++ui;
        if constexpr (ALIGN_EPI) { if (wr == 1) PG8_BAR; }
    }
    PG8_WAIT_V(0);
    if constexpr (!ALIGN_EPI) { if (wr == 0) PG8_BAR; }
    PG8_BAR;
#undef PG8_SA
#undef PG8_SB
#undef PG8_STAGE
#undef PG8_LDA
#undef PG8_LDB
#undef PG8_MMA
#undef PG8_WAIT_V
#undef PG8_WAIT_L
#undef PG8_BAR
#undef PG8_SCHED
}
}

namespace att {
constexpr int AD = 128, NW = 8, QBLK = 32, KVBLK = 64;
constexpr float SCALE = 0.088388347648318440f;
constexpr float THR = 8.f;
constexpr int LDQ = INC, LDK = INC;
constexpr size_t SHM_V = KVBLK * AD * 2, SHM_K = KVBLK * AD * 2, SHM_ATTN = 2 * SHM_V + 2 * SHM_K + NW * 64 * 4;
using s16x4 = __attribute__((ext_vector_type(4))) short;
using f32x16 = __attribute__((ext_vector_type(16))) float;
#define KSWZ(row, colB) ((row) * 256 + ((colB) ^ (((row) & 7) << 4)))
#define SBAR() __builtin_amdgcn_sched_barrier(0)
__device__ __forceinline__ int crow(int r, int hi) { return (r & 3) + 8 * (r >> 2) + 4 * hi; }
__device__ __forceinline__ void partialSM(f32x16& p0, f32x16& p1, float& m_reg, float& mn, float& alpha) {
  constexpr float C = SCALE * 1.4426950408889634f;
  float pmax = p0[0]; for (int r = 1; r < 16; ++r) pmax = fmaxf(pmax, p0[r]); for (int r = 0; r < 16; ++r) pmax = fmaxf(pmax, p1[r]);
  { auto rr = __builtin_amdgcn_permlane32_swap(__float_as_uint(pmax), __float_as_uint(pmax), false, false);
    pmax = fmaxf(__uint_as_float(rr[0]), __uint_as_float(rr[1])); }
  if (__builtin_expect(__all(pmax - m_reg <= THR / SCALE), 1)) { mn = m_reg; alpha = 1.f; }
  else { mn = fmaxf(m_reg, pmax); alpha = __builtin_amdgcn_exp2f((m_reg - mn) * C); m_reg = mn; }
  float mnC = -mn * C;
  for (int r = 0; r < 16; ++r) p0[r] = fmaf(p0[r], C, mnC); for (int r = 0; r < 16; ++r) p1[r] = fmaf(p1[r], C, mnC);
  for (int r = 0; r < 16; ++r) p0[r] = __builtin_amdgcn_exp2f(p0[r]);
}
__device__ __forceinline__ void finishSM(f32x16& p0, f32x16& p1, float alpha, float& l_reg, bf16x8& pa0, bf16x8& pa1, bf16x8& pa2, bf16x8& pa3) {
  for (int r = 0; r < 16; ++r) p1[r] = __builtin_amdgcn_exp2f(p1[r]);
  float ps = 0; for (int r = 0; r < 16; ++r) ps += p0[r]; for (int r = 0; r < 16; ++r) ps += p1[r];
  { auto rr = __builtin_amdgcn_permlane32_swap(__float_as_uint(ps), __float_as_uint(ps), false, false);
    ps = __uint_as_float(rr[0]) + __uint_as_float(rr[1]); }
  l_reg = l_reg * alpha + ps;
#define PK4(P, BASE, OUT) do { unsigned a0 = cvt_pk(P[BASE + 0], P[BASE + 1]), a1 = cvt_pk(P[BASE + 2], P[BASE + 3]);   \
    unsigned b0 = cvt_pk(P[BASE + 4], P[BASE + 5]), b1 = cvt_pk(P[BASE + 6], P[BASE + 7]);                              \
    auto r0 = __builtin_amdgcn_permlane32_swap(a0, b0, false, false); auto r1 = __builtin_amdgcn_permlane32_swap(a1, b1, false, false); \
    v4u w = {r0[0], r1[0], r0[1], r1[1]}; OUT = *reinterpret_cast<bf16x8*>(&w); } while (0)
  PK4(p0, 0, pa0); PK4(p0, 8, pa1); PK4(p1, 0, pa2); PK4(p1, 8, pa3);
#undef PK4
}
__device__ __forceinline__ void qkt(f32x16& p0, f32x16& p1, const bf16* Ks, const bf16x8* qr, int r32, int hi) {
  p0 = f32x16{}; p1 = f32x16{};
  for (int d0 = 0; d0 < 8; ++d0) { int cb = (d0 * 16 + hi * 8) * 2;
    bf16x8 b0 = *reinterpret_cast<const bf16x8*>((const char*)Ks + KSWZ(r32, cb));
    bf16x8 b1 = *reinterpret_cast<const bf16x8*>((const char*)Ks + KSWZ(32 + r32, cb));
    p0 = __builtin_amdgcn_mfma_f32_32x32x16_bf16(b0, qr[d0], p0, 0, 0, 0);
    p1 = __builtin_amdgcn_mfma_f32_32x32x16_bf16(b1, qr[d0], p1, 0, 0, 0); }
}
__device__ __forceinline__ int v_st(int k, int c) { const int kk = (k & ~0xC) | ((k & 4) << 1) | ((k & 8) >> 1); return ((kk >> 3) * 4 + (c >> 5)) * 512 + ((kk & 7) * 32 + (c & 31)) * 2; }
__device__ __forceinline__ int v_rd_base(int lane) { return ((lane & 3) << 3) | (((lane >> 2) & 3) << 6) | (((lane >> 4) & 1) << 5) | (((lane >> 5) & 1) << 8); }
constexpr int v_rd_off(int d0, int ks, int half) { return d0 * 512 + ks * 4096 + half * 2048; }
template <int OFF> __device__ __forceinline__ s16x4 tr_read(int vb) {
  s16x4 r; asm volatile("ds_read_b64_tr_b16 %0, %1 offset:%2" : "=&v"(r) : "v"(vb), "i"(OFF) : "memory"); return r;
}
template <int D0> __device__ __forceinline__ void pv_one(f32x16& od, int vb, bf16x8 pa0, bf16x8 pa1, bf16x8 pa2, bf16x8 pa3) {
  const s16x4 l0 = tr_read<v_rd_off(D0, 0, 0)>(vb), h0 = tr_read<v_rd_off(D0, 0, 1)>(vb), l1 = tr_read<v_rd_off(D0, 1, 0)>(vb), h1 = tr_read<v_rd_off(D0, 1, 1)>(vb);
  const s16x4 l2 = tr_read<v_rd_off(D0, 2, 0)>(vb), h2 = tr_read<v_rd_off(D0, 2, 1)>(vb), l3 = tr_read<v_rd_off(D0, 3, 0)>(vb), h3 = tr_read<v_rd_off(D0, 3, 1)>(vb);
  asm volatile("s_waitcnt lgkmcnt(0)" ::: "memory"); SBAR();
#define PK(L, H) (bf16x8){L[0], L[1], L[2], L[3], H[0], H[1], H[2], H[3]}
  od = __builtin_amdgcn_mfma_f32_32x32x16_bf16(pa0, PK(l0, h0), od, 0, 0, 0);
  od = __builtin_amdgcn_mfma_f32_32x32x16_bf16(pa1, PK(l1, h1), od, 0, 0, 0);
  od = __builtin_amdgcn_mfma_f32_32x32x16_bf16(pa2, PK(l2, h2), od, 0, 0, 0);
  od = __builtin_amdgcn_mfma_f32_32x32x16_bf16(pa3, PK(l3, h3), od, 0, 0, 0);
#undef PK
}
__device__ __forceinline__ void pv_d0(f32x16* o, int vb, bf16x8 pa0, bf16x8 pa1, bf16x8 pa2, bf16x8 pa3) {
  pv_one<0>(o[0], vb, pa0, pa1, pa2, pa3); pv_one<1>(o[1], vb, pa0, pa1, pa2, pa3); pv_one<2>(o[2], vb, pa0, pa1, pa2, pa3); pv_one<3>(o[3], vb, pa0, pa1, pa2, pa3);
}
__device__ __forceinline__ void attn_dense_body(const bf16* __restrict__ Qb, const bf16* __restrict__ Kh, const bf16* __restrict__ Vh,
                                                bf16* __restrict__ Ob, int ldo, int seq, char* lds) {
  constexpr int SDEPTH = 2;
  int tid_ = threadIdx.x; asm volatile("" : "+v"(tid_));
  const int tid = tid_, wid = tid >> 6, lane = tid & 63, r32 = lane & 31, hi = lane >> 5;
  bf16* V_lds = (bf16*)lds; bf16* K_lds = (bf16*)(lds + 2 * SHM_V);
  float* ws = (float*)(lds + 2 * SHM_V + 2 * SHM_K) + wid * 64; float* li_l = ws; float* al_l = ws + 32;
  float m_reg = -1e30f, l_reg = 0; f32x16 o[4] = {}; bf16x8 qr[8];
  const bf16* Qw = Qb + (long)(wid * QBLK + r32) * LDQ + hi * 8;
#pragma unroll
  for (int d0 = 0; d0 < 8; ++d0) qr[d0] = *reinterpret_cast<const bf16x8*>(Qw + d0 * 16);
  const int sr = tid >> 4, sc = (tid & 15) * 8, vst0 = v_st(sr, sc), vst1 = v_st(32 + sr, sc);
  const int vb0 = (int)(uintptr_t)V_lds + v_rd_base(lane);
  struct { bf16x8 vs0, vs1, ks0, ks1; } sr_[SDEPTH];
#define SLOAD(i, k0) do { sr_[i].vs0 = *(const bf16x8*)(&Vh[(long)((k0) + sr) * LDK + sc]); sr_[i].vs1 = *(const bf16x8*)(&Vh[(long)((k0) + 32 + sr) * LDK + sc]); \
    sr_[i].ks0 = *(const bf16x8*)(&Kh[(long)((k0) + sr) * LDK + sc]); sr_[i].ks1 = *(const bf16x8*)(&Kh[(long)((k0) + 32 + sr) * LDK + sc]); } while (0)
#define SWRITE(b, i) do { *(bf16x8*)((char*)V_lds + (b) * SHM_V + vst0) = sr_[i].vs0;          \
    *(bf16x8*)((char*)V_lds + (b) * SHM_V + vst1) = sr_[i].vs1; int kc = sc * 2;               \
    *(bf16x8*)((char*)K_lds + (b) * SHM_K + KSWZ(sr, kc)) = sr_[i].ks0;                       \
    *(bf16x8*)((char*)K_lds + (b) * SHM_K + KSWZ(32 + sr, kc)) = sr_[i].ks1; } while (0)
#define SWAIT() asm volatile("s_waitcnt vmcnt(4)" ::: "memory")
#define RESC(a) do { if (__any((a) < 1.f)) { if (hi == 0) al_l[r32] = (a); asm volatile("s_waitcnt lgkmcnt(0)" ::: "memory"); \
    for (int d = 0; d < 4; ++d) for (int r = 0; r < 16; ++r) o[d][r] *= al_l[crow(r, hi)]; } } while (0)
  f32x16 pA0, pA1, pB0, pB1; float mnA, mnB, alA, alB; bf16x8 pa0, pa1, pa2, pa3; const int NT = seq / KVBLK;
  constexpr int SE = 0, SO = SDEPTH - 1;
  SLOAD(SE, 0); asm volatile("s_waitcnt vmcnt(0)" ::: "memory"); SWRITE(0, SE); __syncthreads();
  qkt(pA0, pA1, K_lds, qr, r32, hi); partialSM(pA0, pA1, m_reg, mnA, alA);
  SLOAD(SO, KVBLK); if (2 < NT) SLOAD(SE, 2 * KVBLK);
  SWAIT(); SWRITE(1, SO); __syncthreads();
  for (int j = 1; j + 1 < NT; j += 2) {
    SBAR(); qkt(pB0, pB1, (bf16*)((char*)K_lds + SHM_K), qr, r32, hi);
    finishSM(pA0, pA1, alA, l_reg, pa0, pa1, pa2, pa3); SBAR();
    SLOAD(SO, (j + SDEPTH) * KVBLK); SBAR();
    pv_d0(o, vb0, pa0, pa1, pa2, pa3); partialSM(pB0, pB1, m_reg, mnB, alB);
    __syncthreads(); SWAIT(); SWRITE(0, SE);
    RESC(alB); __syncthreads();
    SBAR(); qkt(pA0, pA1, K_lds, qr, r32, hi);
    finishSM(pB0, pB1, alB, l_reg, pa0, pa1, pa2, pa3); SBAR();
    if (j + 3 < NT) SLOAD(SE, (j + 1 + SDEPTH) * KVBLK); SBAR();
    pv_d0(o, vb0 + (int)SHM_V, pa0, pa1, pa2, pa3); partialSM(pA0, pA1, m_reg, mnA, alA);
    __syncthreads(); SWAIT(); SWRITE(1, SO);
    RESC(alA); __syncthreads();
  }
  SBAR(); qkt(pB0, pB1, (bf16*)((char*)K_lds + SHM_K), qr, r32, hi);
  finishSM(pA0, pA1, alA, l_reg, pa0, pa1, pa2, pa3); SBAR();
  pv_d0(o, vb0, pa0, pa1, pa2, pa3); partialSM(pB0, pB1, m_reg, mnB, alB);
  __syncthreads(); RESC(alB);
  finishSM(pB0, pB1, alB, l_reg, pa0, pa1, pa2, pa3); SBAR();
  pv_d0(o, vb0 + (int)SHM_V, pa0, pa1, pa2, pa3);
  if (hi == 0) li_l[r32] = l_reg; asm volatile("s_waitcnt lgkmcnt(0)" ::: "memory");
  float rli[16];
#pragma unroll
  for (int r = 0; r < 16; ++r) rli[r] = __builtin_amdgcn_rcpf(li_l[crow(r, hi)]);
  bf16* Ow = Ob + (long)(wid * QBLK) * ldo;
#pragma unroll
  for (int r = 0; r < 16; ++r) { int orow = crow(r, hi);
    for (int d0 = 0; d0 < 4; ++d0) Ow[(long)orow * ldo + d0 * 32 + r32] = (bf16)(cvt_pk(o[d0][r] * rli[r], 0.f) & 0xffffu); }
#undef SLOAD
#undef SWRITE
#undef SWAIT
#undef RESC
}
}

#define XB_TMO      128
#define XB_XCNT(j)  (256  + 64 * (j))
#define XB_XSUB(j)  (1280 + 64 * (j))
#define XB_XGEN(j)  (2304 + 64 * (j))
#define XB_TOP      3328
#define XB_TOPGEN   3392
#define XCD_BAR_WORDS 3456
#define XB_SPIN_CAP (1u << 18)
__device__ __forceinline__ unsigned xb_ld(unsigned* p)              { return __hip_atomic_load(p, __ATOMIC_RELAXED, __HIP_MEMORY_SCOPE_AGENT); }
__device__ __forceinline__ unsigned xb_add(unsigned* p, unsigned v) { return __hip_atomic_fetch_add(p, v, __ATOMIC_RELAXED, __HIP_MEMORY_SCOPE_AGENT); }
__device__ __forceinline__ unsigned xb_xcc_id() { return (unsigned)__builtin_amdgcn_s_getreg((3 << 11) | 20) & 0xFu; }
#define XB_SPIN(cond, bar) do { unsigned _sp = 0; while (cond) { __builtin_amdgcn_s_sleep(1); \
    if ((++_sp & 255u) == 0u) { if (xb_ld(&(bar)[XB_TMO])) break; if (_sp > XB_SPIN_CAP) { atomicAdd(&(bar)[XB_TMO], 1u); break; } } } } while (0)
struct XcdBarrier { unsigned* bar; unsigned x; volatile LAS unsigned* st; };
__device__ __forceinline__ XcdBarrier xcd_barrier_post(unsigned* bar, volatile LAS unsigned* st) {
    XcdBarrier b; b.bar = bar; b.x = xb_xcc_id(); b.st = st;
    if (threadIdx.x == 0) (void)xb_add(&bar[XB_XCNT(b.x)], 1u);
    return b;
}
__device__ __forceinline__ void xcd_barrier_complete(unsigned* bar, unsigned x, unsigned& nloc, unsigned& nx) {
    const unsigned G = gridDim.x * gridDim.y * gridDim.z;
    unsigned sum, cnt, mine, sp = 0u;
    for (;;) {
        sum = 0u; cnt = 0u; mine = 0u;
#pragma unroll
        for (unsigned j = 0; j < 16; ++j) { const unsigned c = xb_ld(&bar[XB_XCNT(j)]); sum += c; cnt += (c > 0u) ? 1u : 0u; mine = (j == x) ? c : mine; }
        if (sum == G) break;
        __builtin_amdgcn_s_sleep(1);
        if ((++sp & 255u) == 0u) { if (xb_ld(&bar[XB_TMO])) break; if (sp > XB_SPIN_CAP) { atomicAdd(&bar[XB_TMO], 1u); break; } }
    }
    nloc = mine > 0u ? mine : 1u; nx = cnt > 0u ? cnt : 1u;
}
__device__ __forceinline__ void xcd_barrier(const XcdBarrier& b) {
    asm volatile("s_waitcnt vmcnt(0)" ::: "memory");
    __syncthreads();
    if (threadIdx.x == 0) {
        unsigned* bar = b.bar;
        __builtin_amdgcn_s_waitcnt(0);
        unsigned nloc = b.st[0], nx = b.st[1];
        if (nloc == 0u) { xcd_barrier_complete(bar, b.x, nloc, nx); b.st[0] = nloc; b.st[1] = nx; }
        const unsigned old = xb_add(&bar[XB_XSUB(b.x)], 1u);
        const unsigned gen = old / nloc;
        if (old + 1u == (gen + 1u) * nloc) {
            __builtin_amdgcn_fence(__ATOMIC_RELEASE, "agent");
            asm volatile("s_waitcnt vmcnt(0)" ::: "memory");
            const unsigned og = xb_add(&bar[XB_TOP], 1u);
            const unsigned tg = og / nx;
            if (og + 1u == (tg + 1u) * nx) xb_add(&bar[XB_TOPGEN], 1u);
            else XB_SPIN(xb_ld(&bar[XB_TOPGEN]) == tg, bar);
            __builtin_amdgcn_fence(__ATOMIC_ACQUIRE, "agent");
            xb_add(&bar[XB_XGEN(b.x)], 1u);
            asm volatile("s_waitcnt vmcnt(0)" ::: "memory");
        } else {
            XB_SPIN(xb_ld(&bar[XB_XGEN(b.x)]) == gen, bar);
            __builtin_amdgcn_fence(__ATOMIC_ACQUIRE, "agent");
            asm volatile("s_waitcnt vmcnt(0)" ::: "memory");
        }
    }
    __syncthreads();
}

struct Args { const float* in[34]; float* out; unsigned char* ws; int ph_lo, ph_hi; };
typedef const __attribute__((address_space(4))) Args* KArgs;
template <class T> __device__ __forceinline__ T* as_global(T* p) { return (T*)(GAS T*)p; }
__device__ __forceinline__ KArgs kargs() { KArgs p = (KArgs)__builtin_amdgcn_kernarg_segment_ptr(); asm volatile("" : "+s"(p)); return p; }
__device__ __forceinline__ const float* ain(KArgs a, int i) { return as_global(a->in[i]); }
__device__ __forceinline__ float* aout(KArgs a) { return as_global(a->out); }
struct Frame {
    unsigned char* lds; unsigned char* lds0;
    LAS unsigned char* ldsl;
    unsigned char* ws;
    int tid, lane, wave, G, gw, NGW;
};
enum { I_X = 0, I_C, I_CTX, I_CCTX, I_WADA, I_BADA, I_N1G, I_N2G, I_WIN, I_BGATE, I_QNA, I_KNA, I_DLAM, I_SUBN, I_QNC, I_KNC, I_CONVW, I_CONVB,
       I_LWA, I_LBA, I_LWX, I_LBX, I_LLAM, I_WBA, I_WBB, I_WBC, I_WOUT, I_WGRP, I_BGRP, I_WRT, I_BRT, I_W1, I_W3, I_W2 };

__device__ __forceinline__ void phase_ids(Frame& F) {
    int t = threadIdx.x; asm volatile("" : "+v"(t)); F.tid = t; F.lane = t & 63; F.wave = __builtin_amdgcn_readfirstlane(t >> 6); F.gw = blockIdx.x * 8 + F.wave;
    GAS unsigned char* w = (GAS unsigned char*)kargs()->ws; asm volatile("" : "+s"(w)); F.ws = (unsigned char*)w; F.lds = F.lds0; F.ldsl = (LAS unsigned char*)F.lds0;
}
__device__ __forceinline__ int launder_s(int v) { asm volatile("" : "+s"(v)); return v; }
__device__ __forceinline__ void tr_item(const float* __restrict__ W, int N, bf16* __restrict__ WT, int K, int k0, int n0, int drow0, LAS float* scr, int lane) {
#pragma unroll 8
    for (int i = 0; i < 64; ++i) scr[i * 65 + lane] = W[(size_t)(k0 + i) * N + n0 + lane];
    LDS_WAIT();
    const int c = lane & 7;
#pragma unroll
    for (int j = 0; j < 8; ++j) { const int n = (lane >> 3) + 8 * j; const LAS float* s = scr + (8 * c) * 65 + n;
        v4u o; o.x = cvt_pk(s[0], s[65]); o.y = cvt_pk(s[130], s[195]); o.z = cvt_pk(s[260], s[325]); o.w = cvt_pk(s[390], s[455]);
        *(v4u*)(WT + (size_t)(drow0 + n) * K + k0 + 8 * c) = o; }
    LDS_WAIT();
}
__device__ __forceinline__ void conv_weights(Frame& F, int l) {
    phase_ids(F); l = launder_s(l); KArgs a = kargs();
    LAS float* scr = (LAS float*)(F.ldsl + F.wave * 16640);
    constexpr int I_IN = 32 * 200, I_BR = 16 * 32, I_OUT = 32 * 32, I_W = 32 * 256;
    constexpr int NIT = I_IN + 3 * I_BR + I_OUT + 3 * I_W;
    bf16* WIN = (bf16*)(F.ws + WS_WIN); bf16* WBR = (bf16*)(F.ws + WS_WBR); bf16* WOUT = (bf16*)(F.ws + WS_WOUT); bf16* W13 = (bf16*)(F.ws + WS_W13); bf16* W2 = (bf16*)(F.ws + WS_W2);
    for (int it = F.gw; it < NIT; it += F.NGW) {
        int r = it;
        if (r < I_IN) { const int kb = r / 200, nb = r % 200; tr_item(ain(a, I_WIN) + (size_t)l * D * INC, INC, WIN, D, kb * 64, nb * 64, nb * 64, scr, F.lane); continue; } r -= I_IN;
        if (r < 3 * I_BR) { const int br = r / I_BR, q = r % I_BR, kb = q / 32, nb = q % 32;
            tr_item(ain(a, I_WBA + br) + (size_t)l * 1024 * D, D, WBR + (size_t)br * D * 1024, 1024, kb * 64, nb * 64, nb * 64, scr, F.lane); continue; } r -= 3 * I_BR;
        if (r < I_OUT) { const int kb = r / 32, nb = r % 32; tr_item(ain(a, I_WOUT) + (size_t)l * D * D, D, WOUT, D, kb * 64, nb * 64, nb * 64, scr, F.lane); continue; } r -= I_OUT;
        if (r < 2 * I_W) { const int which = r / I_W, q = r % I_W, e = q / 256, q2 = q % 256, kb = q2 / 8, nb = q2 % 8;
            const int n0 = nb * 64; const int drow = e * 1024 + (n0 / 128) * 256 + (n0 % 128) + which * 128;
            tr_item(ain(a, which ? I_W3 : I_W1) + ((size_t)l * NE + e) * D * DE, DE, W13, D, kb * 64, n0, drow, scr, F.lane); continue; } r -= 2 * I_W;
        { const int e = r / 256, q2 = r % 256, kb = q2 / 32, nb = q2 % 32;
            tr_item(ain(a, I_W2) + ((size_t)l * NE + e) * DE * D, D, W2, DE, kb * 64, nb * 64, e * D + nb * 64, scr, F.lane); }
    }
}

__device__ __forceinline__ void p0_misc(Frame& F) {
    phase_ids(F); KArgs a = kargs();
    LAS float* sl = (LAS float*)F.ldsl;
    LAS float* red = sl + 9 * 2048;
    const float* c = ain(a, I_C); const float* cc = ain(a, I_CCTX);
    float* mod = (float*)(F.ws + WS_MOD);
    if (blockIdx.x < 192 || F.G < 192) {
        for (int idx = F.tid; idx < 9 * 2048; idx += 512) { const int b = idx >> 11, k = idx & 2047; const float v = b < 8 ? c[b * 2048 + k] : cc[k]; sl[idx] = v / (1.0f + expf(-v)); }
        __syncthreads();
        for (int it = blockIdx.x; it < 192; it += F.G) {
            const int l = it / 96, cb = it % 96, col = cb * 128 + 2 * F.lane;
            const float* wp = ain(a, I_WADA) + ((size_t)l * D + F.wave * 256) * (NMOD * D) + col;
            float ax[9], ay[9];
#pragma unroll
            for (int b = 0; b < 9; ++b) { ax[b] = 0.f; ay[b] = 0.f; }
            for (int k = 0; k < 256; k += 8) {
                f32x2 w[8];
#pragma unroll
                for (int u = 0; u < 8; ++u) w[u] = *(const f32x2*)(wp + (size_t)(k + u) * (NMOD * D));
#pragma unroll
                for (int u = 0; u < 8; ++u)
#pragma unroll
                    for (int b = 0; b < 9; ++b) { const float s = sl[b * 2048 + F.wave * 256 + k + u]; ax[b] += s * w[u].x; ay[b] += s * w[u].y; }
            }
#pragma unroll
            for (int b = 0; b < 9; ++b) { red[(F.wave * 9 + b) * 128 + 2 * F.lane] = ax[b]; red[(F.wave * 9 + b) * 128 + 2 * F.lane + 1] = ay[b]; }
            __syncthreads();
            for (int o = F.tid; o < 9 * 128; o += 512) { const int b = o >> 7, ci = o & 127; float s = 0.f;
#pragma unroll
                for (int w = 0; w < 8; ++w) s += red[(w * 9 + b) * 128 + ci];
                mod[((size_t)l * 9 + b) * (NMOD * D) + cb * 128 + ci] = s + ain(a, I_BADA)[(size_t)l * (NMOD * D) + cb * 128 + ci]; }
            __syncthreads();
        }
    }
    { float* rc = (float*)(F.ws + WS_ROPE); float* rs = rc + 2048 * 64;
      for (int idx = blockIdx.x * 512 + F.tid; idx < 2048 * 64; idx += F.G * 512) { const int t = idx >> 6, j = idx & 63, jj = j & 31;
          const float inv = 1.0f / powf(10000.0f, (float)(2 * jj) / 64.0f); const float pos = (float)(j < 32 ? (t >> 6) : (t & 63));
          float s, co; sincosf(pos * inv, &s, &co); rc[idx] = co; rs[idx] = s; } }
    if (blockIdx.x == 0 && F.wave < 2) { const int l = F.wave; const float* dl = ain(a, I_DLAM) + (size_t)l * 4 * 128;
        float s01 = dl[F.lane] * dl[128 + F.lane] + dl[64 + F.lane] * dl[192 + F.lane];
        float s23 = dl[256 + F.lane] * dl[384 + F.lane] + dl[320 + F.lane] * dl[448 + F.lane];
        s01 = wave_sum(s01); s23 = wave_sum(s23);
        const float li = l == 0 ? 0.2f : 0.3555090676f;
        if (F.lane == 0) ((float*)(F.ws + WS_MISC + MISC_LAM))[l] = expf(s01) - expf(s23) + li; }
    { bf16* wr = (bf16*)(F.ws + WS_MISC + MISC_WR);
      for (int idx = blockIdx.x * 512 + F.tid; idx < 2 * 48 * 2048; idx += F.G * 512) { const int l = idx / (48 * 2048), rem = idx % (48 * 2048), e = rem >> 11, k = rem & 2047;
          float w = 0.f; if (e < 4) w = ain(a, I_WGRP)[((size_t)l * D + k) * 4 + e]; else if (e < 36) w = ain(a, I_WRT)[((size_t)l * D + k) * 32 + (e - 4)];
          const unsigned hi = cvt_pk(w, 0.f) & 0xffffu; const float lo = w - bflo(hi);
          wr[((size_t)(l * 2 + 0) * 48 + e) * 2048 + k] = (bf16)hi; wr[((size_t)(l * 2 + 1) * 48 + e) * 2048 + k] = (bf16)(cvt_pk(lo, 0.f) & 0xffffu); } }
    { bf16* lw = (bf16*)(F.ws + WS_LRUW);
      for (int idx = blockIdx.x * 512 + F.tid; idx < 2 * 2 * 2 * 8 * 128 * 128; idx += F.G * 512) {
          const int cidx = idx & 127, d = (idx >> 7) & 127, n = (idx >> 14) & 7, dir = (idx >> 17) & 1, mat = (idx >> 18) & 1, l = idx >> 19;
          const float w = ain(a, mat ? I_LWX : I_LWA)[((((size_t)l * 2 + dir) * 8 + n) * 128 + cidx) * 128 + d];
          lw[idx] = (bf16)(cvt_pk(w, 0.f) & 0xffffu); } }
}

__device__ __forceinline__ void row_split(int r, int& b, int& i) { b = r / TB; i = r - b * TB; }
__device__ __forceinline__ size_t hrow_off(int b, int i, bool& ctx) { ctx = i < CTXL; return ctx ? ((size_t)b * CTXL + i) * D : ((size_t)b * SEQ + (i - CTXL)) * D; }

__device__ __forceinline__ void norm_mod(f32x4 (&v)[8], const float* g, const float* shift, const float* scale, int lane) {
    float ss = 0.f;
#pragma unroll
    for (int j = 0; j < 8; ++j) ss += (v[j][0] * v[j][0] + v[j][1] * v[j][1]) + (v[j][2] * v[j][2] + v[j][3] * v[j][3]);
    ss = wave_sum(ss);
    const float rs = rsqrtf(ss * (1.0f / D) + EPS);
#pragma unroll
    for (int j = 0; j < 8; ++j) { const int c = (lane + 64 * j) * 4; const f32x4 gg = *(const f32x4*)(g + c), sh = *(const f32x4*)(shift + c), sc = *(const f32x4*)(scale + c);
        v[j] = v[j] * rs * gg * (sc + 1.0f) + sh; }
}

__device__ __forceinline__ void pa_norm1(Frame& F, int l) {
    phase_ids(F); l = launder_s(l); KArgs a = kargs();
    const float* hl = l == 0 ? ain(a, I_X) : aout(a); const float* hc = l == 0 ? ain(a, I_CTX) : (const float*)(F.ws + WS_HC);
    const float* mod = (const float*)(F.ws + WS_MOD) + (size_t)l * 9 * (NMOD * D);
    const float* g = ain(a, I_N1G) + (size_t)l * D; bf16* U = (bf16*)(F.ws + WS_ACT);
    for (int r = F.gw; r < ROWS; r += F.NGW) {
        int b, i; row_split(r, b, i); bool ctx; const size_t off = hrow_off(b, i, ctx);
        const f32x4* xr = (const f32x4*)((ctx ? hc : hl) + off) + F.lane;
        f32x4 v[8];
#pragma unroll
        for (int j = 0; j < 8; ++j) v[j] = xr[64 * j];
        const float* mb = mod + (size_t)(ctx ? 8 : b) * (NMOD * D);
        norm_mod(v, g, mb, mb + D, F.lane);
        v2u* o = (v2u*)(U + (size_t)r * D) + F.lane;
#pragma unroll
        for (int j = 0; j < 8; ++j) { v2u w; w.x = cvt_pk(v[j][0], v[j][1]); w.y = cvt_pk(v[j][2], v[j][3]); o[64 * j] = w; }
    }
}

__device__ __forceinline__ void pc_qk(Frame& F, int l) {
    phase_ids(F); l = launder_s(l); KArgs a = kargs();
    bf16* PROJ = (bf16*)(F.ws + WS_PROJ);
    const float* rc = (const float*)(F.ws + WS_ROPE); const float* rs = rc + 2048 * 64;
    const float* qna = ain(a, I_QNA) + l * 128; const float* kna = ain(a, I_KNA) + l * 128; const float* qnc = ain(a, I_QNC) + l * 128; const float* knc = ain(a, I_KNC) + l * 128;
    const int half = F.lane >> 5, li = F.lane & 31;
    for (int r = F.gw; r < ROWS; r += F.NGW) {
        int b, i; row_split(r, b, i); const bool lat = i >= CTXL; const int t = i - CTXL;
        bf16* prow = PROJ + (size_t)r * INC;
        f32x4 cs = {1.f, 1.f, 1.f, 1.f}, sn = {0.f, 0.f, 0.f, 0.f};
        if (lat) { const int ti = t * 64 + (li >> 4) * 32 + 4 * (li & 7); cs = *(const f32x4*)(rc + ti); sn = *(const f32x4*)(rs + ti); }
        const float sgn = (li & 8) ? 1.0f : -1.0f;
        for (int it = 0; it < 13; ++it) {
            if (l == 1 && !lat && !(it >= 4 && it < 8) && it != 12) continue;
            const int hidx = 2 * it + half; int colbase; const float* g;
            if (hidx < 8) { colbase = C_AQ + hidx * 128; g = qna; } else if (hidx < 16) { colbase = C_AK + (hidx - 8) * 128; g = kna; }
            else if (hidx < 24) { colbase = C_CQ + (hidx - 16) * 128; g = qnc; } else { colbase = C_CK + (hidx - 24) * 128; g = knc; }
            v2u* p = (v2u*)(prow + colbase + 4 * li); const v2u raw = *p;
            f32x4 x = {bflo(raw.x), bfhi(raw.x), bflo(raw.y), bfhi(raw.y)};
            float ss = (x[0] * x[0] + x[1] * x[1]) + (x[2] * x[2] + x[3] * x[3]);
#pragma unroll
            for (int o = 1; o < 32; o <<= 1) ss += __shfl_xor(ss, o);
            const float rn = rsqrtf(ss * (1.0f / 128.0f) + EPS);
            const f32x4 gg = *(const f32x4*)(g + 4 * li);
            f32x4 y = x * rn * gg;
            f32x4 pr; pr[0] = __shfl_xor(y[0], 8); pr[1] = __shfl_xor(y[1], 8); pr[2] = __shfl_xor(y[2], 8); pr[3] = __shfl_xor(y[3], 8);
            y = y * cs + pr * sn * sgn;
            v2u w; w.x = cvt_pk(y[0], y[1]); w.y = cvt_pk(y[2], y[3]); *p = w;
        }
    }
}

__device__ __forceinline__ void pc_lru(Frame& F, int l) {
    phase_ids(F); l = launder_s(l); KArgs a = kargs();
    const bf16* PROJ = (const bf16*)(F.ws + WS_PROJ);
    LAS bf16* xcb = (LAS bf16*)F.ldsl;
    LAS float* xcf = (LAS float*)(F.ldsl + 8704);
    LAS float* Sa = (LAS float*)(F.ldsl + 25600);
    LAS float* Sb = (LAS float*)(F.ldsl + 58368);
    bf16* hloc = (bf16*)(F.ws + WS_BIG); bf16* acum = hloc + (size_t)2 * ROWS * 1024;
    float* cA = (float*)(F.ws + WS_CARRY); float* cH = cA + CARRY_N;
    const bf16* LW = (const bf16*)(F.ws + WS_LRUW);
    const float* convw = ain(a, I_CONVW) + (size_t)l * 4 * 1024; const float* convb = ain(a, I_CONVB) + (size_t)l * 1024;
    const int dir = F.wave >> 2, cq = F.wave & 3, l15 = F.lane & 15, l4 = F.lane >> 4;
    for (int u = blockIdx.x; u < NB * NCH * 8; u += F.G) {
        const int n = u & 7, bc = u >> 3, c = bc % NCH, b = bc / NCH;
        const int r0 = b * TB + c * 32; const int seq_lo = (c < 8) ? b * TB : b * TB + CTXL, seq_hi = (c < 8) ? b * TB + CTXL : (b + 1) * TB;
        { const int t = F.tid >> 4, ch0 = (F.tid & 15) * 8; const int chg = n * 128 + ch0;
          float acc8[8];
          { const f32x4 b0 = *(const f32x4*)(convb + chg), b1 = *(const f32x4*)(convb + chg + 4);
#pragma unroll
            for (int e = 0; e < 4; ++e) { acc8[e] = b0[e]; acc8[4 + e] = b1[e]; } }
#pragma unroll
          for (int k = 0; k < 4; ++k) { const int rr = r0 + t - 2 + k;
              if (rr >= seq_lo && rr < seq_hi) { const v4u raw = *(const v4u*)(PROJ + (size_t)rr * INC + C_BX + chg);
                  const f32x4 w0 = *(const f32x4*)(convw + k * 1024 + chg), w1 = *(const f32x4*)(convw + k * 1024 + chg + 4);
                  acc8[0] += w0[0] * bflo(raw.x); acc8[1] += w0[1] * bfhi(raw.x); acc8[2] += w0[2] * bflo(raw.y); acc8[3] += w0[3] * bfhi(raw.y);
                  acc8[4] += w1[0] * bflo(raw.z); acc8[5] += w1[1] * bfhi(raw.z); acc8[6] += w1[2] * bflo(raw.w); acc8[7] += w1[3] * bfhi(raw.w); } }
          v4u pk; pk.x = cvt_pk(acc8[0], acc8[1]); pk.y = cvt_pk(acc8[2], acc8[3]); pk.z = cvt_pk(acc8[4], acc8[5]); pk.w = cvt_pk(acc8[6], acc8[7]);
          *(LAS v4u*)(xcb + t * 136 + ch0) = pk;
          *(LAS f32x4*)(xcf + t * 132 + ch0) = (f32x4){acc8[0], acc8[1], acc8[2], acc8[3]}; *(LAS f32x4*)(xcf + t * 132 + ch0 + 4) = (f32x4){acc8[4], acc8[5], acc8[6], acc8[7]}; }
        __syncthreads();
#pragma unroll
        for (int nt = 0; nt < 2; ++nt) {
            const int ch = cq * 32 + nt * 16 + l15, chg = n * 128 + ch;
            bf16x8 Ba[4], Bx[4];
#pragma unroll
            for (int k = 0; k < 4; ++k) {
                Ba[k] = *(const bf16x8*)(LW + ((((size_t)(l * 2 + 0) * 2 + dir) * 8 + n) * 128 + ch) * 128 + k * 32 + l4 * 8);
                Bx[k] = *(const bf16x8*)(LW + ((((size_t)(l * 2 + 1) * 2 + dir) * 8 + n) * 128 + ch) * 128 + k * 32 + l4 * 8); }
            const float ba = ain(a, I_LBA)[((size_t)l * 2 + dir) * 1024 + chg], bx = ain(a, I_LBX)[((size_t)l * 2 + dir) * 1024 + chg];
            const float lamv = ain(a, I_LLAM)[((size_t)l * 2 + dir) * 1024 + chg]; const float sp = log1pf(expf(-lamv));
#pragma unroll
            for (int mt = 0; mt < 2; ++mt) {
                f32x4 ra = {0.f, 0.f, 0.f, 0.f}, rx = {0.f, 0.f, 0.f, 0.f};
#pragma unroll
                for (int k = 0; k < 4; ++k) { const bf16x8 A = *(const LAS bf16x8*)(xcb + (mt * 16 + l15) * 136 + k * 32 + l4 * 8);
                    ra = __builtin_amdgcn_mfma_f32_16x16x32_bf16(A, Ba[k], ra, 0, 0, 0); rx = __builtin_amdgcn_mfma_f32_16x16x32_bf16(A, Bx[k], rx, 0, 0, 0); }
#pragma unroll
                for (int j = 0; j < 4; ++j) { const int tt = mt * 16 + l4 * 4 + j;
                    const float rg = 1.0f / (1.0f + expf(-(ra[j] + ba))), ig = 1.0f / (1.0f + expf(-(rx[j] + bx)));
                    const float la = -8.0f * rg * sp; const float av = expf(la); const float mult = sqrtf(-expm1f(2.0f * la));
                    Sa[(dir * 32 + tt) * 128 + ch] = av; Sb[(dir * 32 + tt) * 128 + ch] = mult * ig * xcf[tt * 132 + ch]; }
            }
        }
        __syncthreads();
        if (F.tid < 256) { const int d2 = F.tid >> 7, ch = F.tid & 127; float h = 0.f, A = 1.f;
            bf16* hp = hloc + ((size_t)d2 * ROWS + r0) * 1024 + n * 128 + ch; bf16* ap = acum + ((size_t)d2 * ROWS + r0) * 1024 + n * 128 + ch;
            for (int s = 0; s < 32; ++s) { const int t = d2 ? 31 - s : s; const float av = Sa[(d2 * 32 + t) * 128 + ch], bv = Sb[(d2 * 32 + t) * 128 + ch];
                h = av * h + bv; A *= av; hp[(size_t)t * 1024] = (bf16)(cvt_pk(h, 0.f) & 0xffffu); ap[(size_t)t * 1024] = (bf16)(cvt_pk(A, 0.f) & 0xffffu); }
            const size_t ci = (((size_t)d2 * NB + b) * NCH + c) * 1024 + n * 128 + ch; cA[ci] = A; cH[ci] = h; }
        __syncthreads();
    }
}

__device__ __forceinline__ void pd_chain(Frame& F) {
    phase_ids(F);
    const float* cA = (const float*)(F.ws + WS_CARRY); const float* cH = cA + CARRY_N; float* Hin = (float*)(F.ws + WS_CARRY) + 2 * CARRY_N;
    for (int blk = blockIdx.x; blk < 32; blk += F.G) {
        const int idx = blk * 512 + F.tid, dir = idx >> 13, b = (idx >> 10) & 7, ch = idx & 1023;
        const size_t base = (((size_t)dir * NB + b) * NCH) * 1024 + ch; float H = 0.f;
        if (dir == 0) { for (int c = 0; c < NCH; ++c) { Hin[base + (size_t)c * 1024] = H; H = cA[base + (size_t)c * 1024] * H + cH[base + (size_t)c * 1024]; } }
        else { for (int c = 7; c >= 0; --c) { Hin[base + (size_t)c * 1024] = H; H = cA[base + (size_t)c * 1024] * H + cH[base + (size_t)c * 1024]; }
               for (int c = NCH - 1; c >= 8; --c) { Hin[base + (size_t)c * 1024] = H; H = cA[base + (size_t)c * 1024] * H + cH[base + (size_t)c * 1024]; } }
    }
}
__device__ __forceinline__ void pd_attn(Frame& F, int l) {
    phase_ids(F); l = launder_s(l);
    const bf16* PROJ = (const bf16*)(F.ws + WS_PROJ); bf16* OA = (bf16*)(F.ws + WS_OA); bf16* YC = (bf16*)(F.ws + WS_YC);
    constexpr int NLAT = NB * 8 * 24, NCTX = NB * 24;
    const int nun = NLAT + (l == 0 ? NCTX : 0);
    for (int u = blockIdx.x; u < nun; u += F.G) {
        int hh, b, q0row, seq;
        if (u < NLAT) { const int qb = u & 7; hh = (u >> 3) % 24; b = u / 192; q0row = b * TB + CTXL + qb * 256; seq = TB; }
        else { const int v = u - NLAT; hh = v % 24; b = v / 24; q0row = b * TB; seq = CTXL; }
        const bf16* kb = PROJ + (size_t)b * TB * INC; const bf16* qp = PROJ + (size_t)q0row * INC;
        const bf16 *Q, *K, *V; bf16* O; int ldo;
        if (hh < 16) { const int m = hh >> 1, vh = hh & 1; Q = qp + C_AQ + m * 128; K = kb + C_AK + m * 128; V = kb + C_AV + (m >> 1) * 256 + vh * 128; O = OA + (size_t)q0row * D + m * 256 + vh * 128; ldo = D; }
        else { const int hq = hh - 16; Q = qp + C_CQ + hq * 128; K = kb + C_CK + (hq >> 2) * 128; V = kb + C_CV + (hq >> 2) * 128; O = YC + (size_t)q0row * 1024 + hq * 128; ldo = 1024; }
        att::attn_dense_body(Q, K, V, O, ldo, seq, (char*)F.lds);
        __syncthreads();
    }
}

__device__ __forceinline__ void pe_combine(Frame& F, int l) {
    phase_ids(F); l = launder_s(l); KArgs a = kargs();
    bf16* OA = (bf16*)(F.ws + WS_OA); bf16* YA = (bf16*)(F.ws + WS_YA); bf16* YB = (bf16*)(F.ws + WS_YB); const bf16* PROJ = (const bf16*)(F.ws + WS_PROJ);
    const bf16* hloc = (const bf16*)(F.ws + WS_BIG); const bf16* acum = hloc + (size_t)2 * ROWS * 1024;
    const float* Hin = (const float*)(F.ws + WS_CARRY) + 2 * CARRY_N;
    const float lam = ((const float*)(F.ws + WS_MISC + MISC_LAM))[l]; const float omli = 1.0f - (l == 0 ? 0.2f : 0.3555090676f);
    const f32x4 sg = *(const f32x4*)(ain(a, I_SUBN) + (size_t)l * 256 + 4 * F.lane);
    for (int r = F.gw; r < ROWS; r += F.NGW) {
        int b, i; row_split(r, b, i); if (l == 1 && i < CTXL) continue;
        bf16* oa = OA + (size_t)r * D;
        v2u raw[8];
#pragma unroll
        for (int m = 0; m < 8; ++m) raw[m] = *(const v2u*)(oa + m * 256 + 4 * F.lane);
#pragma unroll
        for (int h = 0; h < 4; ++h) { const v2u p = raw[2 * h], q = raw[2 * h + 1];
            f32x4 o = {bflo(p.x) - lam * bflo(q.x), bfhi(p.x) - lam * bfhi(q.x), bflo(p.y) - lam * bflo(q.y), bfhi(p.y) - lam * bfhi(q.y)};
            float ss = (o[0] * o[0] + o[1] * o[1]) + (o[2] * o[2] + o[3] * o[3]); ss = wave_sum(ss);
            const float rn = rsqrtf(ss * (1.0f / 256.0f) + EPS) * omli;
            o = o * rn * sg; v2u w; w.x = cvt_pk(o[0], o[1]); w.y = cvt_pk(o[2], o[3]); *(v2u*)(YA + (size_t)r * 1024 + h * 256 + 4 * F.lane) = w; }
        const int c = i >> 5;
        const size_t hf = ((size_t)(0 * NB + b) * NCH + c) * 1024, hb = ((size_t)(1 * NB + b) * NCH + c) * 1024;
#pragma unroll
        for (int hv = 0; hv < 2; ++hv) { const int ch = F.lane * 16 + hv * 8;
            const v4u lf = *(const v4u*)(hloc + (size_t)r * 1024 + ch), af = *(const v4u*)(acum + (size_t)r * 1024 + ch);
            const v4u lb = *(const v4u*)(hloc + ((size_t)ROWS + r) * 1024 + ch), ab = *(const v4u*)(acum + ((size_t)ROWS + r) * 1024 + ch);
            const v4u by = *(const v4u*)(PROJ + (size_t)r * INC + C_BY + ch);
            const f32x4 Hf0 = *(const f32x4*)(Hin + hf + ch), Hf1 = *(const f32x4*)(Hin + hf + ch + 4), Hb0 = *(const f32x4*)(Hin + hb + ch), Hb1 = *(const f32x4*)(Hin + hb + ch + 4);
            float y[8];
#define FIX(e, LF, AF, LB, AB, BY, HF, HB, GET) { const float hsum = GET(LF) + GET(AF) * HF + GET(LB) + GET(AB) * HB; const float x = GET(BY); \
                const float u2 = 0.7978845608f * (x + 0.044715f * x * x * x); const float th = 1.0f - 2.0f / (1.0f + __expf(2.0f * u2)); y[e] = hsum * 0.5f * x * (1.0f + th); }
            FIX(0, lf.x, af.x, lb.x, ab.x, by.x, Hf0[0], Hb0[0], bflo) FIX(1, lf.x, af.x, lb.x, ab.x, by.x, Hf0[1], Hb0[1], bfhi)
            FIX(2, lf.y, af.y, lb.y, ab.y, by.y, Hf0[2], Hb0[2], bflo) FIX(3, lf.y, af.y, lb.y, ab.y, by.y, Hf0[3], Hb0[3], bfhi)
            FIX(4, lf.z, af.z, lb.z, ab.z, by.z, Hf1[0], Hb1[0], bflo) FIX(5, lf.z, af.z, lb.z, ab.z, by.z, Hf1[1], Hb1[1], bfhi)
            FIX(6, lf.w, af.w, lb.w, ab.w, by.w, Hf1[2], Hb1[2], bflo) FIX(7, lf.w, af.w, lb.w, ab.w, by.w, Hf1[3], Hb1[3], bfhi)
#undef FIX
            v4u w; w.x = cvt_pk(y[0], y[1]); w.y = cvt_pk(y[2], y[3]); w.z = cvt_pk(y[4], y[5]); w.w = cvt_pk(y[6], y[7]);
            *(v4u*)(YB + (size_t)r * 1024 + ch) = w; }
    }
}

__device__ __forceinline__ void ph_norm2_route(Frame& F, int l) {
    phase_ids(F); l = launder_s(l); KArgs a = kargs();
    const float* hl = aout(a); const float* hc = (const float*)(F.ws + WS_HC);
    const float* mod = (const float*)(F.ws + WS_MOD) + (size_t)l * 9 * (NMOD * D);
    const float* g = ain(a, I_N2G) + (size_t)l * D; bf16* V = (bf16*)(F.ws + WS_ACT);
    LAS bf16* Thi = (LAS bf16*)F.ldsl; LAS bf16* Tlo = (LAS bf16*)(F.ldsl + 65792);
    LAS float* red = (LAS float*)F.ldsl;
    LAS float* logit = (LAS float*)(F.ldsl + 24576);
    const bf16* wr = (const bf16*)(F.ws + WS_MISC + MISC_WR) + (size_t)l * 2 * 48 * 2048;
    unsigned* cnt = (unsigned*)(F.ws + WS_CTL) + CW_CNT + 64 * l;
    int* tok_e = (int*)(F.ws + WS_ROUTE + RT_E); int* tok_pos = (int*)(F.ws + WS_ROUTE + RT_POS); float* tok_p = (float*)(F.ws + WS_ROUTE + RT_P);
    const int l15 = F.lane & 15, l4 = F.lane >> 4;
    for (int blk = blockIdx.x; blk < ROWS / 16; blk += F.G) {
        if (l == 1 && (blk % (TB / 16)) < CTXL / 16) continue;
#pragma unroll 1
        for (int rr = 0; rr < 2; ++rr) { const int lr = F.wave * 2 + rr, r = blk * 16 + lr;
            int b, i; row_split(r, b, i); bool ctx; const size_t off = hrow_off(b, i, ctx);
            const f32x4* xr = (const f32x4*)((ctx ? hc : hl) + off) + F.lane;
            f32x4 v[8];
#pragma unroll
            for (int j = 0; j < 8; ++j) v[j] = xr[64 * j];
            const float* mb = mod + (size_t)(ctx ? 8 : b) * (NMOD * D);
            norm_mod(v, g, mb + 3 * D, mb + 4 * D, F.lane);
            v2u* o = (v2u*)(V + (size_t)r * D) + F.lane;
#pragma unroll
            for (int j = 0; j < 8; ++j) { v2u w; w.x = cvt_pk(v[j][0], v[j][1]); w.y = cvt_pk(v[j][2], v[j][3]); o[64 * j] = w;
                v2u wl; wl.x = cvt_pk(v[j][0] - bflo(w.x), v[j][1] - bfhi(w.x)); wl.y = cvt_pk(v[j][2] - bflo(w.y), v[j][3] - bfhi(w.y));
                *(LAS v2u*)(Thi + lr * 2056 + (F.lane + 64 * j) * 4) = w; *(LAS v2u*)(Tlo + lr * 2056 + (F.lane + 64 * j) * 4) = wl; } }
        __syncthreads();
        f32x4 acc[3];
#pragma unroll
        for (int ct = 0; ct < 3; ++ct) acc[ct] = (f32x4){0.f, 0.f, 0.f, 0.f};
#pragma unroll 2
        for (int ks = 0; ks < 8; ++ks) { const int k0 = (F.wave * 8 + ks) * 32 + l4 * 8;
            const bf16x8 Ah = *(const LAS bf16x8*)(Thi + l15 * 2056 + k0), Al = *(const LAS bf16x8*)(Tlo + l15 * 2056 + k0);
#pragma unroll
            for (int ct = 0; ct < 3; ++ct) { const bf16x8 Bh = *(const bf16x8*)(wr + (size_t)(ct * 16 + l15) * 2048 + k0), Bl = *(const bf16x8*)(wr + (size_t)(48 + ct * 16 + l15) * 2048 + k0);
                acc[ct] = __builtin_amdgcn_mfma_f32_16x16x32_bf16(Ah, Bh, acc[ct], 0, 0, 0);
                acc[ct] = __builtin_amdgcn_mfma_f32_16x16x32_bf16(Ah, Bl, acc[ct], 0, 0, 0);
                acc[ct] = __builtin_amdgcn_mfma_f32_16x16x32_bf16(Al, Bh, acc[ct], 0, 0, 0); } }
        __syncthreads();
#pragma unroll
        for (int ct = 0; ct < 3; ++ct)
#pragma unroll
            for (int j = 0; j < 4; ++j) red[(F.wave * 16 + l4 * 4 + j) * 48 + ct * 16 + l15] = acc[ct][j];
        __syncthreads();
        for (int o = F.tid; o < 16 * 36; o += 512) { const int row = o / 36, e = o % 36; float s = 0.f;
#pragma unroll
            for (int w = 0; w < 8; ++w) s += red[(w * 16 + row) * 48 + e];
            s += e < 4 ? ain(a, I_BGRP)[l * 4 + e] : ain(a, I_BRT)[l * 32 + (e - 4)];
            logit[o] = s; }
        __syncthreads();
        if (F.tid < 16) { const LAS float* lg = logit + F.tid * 36; const int r = blk * 16 + F.tid;
            int gi = 0; float gm = lg[0];
            for (int e = 1; e < 4; ++e) { const float v = lg[e]; if (v > gm) { gm = v; gi = e; } }
            float gs = 0.f; for (int e = 0; e < 4; ++e) gs += expf(lg[e] - gm);
            const float gw = 1.0f / gs;
            const LAS float* el = lg + 4 + gi * 8;
            int i1 = 0; float v1 = el[0];
            for (int e = 1; e < 8; ++e) { const float v = el[e]; if (v > v1) { v1 = v; i1 = e; } }
            int i2 = -1; float v2 = -3.0e38f;
            for (int e = 0; e < 8; ++e) { const float v = el[e]; if (e != i1 && v > v2) { v2 = v; i2 = e; } }
            const float p1 = 1.0f / (1.0f + expf(v2 - v1)); const float p2 = 1.0f - p1;
            const int e1 = gi * 8 + i1, e2 = gi * 8 + i2;
            const unsigned pos1 = atomicAdd(&cnt[e1], 1u), pos2 = atomicAdd(&cnt[e2], 1u);
            tok_e[2 * r] = e1; tok_e[2 * r + 1] = e2; tok_pos[2 * r] = (int)pos1; tok_pos[2 * r + 1] = (int)pos2; tok_p[2 * r] = p1 * gw; tok_p[2 * r + 1] = p2 * gw; }
        __syncthreads();
    }
}

__device__ __forceinline__ void pi_scatter(Frame& F, int l) {
    phase_ids(F); l = launder_s(l);
    const unsigned* cnt = (const unsigned*)(F.ws + WS_CTL) + CW_CNT + 64 * l;
    LAS int* base = (LAS int*)F.ldsl;
    if (F.tid == 0) { int run = 0; for (int e = 0; e < NE; ++e) { base[e] = run; run += (int)((__hip_atomic_load(&cnt[e], __ATOMIC_RELAXED, __HIP_MEMORY_SCOPE_AGENT) + 255u) & ~255u); } base[NE] = run; }
    __syncthreads();
    const int* tok_e = (const int*)(F.ws + WS_ROUTE + RT_E); const int* tok_pos = (const int*)(F.ws + WS_ROUTE + RT_POS); int* tok_dest = (int*)(F.ws + WS_ROUTE + RT_DEST);
    const bf16* V = (const bf16*)(F.ws + WS_ACT); bf16* VS = (bf16*)(F.ws + WS_BIG);
    for (int s = F.gw; s < 2 * ROWS; s += F.NGW) { const int r = s >> 1; if (l == 1 && (r % TB) < CTXL) continue; const int e = tok_e[s], pos = tok_pos[s]; const int dest = base[e] + pos;
        if (F.lane == 0) tok_dest[s] = dest;
        const v4u* src = (const v4u*)(V + (size_t)r * D) + F.lane; v4u* dst = (v4u*)(VS + (size_t)dest * D) + F.lane;
#pragma unroll
        for (int j = 0; j < 4; ++j) dst[64 * j] = src[64 * j]; }
    if (blockIdx.x == 0 && F.tid == 0) { int* tt = (int*)(F.ws + WS_MISC + MISC_TILE); int nt = 0;
        for (int e = 0; e < NE; ++e) { const int n = (base[e + 1] - base[e]) >> 8; for (int t = 0; t < n; ++t) tt[4 + nt++] = e; }
        tt[0] = nt; }
    __syncthreads();
}

__device__ __forceinline__ void pl_moe_combine(Frame& F, int l) {
    phase_ids(F); l = launder_s(l); KArgs a = kargs();
    float* hl = aout(a); float* hc = (float*)(F.ws + WS_HC);
    const float* mod = (const float*)(F.ws + WS_MOD) + (size_t)l * 9 * (NMOD * D);
    const bf16* YS = (const bf16*)(F.ws + WS_BIG);
    const int* tok_dest = (const int*)(F.ws + WS_ROUTE + RT_DEST); const float* tok_p = (const float*)(F.ws + WS_ROUTE + RT_P);
    for (int r = F.gw; r < ROWS; r += F.NGW) {
        int b, i; row_split(r, b, i); if (l == 1 && i < CTXL) continue; bool ctx; const size_t off = hrow_off(b, i, ctx);
        float* hp = (ctx ? hc : hl) + off; const float* mg = mod + (size_t)(ctx ? 8 : b) * (NMOD * D) + 5 * D;
        const int d0 = tok_dest[2 * r], d1 = tok_dest[2 * r + 1]; const float p0 = tok_p[2 * r], p1 = tok_p[2 * r + 1];
        const v2u* y0 = (const v2u*)(YS + (size_t)d0 * D) + F.lane; const v2u* y1 = (const v2u*)(YS + (size_t)d1 * D) + F.lane;
#pragma unroll
        for (int j = 0; j < 8; ++j) { const int c = (F.lane + 64 * j) * 4; const v2u u0 = y0[64 * j], u1 = y1[64 * j];
            const f32x4 g = *(const f32x4*)(mg + c); f32x4 h = *(const f32x4*)(hp + c);
            h[0] += g[0] * (p0 * bflo(u0.x) + p1 * bflo(u1.x)); h[1] += g[1] * (p0 * bfhi(u0.x) + p1 * bfhi(u1.x));
            h[2] += g[2] * (p0 * bflo(u0.y) + p1 * bflo(u1.y)); h[3] += g[3] * (p0 * bfhi(u0.y) + p1 * bfhi(u1.y));
            *(f32x4*)(hp + c) = h; }
    }
}

constexpr int PH_PER_LAYER = 12, N_PHASES = 1 + 2 * PH_PER_LAYER;
#ifndef PHMASK
#define PHMASK 0xffffffffu
#endif
#define EN(j) ((PHMASK >> (j)) & 1u)
#define IN(k) (lo <= (k) && (k) < hi)
#define SEAM(k) do { if (IN(k) && IN((k) + 1)) xcd_barrier(bar); } while (0)
#ifndef REPMASK
#define REPMASK 0u
#endif
#define RUNPH(j, k, ...) if (EN(j) && IN(p + k)) { { __VA_ARGS__ } if constexpr (((REPMASK) >> (j)) & 1u) { __syncthreads(); { __VA_ARGS__ } } }
template <int l> __device__ __forceinline__ void layer_phases(Frame& F, const int lo, const int hi, const XcdBarrier& bar) {
        constexpr int p = 1 + l * PH_PER_LAYER;
        constexpr int LAT = (l == 1);
        constexpr int NPAN = LAT ? 64 : 72;
        RUNPH(1, 0,  pa_norm1(F, l); if (l > 0) { __syncthreads(); conv_weights(F, l); if constexpr ((REPMASK) & 1u) { __syncthreads(); conv_weights(F, l); } } )
        SEAM(p + 0);
        RUNPH(2, 1,  phase_ids(F); unsigned char* ws = F.ws; KArgs a = kargs(); const int ll = launder_s(l);
            pg8::Gemm1Order S{pg8::make_gb((const bf16*)(ws + WS_ACT), D, (const bf16*)(ws + WS_WIN), D), F.G, (int)blockIdx.x, LAT};
            pg8::EpiBf16T<true> E{(bf16*)(ws + WS_PROJ), INC, 0xffff, ain(a, I_BGATE) + (size_t)ll * 3 * D}; pg8::gemm_phase(F.ldsl, D, D, D, S, E); )
        SEAM(p + 1);
        if (EN(3) && IN(p + 2)) { pc_qk(F, l); __syncthreads(); pc_lru(F, l); if constexpr (((REPMASK) >> 3) & 1u) { __syncthreads(); pc_lru(F, l); } }
        SEAM(p + 2);
        RUNPH(4, 3,  pd_chain(F); pd_attn(F, l); )
        SEAM(p + 3);
        RUNPH(5, 4,  pe_combine(F, l); )
        SEAM(p + 4);
        RUNPH(6, 5,  phase_ids(F); unsigned char* ws = F.ws;
            pg8::BranchOrder S{ pg8::StaticOrder{pg8::make_gb((const bf16*)(ws + WS_YA), 1024, (const bf16*)(ws + WS_WBR), 1024), NPAN, D / 256, F.G, (int)blockIdx.x, LAT},
                                (size_t)(WS_YB - WS_YA) };
            static_assert(WS_YC - WS_YB == WS_YB - WS_YA, "branch inputs equally spaced");
            pg8::EpiChain E{(bf16*)(ws + WS_ACT), (const bf16*)(ws + WS_PROJ)}; pg8::gemm_phase(F.ldsl, 1024, 1024, 1024, S, E); )
        SEAM(p + 5);
        RUNPH(7, 6,  phase_ids(F); unsigned char* ws = F.ws; KArgs a = kargs(); const int ll = launder_s(l);
            pg8::StaticOrder S{pg8::make_gb((const bf16*)(ws + WS_ACT), D, (const bf16*)(ws + WS_WOUT), D), NPAN, D / 256, F.G, (int)blockIdx.x, LAT};
            pg8::EpiWout E{ll == 0 ? ain(a, I_X) : (const float*)aout(a), ll == 0 ? ain(a, I_CTX) : (const float*)(ws + WS_HC), aout(a), (float*)(ws + WS_HC), (const float*)(ws + WS_MOD) + (size_t)ll * 9 * (NMOD * D)};
            pg8::gemm_phase(F.ldsl, D, D, D, S, E); )
        SEAM(p + 6);
        RUNPH(8, 7,  ph_norm2_route(F, l); )
        SEAM(p + 7);
        RUNPH(9, 8,  pi_scatter(F, l); )
        SEAM(p + 8);
        RUNPH(10, 9,  phase_ids(F); unsigned char* ws = F.ws; const int* tt = (const int*)(ws + WS_MISC + MISC_TILE);
            pg8::MoeOrder S{pg8::make_gb((const bf16*)(ws + WS_BIG), D, (const bf16*)(ws + WS_W13), D), tt + 4, tt[0], 4, F.G, (int)blockIdx.x};
            pg8::EpiUp E{(bf16*)(ws + WS_OA)}; pg8::gemm_phase(F.ldsl, D, D, D, S, E); )
        SEAM(p + 9);
        RUNPH(11, 10,  phase_ids(F); unsigned char* ws = F.ws; const int* tt = (const int*)(ws + WS_MISC + MISC_TILE);
            pg8::MoeOrder S{pg8::make_gb((const bf16*)(ws + WS_OA), DE, (const bf16*)(ws + WS_W2), DE), tt + 4, tt[0], 8, F.G, (int)blockIdx.x};
            pg8::EpiBf16 E{(bf16*)(ws + WS_BIG), D, 7, nullptr}; pg8::gemm_phase(F.ldsl, DE, DE, DE, S, E); )
        SEAM(p + 10);
        RUNPH(12, 11,  pl_moe_combine(F, l); )
        SEAM(p + 11);
}
__global__ void __launch_bounds__(512, 2) mega_fwd(Args args) {
    extern __shared__ __attribute__((aligned(16))) unsigned char lds[];
    Frame F;
    F.lds0 = lds; F.lds = lds; F.ldsl = (LAS unsigned char*)lds; F.ws = args.ws;
    F.tid = threadIdx.x; F.lane = F.tid & 63; F.wave = __builtin_amdgcn_readfirstlane(F.tid >> 6);
    F.G = gridDim.x; F.gw = blockIdx.x * 8 + F.wave; F.NGW = F.G * 8;
    volatile LAS unsigned* misc = (volatile LAS unsigned*)(F.ldsl + LDS_MISC_OFF);
    if (F.tid < 4) misc[F.tid] = 0u;
    __syncthreads();
    const int lo = args.ph_lo, hi = args.ph_hi;
    XcdBarrier bar; bar.bar = (unsigned*)(args.ws + WS_CTL) + CW_BAR; bar.x = 0; bar.st = misc;
    if (hi - lo > 1) bar = xcd_barrier_post((unsigned*)(args.ws + WS_CTL) + CW_BAR, misc);
    if (EN(0) && IN(0)) { p0_misc(F); __syncthreads(); conv_weights(F, 0); if constexpr ((REPMASK) & 1u) { __syncthreads(); conv_weights(F, 0); } }
    SEAM(0);
    layer_phases<0>(F, lo, hi, bar);
    layer_phases<1>(F, lo, hi, bar);
#undef IN
#undef SEAM
}

#ifndef MK_SINGLE
#define MK_SINGLE 1
#endif
extern "C" void kernel_launch(void* const* d_in, const int* in_sizes, int n_in, void* d_out, int out_size, void* d_ws, size_t ws_size, hipStream_t stream) {
    static int grid = 0;
    if (grid == 0) {
        if (n_in != 34 || out_size != NB * SEQ * D || ws_size < WS_END) { fprintf(stderr, "kernel_launch: unexpected shapes (n_in %d out %d ws %zu, need ws >= %zu)\n", n_in, out_size, ws_size, (size_t)WS_END); grid = -1; return; }
        int dev = 0, cus = 0, per_cu = 0;
        if (hipGetDevice(&dev) != hipSuccess || hipDeviceGetAttribute(&cus, hipDeviceAttributeMultiprocessorCount, dev) != hipSuccess) { grid = -1; return; }
        if (hipFuncSetAttribute((const void*)mega_fwd, hipFuncAttributeMaxDynamicSharedMemorySize, LDS_BYTES) != hipSuccess) { fprintf(stderr, "kernel_launch: hipFuncSetAttribute failed\n"); grid = -1; return; }
        if (hipOccupancyMaxActiveBlocksPerMultiprocessor(&per_cu, (const void*)mega_fwd, 512, LDS_BYTES) != hipSuccess || per_cu < 1) fprintf(stderr, "kernel_launch: occupancy query says %d\n", per_cu);
        (void)hipGetLastError();
        grid = cus;
    }
    if (grid < 0) return;
    (void)hipMemsetAsync((char*)d_ws + WS_CTL, 0, CTL_ZERO_BYTES, stream);
    Args a{};
    for (int i = 0; i < 34; ++i) a.in[i] = (const float*)d_in[i];
    a.out = (float*)d_out; a.ws = (unsigned char*)d_ws;
#if MK_SINGLE
    a.ph_lo = 0; a.ph_hi = N_PHASES;
    hipLaunchKernelGGL(mega_fwd, dim3(grid), dim3(512), LDS_BYTES, stream, a);
#else
    for (int p = 0; p < N_PHASES; ++p) { a.ph_lo = p; a.ph_hi = p + 1; hipLaunchKernelGGL(mega_fwd, dim3(grid), dim3(512), LDS_BYTES, stream, a); }
#endif
    const hipError_t le = hipPeekAtLastError();
    if (le != hipSuccess) fprintf(stderr, "kernel_launch: launch failed: %s\n", hipGetErrorName(le));
}
```

```cpp
#include <hip/hip_runtime.h>
#include <cstdio>
#include <cstdint>

#define GAS __attribute__((address_space(1)))
#define LAS __attribute__((address_space(3)))
typedef unsigned short bf16;
typedef unsigned v4u __attribute__((ext_vector_type(4)));
typedef unsigned v2u __attribute__((ext_vector_type(2)));
typedef float f32x4 __attribute__((ext_vector_type(4)));
typedef float f32x2 __attribute__((ext_vector_type(2)));
typedef short bf16x8 __attribute__((ext_vector_type(8)));
#define LDS_WAIT() asm volatile("s_waitcnt lgkmcnt(0)" ::: "memory")
#define VM_WAIT() asm volatile("s_waitcnt vmcnt(0)" ::: "memory")

constexpr int D = 2048, NB = 8, SEQ = 2048, CTXL = 256, TB = SEQ + CTXL, ROWS = NB * TB;
constexpr int INC = 12800;
constexpr int C_AQ = 0, C_AK = 1024, C_AV = 2048, C_BX = 3072, C_BY = 4096, C_CQ = 5120, C_CK = 6144, C_CV = 6400, C_G = 6656;
constexpr int NE = 32, DE = 512, NMOD = 6;
constexpr int MS = 45056;
constexpr int NCH = TB / 32;
constexpr float EPS = 1e-6f;

constexpr size_t MiB = 1u << 20;
constexpr size_t WS_CTL = 0, CTL_ZERO_BYTES = 1 * MiB;
constexpr size_t WS_MOD = 1 * MiB;
constexpr size_t WS_ROPE = 2 * MiB;
constexpr size_t WS_MISC = 3 * MiB;
constexpr size_t WS_LRUW = 4 * MiB;
constexpr size_t WS_ROUTE = 6 * MiB;
constexpr size_t WS_CARRY = 8 * MiB;
constexpr size_t WS_WIN = 24 * MiB;
constexpr size_t WS_WBR = 74 * MiB;
constexpr size_t WS_WOUT = 86 * MiB;
constexpr size_t WS_W13 = 94 * MiB;
constexpr size_t WS_W2 = 222 * MiB;
constexpr size_t WS_HC = 286 * MiB;
constexpr size_t WS_ACT = 302 * MiB;
constexpr size_t WS_PROJ = 374 * MiB;
constexpr size_t WS_BIG = 824 * MiB;
constexpr size_t WS_OA = 1000 * MiB;
constexpr size_t WS_YA = 1072 * MiB;
constexpr size_t WS_YB = 1108 * MiB;
constexpr size_t WS_YC = 1144 * MiB;
constexpr size_t WS_W13B = 1185 * MiB;
constexpr size_t WS_W2B = 1313 * MiB;
constexpr size_t WS_END = 1377 * MiB;
constexpr int CW_BAR = 4096;
constexpr int CW_CNT = 8192;
constexpr size_t MISC_LAM = 0;
constexpr size_t MISC_TILE = 1024;
constexpr size_t MISC_WR = 4096;
constexpr size_t MISC_SP = 960 * 1024;
constexpr size_t RT_E = 0, RT_POS = 256 * 1024, RT_P = 512 * 1024, RT_DEST = 768 * 1024;
constexpr size_t CARRY_N = (size_t)2 * NB * NCH * 1024;
constexpr int LDS_BYTES = 147456;
constexpr int LDS_MISC_OFF = 135168;

__device__ __forceinline__ float bf2f(unsigned short b) { return __uint_as_float(((unsigned)b) << 16); }
__device__ __forceinline__ float bflo(unsigned u) { return __uint_as_float(u << 16); }
__device__ __forceinline__ float bfhi(unsigned u) { return __uint_as_float(u & 0xffff0000u); }
__device__ __forceinline__ unsigned cvt_pk(float lo, float hi) { unsigned r; asm volatile("v_cvt_pk_bf16_f32 %0, %1, %2" : "=v"(r) : "v"(lo), "v"(hi)); return r; }
__device__ __forceinline__ float sigmoidf_(float x) { return 1.0f / (1.0f + __expf(-x)); }
template <int CTRL> __device__ __forceinline__ float dpp_f(float oldv, float src) {
    return __builtin_bit_cast(float, __builtin_amdgcn_update_dpp(__builtin_bit_cast(int, oldv), __builtin_bit_cast(int, src), CTRL, 0xf, 0xf, false));
}

__device__ __forceinline__ float row16_sum(float v) {
    v += dpp_f<0xB1>(0.f, v); v += dpp_f<0x4E>(0.f, v); v += dpp_f<0x141>(0.f, v); v += dpp_f<0x140>(0.f, v); return v;
}
__device__ __forceinline__ float wave_sum(float v) {
    v = row16_sum(v); v += __shfl_xor(v, 16);
    { auto rr = __builtin_amdgcn_permlane32_swap(__float_as_uint(v), __float_as_uint(v), false, false); v = __uint_as_float(rr[0]) + __uint_as_float(rr[1]); }
    return v;
}
namespace pg8 {
constexpr int BM = 256, BK = 64, HALF = 128, HTB = HALF * BK * 2, STAGE_BYTES = 8 * HTB, NXCD = 8, WGM = 8;
__host__ __device__ __forceinline__ int lds_byte(int r, int c) { const int st = (r >> 4) * 2 + (c >> 5), rr = r & 15, cc = c & 31, ob = rr * 64 + cc * 2; return st * 1024 + (ob ^ (((ob >> 9) & 1) << 5)); }
__host__ __device__ __forceinline__ void stage_rc(int b, int& R, int& C) { const int st = b / 1024, sb = b % 1024, swz = sb ^ (((sb >> 9) & 1) << 5); R = (st >> 1) * 16 + swz / 64; C = (st & 1) * 32 + (swz % 64) / 2; }
__host__ __device__ __forceinline__ int perm32(int rho) { const int n = rho >> 4, i = rho & 15; return 8 * (i >> 2) + 4 * n + (i & 3); }
struct Unit { int pm, pn, fl; };
struct GB { const char* A; const char* B; size_t tA, tB; };
__device__ __forceinline__ GB make_gb(const bf16* A, int lda, const bf16* B, int ldb) { GB g; g.A = (const char*)A; g.B = (const char*)B; g.tA = (size_t)BM * lda * 2; g.tB = (size_t)BM * ldb * 2; return g; }
__device__ __forceinline__ void static_tile(int nM, int nN, int L, int& pm, int& pn) {
    const int nwg = nM * nN; int wgid = L; { const int q = nwg / NXCD, r = nwg % NXCD, xcd = wgid % NXCD, off = wgid / NXCD; wgid = (xcd < r ? xcd * (q + 1) : r * (q + 1) + (xcd - r) * q) + off; }
    const int nig = WGM * nN, gid = wgid / nig, fm = gid * WGM, gsz = (nM - fm) < WGM ? (nM - fm) : WGM;
    pm = fm + ((wgid % nig) % gsz); pn = (wgid % nig) / gsz;
}
__device__ __forceinline__ int lat_panel(int pl) { return (pl >> 3) * 9 + 1 + (pl & 7); }
struct StaticOrder {
    static constexpr bool GATHER = false; __device__ __forceinline__ unsigned rowoff(const Unit&, int) const { return 0u; }
    GB gb; int nM, nN, G, c, lat;
    __device__ __forceinline__ bool next(int i, Unit& u) const {
        const long L = (long)i * G + c; if (L >= (long)nM * nN) return false;
        int pm, pn; static_tile(nM, nN, (int)L, pm, pn); u.pm = lat ? lat_panel(pm) : pm; u.pn = pn; u.fl = 0; return true;
    }
    __device__ __forceinline__ const char* a_base(const Unit& u) const { return gb.A + (size_t)u.pm * gb.tA; }
    __device__ __forceinline__ const char* b_base(const Unit& u) const { return gb.B + (size_t)u.pn * gb.tB; }
    __device__ __forceinline__ bool zero_after(const Unit&) const { return true; }
};
struct Gemm1Order {
    static constexpr bool GATHER = false; __device__ __forceinline__ unsigned rowoff(const Unit&, int) const { return 0u; }
    GB gb; int G, c, l1;
    __device__ __forceinline__ bool next(int i, Unit& u) const {
        const long L = (long)i * G + c; int pm, pn; u.fl = 0;
        if (!l1) { if (L >= 72 * 50) return false; static_tile(72, 50, (int)L, pm, pn); }
        else if (L < 64 * 50) { static_tile(64, 50, (int)L, pm, pn); pm = lat_panel(pm); }
        else { const int q = (int)L - 64 * 50; if (q >= 8 * 14) return false; const int k = q % 14; pm = (q / 14) * 9; pn = k < 12 ? 4 + k : 12 + k; }
        u.pm = pm; u.pn = pn; return true;
    }
    __device__ __forceinline__ const char* a_base(const Unit& u) const { return gb.A + (size_t)u.pm * gb.tA; }
    __device__ __forceinline__ const char* b_base(const Unit& u) const { return gb.B + (size_t)u.pn * gb.tB; }
    __device__ __forceinline__ bool zero_after(const Unit&) const { return true; }
};
struct BranchOrder {
    static constexpr bool GATHER = false; __device__ __forceinline__ unsigned rowoff(const Unit&, int) const { return 0u; }
    StaticOrder so; size_t astride;
    __device__ __forceinline__ bool next(int i, Unit& u) const { if (!so.next(i / 3, u)) return false; u.fl = i % 3; return true; }
    __device__ __forceinline__ const char* a_base(const Unit& u) const { return so.gb.A + (size_t)u.fl * astride + (size_t)u.pm * so.gb.tA; }
    __device__ __forceinline__ const char* b_base(const Unit& u) const { return so.gb.B + (size_t)u.fl * ((size_t)D * 1024 * 2) + (size_t)u.pn * so.gb.tB; }
    __device__ __forceinline__ bool zero_after(const Unit& u) const { return u.fl == 2; }
};
constexpr int MT_E = 1, MT_P0 = 193, MT_CNT = 385, MT_BASE = 417, MT_WORDS = 452, LCAP = 2 * ROWS;
template <bool G_> struct MoeOrderT {
    static constexpr bool GATHER = G_;
    GB gb; const LAS int* tab; const int* list; unsigned rowbytes; int NT, G, c;
    __device__ __forceinline__ bool next(int i, Unit& u) const {
        const long L0 = (long)i * G + c; const int nwg = tab[0] * NT; if (L0 >= nwg) return false;
        int L = (int)L0; { const int q = nwg / NXCD, r = nwg % NXCD, xcd = L % NXCD, off = L / NXCD; L = (xcd < r ? xcd * (q + 1) : r * (q + 1) + (xcd - r) * q) + off; }
        const int mt = L / NT, pnl = L % NT;
        u.pm = mt; u.pn = tab[MT_E + mt] * NT + pnl; u.fl = 0; return true;
    }
    __device__ __forceinline__ const char* a_base(const Unit& u) const { return gb.A + (size_t)u.pm * gb.tA; }
    __device__ __forceinline__ const char* b_base(const Unit& u) const { return gb.B + (size_t)u.pn * gb.tB; }
    __device__ __forceinline__ bool zero_after(const Unit&) const { return true; }
    __device__ __forceinline__ unsigned rowoff(const Unit& u, int row) const {
        const int e = tab[MT_E + u.pm], pos = tab[MT_P0 + u.pm] + row; const int ent = pos < tab[MT_CNT + e] ? list[(size_t)e * LCAP + pos] : 0;
        return (unsigned)(ent >> 1) * rowbytes;
    }
};
typedef MoeOrderT<false> MoeOrder;
typedef MoeOrderT<true> MoeOrderG;
template <bool GATE> struct EpiBf16T {
    static constexpr bool PERM = true;
    bf16* O; int ldc; int pn_mask; const float* bgate;
    __device__ __forceinline__ void operator()(f32x4 (&acc)[2][2][4][2], const Unit& u, int wr, int wc, int fr, int fq) const {
        const int row0 = u.pm * BM + wr * 64 + fr; const int col0 = (u.pn & pn_mask) * BM + wc * 32 + 8 * fq;
        const bool gate = GATE && (u.pn >= C_G / BM);
        f32x4 bg[2][2];
        if (gate) {
#pragma unroll
            for (int bj = 0; bj < 2; ++bj) { bg[bj][0] = *(const f32x4*)(bgate + (col0 - C_G) + bj * HALF); bg[bj][1] = *(const f32x4*)(bgate + (col0 - C_G) + bj * HALF + 4); } }
#pragma unroll
        for (int ai = 0; ai < 2; ++ai)
#pragma unroll
            for (int m = 0; m < 4; ++m) { bf16* rowp = O + (size_t)(row0 + ai * HALF + m * 16) * ldc + col0;
#pragma unroll
                for (int bj = 0; bj < 2; ++bj) { f32x4 v0 = acc[ai][bj][m][0], v1 = acc[ai][bj][m][1];
                    if (gate) {
#pragma unroll
                        for (int e = 0; e < 4; ++e) { v0[e] = sigmoidf_(v0[e] + bg[bj][0][e]); v1[e] = sigmoidf_(v1[e] + bg[bj][1][e]); } }
                    v4u w; w.x = cvt_pk(v0[0], v0[1]); w.y = cvt_pk(v0[2], v0[3]); w.z = cvt_pk(v1[0], v1[1]); w.w = cvt_pk(v1[2], v1[3]);
                    *(v4u*)(rowp + bj * HALF) = w; } }
    }
};
typedef EpiBf16T<false> EpiBf16;
struct EpiChain {
    static constexpr bool PERM = false;
    bf16* Mb; const bf16* proj;
    __device__ __forceinline__ void operator()(f32x4 (&acc)[2][2][4][2], const Unit& u, int wr, int wc, int fr, int fq) const {
        const int row0 = u.pm * BM + wr * 64 + fr, col0 = u.pn * BM + wc * 32 + 4 * fq; const int br = u.fl;
        const bf16* gp = proj + C_G + br * D + col0;
#pragma unroll
        for (int ai = 0; ai < 2; ++ai)
#pragma unroll
            for (int m = 0; m < 4; ++m) { const size_t row = (size_t)(row0 + ai * HALF + m * 16);
                v2u ga[2][2], gb[2][2];
#pragma unroll
                for (int bj = 0; bj < 2; ++bj)
#pragma unroll
                    for (int n = 0; n < 2; ++n) { ga[bj][n] = *(const v2u*)(gp + row * INC + bj * HALF + n * 16); if (br < 2) gb[bj][n] = *(const v2u*)(gp + row * INC + D + bj * HALF + n * 16); }
#pragma unroll
                for (int bj = 0; bj < 2; ++bj)
#pragma unroll
                    for (int n = 0; n < 2; ++n) { const v2u a = ga[bj][n]; f32x4 g = {bflo(a.x), bfhi(a.x), bflo(a.y), bfhi(a.y)};
                        if (br < 2) { const v2u b = gb[bj][n]; g[0] *= __builtin_amdgcn_rcpf(bflo(b.x)); g[1] *= __builtin_amdgcn_rcpf(bfhi(b.x)); g[2] *= __builtin_amdgcn_rcpf(bflo(b.y)); g[3] *= __builtin_amdgcn_rcpf(bfhi(b.y));
                            acc[ai][bj][m][n] *= g; }
                        else { const f32x4 v = acc[ai][bj][m][n] * g; v2u w; w.x = cvt_pk(v[0], v[1]); w.y = cvt_pk(v[2], v[3]); *(v2u*)(Mb + row * D + col0 + bj * HALF + n * 16) = w; } }
                asm volatile("" ::: "memory"); }
    }
};
struct EpiWout {
    static constexpr bool PERM = false;
    const float* base_lat; const float* base_ctx; float* out_lat; float* out_ctx; const float* modl;
    __device__ __forceinline__ void operator()(f32x4 (&acc)[2][2][4][2], const Unit& u, int wr, int wc, int fr, int fq) const {
        const int b = u.pm / 9, j = u.pm % 9; const bool ctx = (j == 0);
        const size_t r0 = ctx ? (size_t)b * CTXL : (size_t)b * SEQ + (size_t)(j - 1) * 256;
        const float* bp = (ctx ? base_ctx : base_lat) + r0 * D; float* op = (ctx ? out_ctx : out_lat) + r0 * D;
        const float* mg = modl + (size_t)(ctx ? 8 : b) * (NMOD * D) + 2 * D;
        const int rl0 = wr * 64 + fr, col0 = u.pn * BM + wc * 32 + 4 * fq;
#pragma unroll
        for (int ai = 0; ai < 2; ++ai)
#pragma unroll
            for (int m = 0; m < 4; ++m) { const size_t ro = (size_t)(rl0 + ai * HALF + m * 16) * D;
#pragma unroll
                for (int bj = 0; bj < 2; ++bj)
#pragma unroll
                    for (int n = 0; n < 2; ++n) { const int col = col0 + bj * HALF + n * 16;
                        const f32x4 g = *(const f32x4*)(mg + col); const f32x4 bs = *(const f32x4*)(bp + ro + col);
                        *(f32x4*)(op + ro + col) = bs + g * acc[ai][bj][m][n]; }
                asm volatile("" ::: "memory"); }
    }
};
struct EpiUp {
    static constexpr bool PERM = true;
    bf16* HB;
    __device__ __forceinline__ void operator()(f32x4 (&acc)[2][2][4][2], const Unit& u, int wr, int wc, int fr, int fq) const {
        const int row0 = u.pm * BM + wr * 64 + fr; const int col0 = (u.pn & 3) * HALF + wc * 32 + 8 * fq;
#pragma unroll
        for (int ai = 0; ai < 2; ++ai)
#pragma unroll
            for (int m = 0; m < 4; ++m) { bf16* rowp = HB + (size_t)(row0 + ai * HALF + m * 16) * DE + col0;
                f32x4 h0, h1;
#pragma unroll
                for (int e = 0; e < 4; ++e) { const float a0 = acc[ai][0][m][0][e], a1 = acc[ai][0][m][1][e];
                    h0[e] = a0 * sigmoidf_(a0) * acc[ai][1][m][0][e]; h1[e] = a1 * sigmoidf_(a1) * acc[ai][1][m][1][e]; }
                v4u w; w.x = cvt_pk(h0[0], h0[1]); w.y = cvt_pk(h0[2], h0[3]); w.z = cvt_pk(h1[0], h1[1]); w.w = cvt_pk(h1[2], h1[3]);
                *(v4u*)rowp = w; }
    }
};

template <class Epi, class Sched>
__device__ __forceinline__ void gemm_phase(LAS unsigned char* lds, const int lda, const int ldb, const int K, const Sched& S, const Epi& E) {
    constexpr bool ALIGN_EPI = true;
    int tid_ = threadIdx.x; asm volatile("" : "+v"(tid_));
    const int tid = tid_, wid = __builtin_amdgcn_readfirstlane(tid >> 6), lane = tid & 63, wr = wid >> 2, wc = wid & 3, fr = lane & 15, fq = lane >> 4;
    const int nt = K / BK;
    constexpr bool GATH = Sched::GATHER;
    unsigned voffA[2], voffB[2]; int gR[2]; unsigned gC[2];
    unsigned vc[2][2], vn[2][2];
#pragma unroll
    for (int i = 0; i < 2; ++i) { int R, C; stage_rc(tid * 16 + i * 8192, R, C); const int Rb = Epi::PERM ? ((R & ~31) + perm32(R & 31)) : R;
        voffA[i] = (unsigned)(R * lda + C) * 2u; voffB[i] = (unsigned)(Rb * ldb + C) * 2u; gR[i] = R; gC[i] = (unsigned)C * 2u; }
    const size_t kstep = (size_t)(BK * 2);
    const size_t hstepA = (size_t)HALF * lda * 2, hstepB = (size_t)HALF * ldb * 2;
    const unsigned ldsw = (unsigned)wid * 1024u;
    const int aoff = lds_byte(wr * 64 + fr, fq * 8), boff = lds_byte(wc * 32 + fr, fq * 8);
#define PG8_SA(b, h) (((b) * 2 + (h)) * HTB)
#define PG8_SB(b, h) ((4 + (b) * 2 + (h)) * HTB)
#define PG8_STAGE(bufoff, gbase, voff) do { _Pragma("unroll") for (int _i = 0; _i < 2; ++_i) \
        __builtin_amdgcn_global_load_lds((const unsigned*)((const char*)(gbase) + (voff)[_i]), (LAS unsigned*)(lds + (bufoff) + ldsw + _i * 8192), 16, 0, 0); } while (0)
#define PG8_STAGE_A(bufoff, ptr, h, kb) do { if constexpr (GATH) { _Pragma("unroll") for (int _i = 0; _i < 2; ++_i) \
        __builtin_amdgcn_global_load_lds((const unsigned*)(S.gb.A + (size_t)(kb) + vc[h][_i]), (LAS unsigned*)(lds + (bufoff) + ldsw + _i * 8192), 16, 0, 0); } else PG8_STAGE(bufoff, ptr, voffA); } while (0)
#define PG8_ROWOFFS(dst, u) do { _Pragma("unroll") for (int _h = 0; _h < 2; ++_h) _Pragma("unroll") for (int _i = 0; _i < 2; ++_i) dst[_h][_i] = S.rowoff(u, _h * HALF + gR[_i]) + gC[_i]; } while (0)
#define PG8_LDA(dst, b, h) do { _Pragma("unroll") for (int m = 0; m < 4; ++m) _Pragma("unroll") for (int k = 0; k < 2; ++k) dst[m][k] = *(const LAS bf16x8*)(lds + PG8_SA(b, h) + aoff + m * 2048 + k * 1024); } while (0)
#define PG8_LDB(dst, b, h) do { _Pragma("unroll") for (int n = 0; n < 2; ++n) _Pragma("unroll") for (int k = 0; k < 2; ++k) dst[n][k] = *(const LAS bf16x8*)(lds + PG8_SB(b, h) + boff + n * 2048 + k * 1024); } while (0)
#define PG8_MMA(ai, bj, At, Bt) do { __builtin_amdgcn_s_setprio(1); _Pragma("unroll") for (int m = 0; m < 4; ++m) _Pragma("unroll") for (int n = 0; n < 2; ++n) _Pragma("unroll") for (int k = 0; k < 2; ++k) \
        acc[ai][bj][m][n] = __builtin_amdgcn_mfma_f32_16x16x32_bf16(Bt[n][k], At[m][k], acc[ai][bj][m][n], 0, 0, 0); __builtin_amdgcn_s_setprio(0); } while (0)
#define PG8_WAIT_V(n) asm volatile("s_waitcnt vmcnt(" #n ")" ::: "memory")
#define PG8_WAIT_L(n) asm volatile("s_waitcnt lgkmcnt(" #n ")" ::: "memory")
#define PG8_BAR __builtin_amdgcn_s_barrier()
#define PG8_SCHED __builtin_amdgcn_sched_barrier(0)
    Unit cur, nxt; int ui = 0;
    if (!S.next(0, cur)) return;
    f32x4 acc[2][2][4][2];
#pragma unroll
    for (int a = 0; a < 2; ++a)
#pragma unroll
        for (int b = 0; b < 2; ++b)
#pragma unroll
            for (int m = 0; m < 4; ++m)
#pragma unroll
                for (int n = 0; n < 2; ++n) acc[a][b][m][n] = (f32x4){0.f, 0.f, 0.f, 0.f};
    bf16x8 At[4][2], B0[2][2], B1[2][2];
    const char* cA = S.a_base(cur); const char* cB = S.b_base(cur);
    if constexpr (GATH) { PG8_ROWOFFS(vc, cur); }
    PG8_STAGE(PG8_SB(0, 0), cB, voffB); PG8_STAGE(PG8_SB(0, 1), cB + hstepB, voffB); PG8_STAGE_A(PG8_SA(0, 0), cA, 0, 0); PG8_STAGE_A(PG8_SA(0, 1), cA + hstepA, 1, 0);
    if (wr == 1) PG8_BAR;
    PG8_WAIT_V(2); PG8_BAR;
    PG8_STAGE(PG8_SB(1, 0), cB + kstep, voffB); PG8_STAGE_A(PG8_SA(1, 0), cA + kstep, 0, kstep); PG8_STAGE(PG8_SB(1, 1), cB + hstepB + kstep, voffB);
    PG8_WAIT_V(6); PG8_BAR;
    for (;;) {
        const bool has_next = S.next(ui + 1, nxt);
        const char* nA = has_next ? S.a_base(nxt) : cA; const char* nB = has_next ? S.b_base(nxt) : cB;
        if constexpr (GATH) { if (has_next) { PG8_ROWOFFS(vn, nxt); } else {
#pragma unroll
            for (int _h = 0; _h < 2; ++_h) { vn[_h][0] = vc[_h][0]; vn[_h][1] = vc[_h][1]; } } }
        for (int t = 0; t < nt; t += 2) {
            const bool last = (t == nt - 2);
            const char* a1 = cA + (size_t)(t + 1) * kstep;
            const char* a2 = last ? nA : cA + (size_t)(t + 2) * kstep; const char* b2 = last ? nB : cB + (size_t)(t + 2) * kstep;
            const char* a3 = a2 + kstep; const char* b3 = b2 + kstep;
            const size_t k1 = (size_t)(t + 1) * kstep, k2 = last ? 0 : (size_t)(t + 2) * kstep, k3 = k2 + kstep;
            PG8_LDB(B0, 0, 0); PG8_LDB(B1, 0, 1); PG8_SCHED; PG8_LDA(At, 0, 0); PG8_STAGE_A(PG8_SA(1, 1), a1 + hstepA, 1, k1);
            if constexpr (GATH) { if (last) {
#pragma unroll
                for (int _h = 0; _h < 2; ++_h) { vc[_h][0] = vn[_h][0]; vc[_h][1] = vn[_h][1]; } } }
            PG8_WAIT_V(8); PG8_WAIT_L(0); PG8_BAR; PG8_MMA(0, 0, At, B0); PG8_MMA(0, 1, At, B1); PG8_BAR; PG8_SCHED;
            PG8_LDA(At, 0, 1); PG8_STAGE(PG8_SB(0, 0), b2, voffB); PG8_STAGE(PG8_SB(0, 1), b2 + hstepB, voffB); PG8_STAGE_A(PG8_SA(0, 0), a2, 0, k2);
            PG8_WAIT_V(8); PG8_WAIT_L(0); PG8_BAR; PG8_MMA(1, 0, At, B0); PG8_MMA(1, 1, At, B1); PG8_BAR; PG8_SCHED;
            PG8_LDB(B0, 1, 0); PG8_LDB(B1, 1, 1); PG8_SCHED; PG8_LDA(At, 1, 0); PG8_STAGE_A(PG8_SA(0, 1), a2 + hstepA, 1, k2);
            PG8_WAIT_V(8); PG8_WAIT_L(0); PG8_BAR; PG8_MMA(0, 0, At, B0); PG8_MMA(0, 1, At, B1); PG8_BAR; PG8_SCHED;
            PG8_LDA(At, 1, 1); PG8_STAGE(PG8_SB(1, 0), b3, voffB); PG8_STAGE(PG8_SB(1, 1), b3 + hstepB, voffB); PG8_STAGE_A(PG8_SA(1, 0), a3, 0, k3);
            PG8_WAIT_V(8); PG8_WAIT_L(0); PG8_BAR; PG8_MMA(1, 0, At, B0); PG8_MMA(1, 1, At, B1); PG8_BAR; PG8_SCHED;
        }
        if constexpr (ALIGN_EPI) { if (wr == 0) PG8_BAR; }
        { int fr2 = fr, fq2 = fq; asm volatile("" : "+v"(fr2), "+v"(fq2)); E(acc, cur, wr, wc, fr2, fq2); }
        if (!has_next) break;
        if (S.zero_after(cur)) {
#pragma unroll
        for (int a = 0; a < 2; ++a)
#pragma unroll
            for (int b = 0; b < 2; ++b)
#pragma unroll
                for (int m = 0; m < 4; ++m)
#pragma unroll
                    for (int n = 0; n < 2; ++n) acc[a][b][m][n] = (f32x4){0.f, 0.f, 0.f, 0.f}; }
        cur = nxt; cA = nA; cB = nB; ++ui;
        if constexpr (ALIGN_EPI) { if (wr == 1) PG8_BAR; }
    }
    PG8_WAIT_V(0);
    if constexpr (!ALIGN_EPI) { if (wr == 0) PG8_BAR; }
    PG8_BAR;
#undef PG8_SA
#undef PG8_SB
#undef PG8_STAGE
#undef PG8_LDA
#undef PG8_STAGE_A
#undef PG8_ROWOFFS
#undef PG8_LDB
#undef PG8_MMA
#undef PG8_WAIT_V
#undef PG8_WAIT_L
#undef PG8_BAR
#undef PG8_SCHED
}
}

namespace att {
constexpr int AD = 128, NW = 8, QBLK = 32, KVBLK = 64;
constexpr float SCALE = 0.088388347648318440f;
constexpr float THR = 8.f;
constexpr int LDQ = INC, LDK = INC;
constexpr size_t SHM_V = KVBLK * AD * 2, SHM_K = KVBLK * AD * 2, SHM_ATTN = 2 * SHM_V + 2 * SHM_K + NW * 64 * 4;
using s16x4 = __attribute__((ext_vector_type(4))) short;
using f32x16 = __attribute__((ext_vector_type(16))) float;
#define KSWZ(row, colB) ((row) * 256 + ((colB) ^ (((row) & 7) << 4)))
#define SBAR() __builtin_amdgcn_sched_barrier(0)
__device__ __forceinline__ int crow(int r, int hi) { return (r & 3) + 8 * (r >> 2) + 4 * hi; }
__device__ __forceinline__ void partialSM(f32x16& p0, f32x16& p1, float& m_reg, float& mn, float& alpha) {
  constexpr float C = SCALE * 1.4426950408889634f;
  float pmax = p0[0]; for (int r = 1; r < 16; ++r) pmax = fmaxf(pmax, p0[r]); for (int r = 0; r < 16; ++r) pmax = fmaxf(pmax, p1[r]);
  { auto rr = __builtin_amdgcn_permlane32_swap(__float_as_uint(pmax), __float_as_uint(pmax), false, false);
    pmax = fmaxf(__uint_as_float(rr[0]), __uint_as_float(rr[1])); }
  if (__builtin_expect(__all(pmax - m_reg <= THR / SCALE), 1)) { mn = m_reg; alpha = 1.f; }
  else { mn = fmaxf(m_reg, pmax); alpha = __builtin_amdgcn_exp2f((m_reg - mn) * C); m_reg = mn; }
  float mnC = -mn * C;
  for (int r = 0; r < 16; ++r) p0[r] = fmaf(p0[r], C, mnC); for (int r = 0; r < 16; ++r) p1[r] = fmaf(p1[r], C, mnC);
  for (int r = 0; r < 16; ++r) p0[r] = __builtin_amdgcn_exp2f(p0[r]);
}
__device__ __forceinline__ void finishSM(f32x16& p0, f32x16& p1, float alpha, float& l_reg, bf16x8& pa0, bf16x8& pa1, bf16x8& pa2, bf16x8& pa3) {
  for (int r = 0; r < 16; ++r) p1[r] = __builtin_amdgcn_exp2f(p1[r]);
  float ps = 0; for (int r = 0; r < 16; ++r) ps += p0[r]; for (int r = 0; r < 16; ++r) ps += p1[r];
  { auto rr = __builtin_amdgcn_permlane32_swap(__float_as_uint(ps), __float_as_uint(ps), false, false);
    ps = __uint_as_float(rr[0]) + __uint_as_float(rr[1]); }
  l_reg = l_reg * alpha + ps;
#define PK4(P, BASE, OUT) do { unsigned a0 = cvt_pk(P[BASE + 0], P[BASE + 1]), a1 = cvt_pk(P[BASE + 2], P[BASE + 3]);   \
    unsigned b0 = cvt_pk(P[BASE + 4], P[BASE + 5]), b1 = cvt_pk(P[BASE + 6], P[BASE + 7]);                              \
    auto r0 = __builtin_amdgcn_permlane32_swap(a0, b0, false, false); auto r1 = __builtin_amdgcn_permlane32_swap(a1, b1, false, false); \
    v4u w = {r0[0], r1[0], r0[1], r1[1]}; OUT = *reinterpret_cast<bf16x8*>(&w); } while (0)
  PK4(p0, 0, pa0); PK4(p0, 8, pa1); PK4(p1, 0, pa2); PK4(p1, 8, pa3);
#undef PK4
}
__device__ __forceinline__ void qkt(f32x16& p0, f32x16& p1, const bf16* Ks, const bf16x8* qr, int r32, int hi) {
  p0 = f32x16{}; p1 = f32x16{};
  for (int d0 = 0; d0 < 8; ++d0) { int cb = (d0 * 16 + hi * 8) * 2;
    bf16x8 b0 = *reinterpret_cast<const bf16x8*>((const char*)Ks + KSWZ(r32, cb));
    bf16x8 b1 = *reinterpret_cast<const bf16x8*>((const char*)Ks + KSWZ(32 + r32, cb));
    p0 = __builtin_amdgcn_mfma_f32_32x32x16_bf16(b0, qr[d0], p0, 0, 0, 0);
    p1 = __builtin_amdgcn_mfma_f32_32x32x16_bf16(b1, qr[d0], p1, 0, 0, 0); }
}
__device__ __forceinline__ int v_st(int k, int c) { const int kk = (k & ~0xC) | ((k & 4) << 1) | ((k & 8) >> 1); return ((kk >> 3) * 4 + (c >> 5)) * 512 + ((kk & 7) * 32 + (c & 31)) * 2; }
__device__ __forceinline__ int v_rd_base(int lane) { return ((lane & 3) << 3) | (((lane >> 2) & 3) << 6) | (((lane >> 4) & 1) << 5) | (((lane >> 5) & 1) << 8); }
constexpr int v_rd_off(int d0, int ks, int half) { return d0 * 512 + ks * 4096 + half * 2048; }
template <int OFF> __device__ __forceinline__ s16x4 tr_read(int vb) {
  s16x4 r; asm volatile("ds_read_b64_tr_b16 %0, %1 offset:%2" : "=&v"(r) : "v"(vb), "i"(OFF) : "memory"); return r;
}
template <int D0> __device__ __forceinline__ void pv_one(f32x16& od, int vb, bf16x8 pa0, bf16x8 pa1, bf16x8 pa2, bf16x8 pa3) {
  const s16x4 l0 = tr_read<v_rd_off(D0, 0, 0)>(vb), h0 = tr_read<v_rd_off(D0, 0, 1)>(vb), l1 = tr_read<v_rd_off(D0, 1, 0)>(vb), h1 = tr_read<v_rd_off(D0, 1, 1)>(vb);
  const s16x4 l2 = tr_read<v_rd_off(D0, 2, 0)>(vb), h2 = tr_read<v_rd_off(D0, 2, 1)>(vb), l3 = tr_read<v_rd_off(D0, 3, 0)>(vb), h3 = tr_read<v_rd_off(D0, 3, 1)>(vb);
  asm volatile("s_waitcnt lgkmcnt(0)" ::: "memory"); SBAR();
#define PK(L, H) (bf16x8){L[0], L[1], L[2], L[3], H[0], H[1], H[2], H[3]}
  od = __builtin_amdgcn_mfma_f32_32x32x16_bf16(pa0, PK(l0, h0), od, 0, 0, 0);
  od = __builtin_amdgcn_mfma_f32_32x32x16_bf16(pa1, PK(l1, h1), od, 0, 0, 0);
  od = __builtin_amdgcn_mfma_f32_32x32x16_bf16(pa2, PK(l2, h2), od, 0, 0, 0);
  od = __builtin_amdgcn_mfma_f32_32x32x16_bf16(pa3, PK(l3, h3), od, 0, 0, 0);
#undef PK
}
__device__ __forceinline__ void pv_d0(f32x16* o, int vb, bf16x8 pa0, bf16x8 pa1, bf16x8 pa2, bf16x8 pa3) {
  pv_one<0>(o[0], vb, pa0, pa1, pa2, pa3); pv_one<1>(o[1], vb, pa0, pa1, pa2, pa3); pv_one<2>(o[2], vb, pa0, pa1, pa2, pa3); pv_one<3>(o[3], vb, pa0, pa1, pa2, pa3);
}
__device__ __forceinline__ void attn_dense_body(const bf16* __restrict__ Qb, const bf16* __restrict__ Kh, const bf16* __restrict__ Vh,
                                                bf16* __restrict__ Ob, int ldo, int seq, char* lds) {
  constexpr int SDEPTH = 2;
  int tid_ = threadIdx.x; asm volatile("" : "+v"(tid_));
  const int tid = tid_, wid = tid >> 6, lane = tid & 63, r32 = lane & 31, hi = lane >> 5;
  bf16* V_lds = (bf16*)lds; bf16* K_lds = (bf16*)(lds + 2 * SHM_V);
  float* ws = (float*)(lds + 2 * SHM_V + 2 * SHM_K) + wid * 64; float* li_l = ws; float* al_l = ws + 32;
  float m_reg = -1e30f, l_reg = 0; f32x16 o[4] = {}; bf16x8 qr[8];
  const bf16* Qw = Qb + (long)(wid * QBLK + r32) * LDQ + hi * 8;
#pragma unroll
  for (int d0 = 0; d0 < 8; ++d0) qr[d0] = *reinterpret_cast<const bf16x8*>(Qw + d0 * 16);
  const int sr = tid >> 4, sc = (tid & 15) * 8, vst0 = v_st(sr, sc), vst1 = v_st(32 + sr, sc);
  const int vb0 = (int)(uintptr_t)V_lds + v_rd_base(lane);
  struct { bf16x8 vs0, vs1, ks0, ks1; } sr_[SDEPTH];
#define SLOAD(i, k0) do { sr_[i].vs0 = *(const bf16x8*)(&Vh[(long)((k0) + sr) * LDK + sc]); sr_[i].vs1 = *(const bf16x8*)(&Vh[(long)((k0) + 32 + sr) * LDK + sc]); \
    sr_[i].ks0 = *(const bf16x8*)(&Kh[(long)((k0) + sr) * LDK + sc]); sr_[i].ks1 = *(const bf16x8*)(&Kh[(long)((k0) + 32 + sr) * LDK + sc]); } while (0)
#define SWRITE(b, i) do { *(bf16x8*)((char*)V_lds + (b) * SHM_V + vst0) = sr_[i].vs0;          \
    *(bf16x8*)((char*)V_lds + (b) * SHM_V + vst1) = sr_[i].vs1; int kc = sc * 2;               \
    *(bf16x8*)((char*)K_lds + (b) * SHM_K + KSWZ(sr, kc)) = sr_[i].ks0;                       \
    *(bf16x8*)((char*)K_lds + (b) * SHM_K + KSWZ(32 + sr, kc)) = sr_[i].ks1; } while (0)
#define SWAIT() asm volatile("s_waitcnt vmcnt(4)" ::: "memory")
#define RESC(a) do { if (__any((a) < 1.f)) { if (hi == 0) al_l[r32] = (a); asm volatile("s_waitcnt lgkmcnt(0)" ::: "memory"); \
    for (int d = 0; d < 4; ++d) for (int r = 0; r < 16; ++r) o[d][r] *= al_l[crow(r, hi)]; } } while (0)
  f32x16 pA0, pA1, pB0, pB1; float mnA, mnB, alA, alB; bf16x8 pa0, pa1, pa2, pa3; const int NT = seq / KVBLK;
  constexpr int SE = 0, SO = SDEPTH - 1;
  SLOAD(SE, 0); asm volatile("s_waitcnt vmcnt(0)" ::: "memory"); SWRITE(0, SE); __syncthreads();
  qkt(pA0, pA1, K_lds, qr, r32, hi); partialSM(pA0, pA1, m_reg, mnA, alA);
  SLOAD(SO, KVBLK); if (2 < NT) SLOAD(SE, 2 * KVBLK);
  SWAIT(); SWRITE(1, SO); __syncthreads();
  for (int j = 1; j + 1 < NT; j += 2) {
    SBAR(); qkt(pB0, pB1, (bf16*)((char*)K_lds + SHM_K), qr, r32, hi);
    finishSM(pA0, pA1, alA, l_reg, pa0, pa1, pa2, pa3); SBAR();
    SLOAD(SO, (j + SDEPTH) * KVBLK); SBAR();
    pv_d0(o, vb0, pa0, pa1, pa2, pa3); partialSM(pB0, pB1, m_reg, mnB, alB);
    __syncthreads(); SWAIT(); SWRITE(0, SE);
    RESC(alB); __syncthreads();
    SBAR(); qkt(pA0, pA1, K_lds, qr, r32, hi);
    finishSM(pB0, pB1, alB, l_reg, pa0, pa1, pa2, pa3); SBAR();
    if (j + 3 < NT) SLOAD(SE, (j + 1 + SDEPTH) * KVBLK); SBAR();
    pv_d0(o, vb0 + (int)SHM_V, pa0, pa1, pa2, pa3); partialSM(pA0, pA1, m_reg, mnA, alA);
    __syncthreads(); SWAIT(); SWRITE(1, SO);
    RESC(alA); __syncthreads();
  }
  SBAR(); qkt(pB0, pB1, (bf16*)((char*)K_lds + SHM_K), qr, r32, hi);
  finishSM(pA0, pA1, alA, l_reg, pa0, pa1, pa2, pa3); SBAR();
  pv_d0(o, vb0, pa0, pa1, pa2, pa3); partialSM(pB0, pB1, m_reg, mnB, alB);
  __syncthreads(); RESC(alB);
  finishSM(pB0, pB1, alB, l_reg, pa0, pa1, pa2, pa3); SBAR();
  pv_d0(o, vb0 + (int)SHM_V, pa0, pa1, pa2, pa3);
  if (hi == 0) li_l[r32] = l_reg; asm volatile("s_waitcnt lgkmcnt(0)" ::: "memory");
  float rli[16];
#pragma unroll
  for (int r = 0; r < 16; ++r) rli[r] = __builtin_amdgcn_rcpf(li_l[crow(r, hi)]);
  bf16* Ow = Ob + (long)(wid * QBLK) * ldo;
#pragma unroll
  for (int r = 0; r < 16; ++r) { int orow = crow(r, hi);
    for (int d0 = 0; d0 < 4; ++d0) Ow[(long)orow * ldo + d0 * 32 + r32] = (bf16)(cvt_pk(o[d0][r] * rli[r], 0.f) & 0xffffu); }
#undef SLOAD
#undef SWRITE
#undef SWAIT
#undef RESC
}
}

#define XB_TMO      128
#define XB_XCNT(j)  (256  + 64 * (j))
#define XB_XSUB(j)  (1280 + 64 * (j))
#define XB_XGEN(j)  (2304 + 64 * (j))
#define XB_TOP      3328
#define XB_TOPGEN   3392
#define XCD_BAR_WORDS 3456
#define XB_SPIN_CAP (1u << 18)
__device__ __forceinline__ unsigned xb_ld(unsigned* p)              { return __hip_atomic_load(p, __ATOMIC_RELAXED, __HIP_MEMORY_SCOPE_AGENT); }
__device__ __forceinline__ unsigned xb_add(unsigned* p, unsigned v) { return __hip_atomic_fetch_add(p, v, __ATOMIC_RELAXED, __HIP_MEMORY_SCOPE_AGENT); }
__device__ __forceinline__ unsigned xb_xcc_id() { return (unsigned)__builtin_amdgcn_s_getreg((3 << 11) | 20) & 0xFu; }
#define XB_SPIN(cond, bar) do { unsigned _sp = 0; while (cond) { __builtin_amdgcn_s_sleep(1); \
    if ((++_sp & 255u) == 0u) { if (xb_ld(&(bar)[XB_TMO])) break; if (_sp > XB_SPIN_CAP) { atomicAdd(&(bar)[XB_TMO], 1u); break; } } } } while (0)
struct XcdBarrier { unsigned* bar; unsigned x; volatile LAS unsigned* st; };
__device__ __forceinline__ XcdBarrier xcd_barrier_post(unsigned* bar, volatile LAS unsigned* st) {
    XcdBarrier b; b.bar = bar; b.x = xb_xcc_id(); b.st = st;
    if (threadIdx.x == 0) (void)xb_add(&bar[XB_XCNT(b.x)], 1u);
    return b;
}
__device__ __forceinline__ void xcd_barrier_complete(unsigned* bar, unsigned x, unsigned& nloc, unsigned& nx) {
    const unsigned G = gridDim.x * gridDim.y * gridDim.z;
    unsigned sum, cnt, mine, sp = 0u;
    for (;;) {
        sum = 0u; cnt = 0u; mine = 0u;
#pragma unroll
        for (unsigned j = 0; j < 16; ++j) { const unsigned c = xb_ld(&bar[XB_XCNT(j)]); sum += c; cnt += (c > 0u) ? 1u : 0u; mine = (j == x) ? c : mine; }
        if (sum == G) break;
        __builtin_amdgcn_s_sleep(1);
        if ((++sp & 255u) == 0u) { if (xb_ld(&bar[XB_TMO])) break; if (sp > XB_SPIN_CAP) { atomicAdd(&bar[XB_TMO], 1u); break; } }
    }
    nloc = mine > 0u ? mine : 1u; nx = cnt > 0u ? cnt : 1u;
}
__device__ __forceinline__ void xcd_barrier(const XcdBarrier& b) {
    asm volatile("s_waitcnt vmcnt(0)" ::: "memory");
    __syncthreads();
    if (threadIdx.x == 0) {
        unsigned* bar = b.bar;
        __builtin_amdgcn_s_waitcnt(0);
        unsigned nloc = b.st[0], nx = b.st[1];
        if (nloc == 0u) { xcd_barrier_complete(bar, b.x, nloc, nx); b.st[0] = nloc; b.st[1] = nx; }
        const unsigned old = xb_add(&bar[XB_XSUB(b.x)], 1u);
        const unsigned gen = old / nloc;
        if (old + 1u == (gen + 1u) * nloc) {
            __builtin_amdgcn_fence(__ATOMIC_RELEASE, "agent");
            asm volatile("s_waitcnt vmcnt(0)" ::: "memory");
            const unsigned og = xb_add(&bar[XB_TOP], 1u);
            const unsigned tg = og / nx;
            if (og + 1u == (tg + 1u) * nx) xb_add(&bar[XB_TOPGEN], 1u);
            else XB_SPIN(xb_ld(&bar[XB_TOPGEN]) == tg, bar);
            __builtin_amdgcn_fence(__ATOMIC_ACQUIRE, "agent");
            xb_add(&bar[XB_XGEN(b.x)], 1u);
            asm volatile("s_waitcnt vmcnt(0)" ::: "memory");
        } else {
            XB_SPIN(xb_ld(&bar[XB_XGEN(b.x)]) == gen, bar);
            __builtin_amdgcn_fence(__ATOMIC_ACQUIRE, "agent");
            asm volatile("s_waitcnt vmcnt(0)" ::: "memory");
        }
    }
    __syncthreads();
}

struct Args { const float* in[34]; float* out; unsigned char* ws; int ph_lo, ph_hi; };
typedef const __attribute__((address_space(4))) Args* KArgs;
template <class T> __device__ __forceinline__ T* as_global(T* p) { return (T*)(GAS T*)p; }
__device__ __forceinline__ KArgs kargs() { KArgs p = (KArgs)__builtin_amdgcn_kernarg_segment_ptr(); asm volatile("" : "+s"(p)); return p; }
__device__ __forceinline__ const float* ain(KArgs a, int i) { return as_global(a->in[i]); }
__device__ __forceinline__ float* aout(KArgs a) { return as_global(a->out); }
struct Frame {
    unsigned char* lds; unsigned char* lds0;
    LAS unsigned char* ldsl;
    unsigned char* ws;
    int tid, lane, wave, G, gw, NGW;
};
enum { I_X = 0, I_C, I_CTX, I_CCTX, I_WADA, I_BADA, I_N1G, I_N2G, I_WIN, I_BGATE, I_QNA, I_KNA, I_DLAM, I_SUBN, I_QNC, I_KNC, I_CONVW, I_CONVB,
       I_LWA, I_LBA, I_LWX, I_LBX, I_LLAM, I_WBA, I_WBB, I_WBC, I_WOUT, I_WGRP, I_BGRP, I_WRT, I_BRT, I_W1, I_W3, I_W2 };

__device__ __forceinline__ void phase_ids(Frame& F) {
    int t = threadIdx.x; asm volatile("" : "+v"(t)); F.tid = t; F.lane = t & 63; F.wave = __builtin_amdgcn_readfirstlane(t >> 6); F.gw = blockIdx.x * 8 + F.wave;
    GAS unsigned char* w = (GAS unsigned char*)kargs()->ws; asm volatile("" : "+s"(w)); F.ws = (unsigned char*)w; F.lds = F.lds0; F.ldsl = (LAS unsigned char*)F.lds0;
}
__device__ __forceinline__ int launder_s(int v) { asm volatile("" : "+s"(v)); return v; }
__device__ __forceinline__ void tr_item(const float* __restrict__ W, int N, bf16* __restrict__ WT, int K, int k0, int n0, int drow0, LAS float* scr, int lane) {
#pragma unroll 8
    for (int i = 0; i < 64; ++i) scr[i * 65 + lane] = W[(size_t)(k0 + i) * N + n0 + lane];
    LDS_WAIT();
    const int c = lane & 7;
#pragma unroll
    for (int j = 0; j < 8; ++j) { const int n = (lane >> 3) + 8 * j; const LAS float* s = scr + (8 * c) * 65 + n;
        v4u o; o.x = cvt_pk(s[0], s[65]); o.y = cvt_pk(s[130], s[195]); o.z = cvt_pk(s[260], s[325]); o.w = cvt_pk(s[390], s[455]);
        *(v4u*)(WT + (size_t)(drow0 + n) * K + k0 + 8 * c) = o; }
    LDS_WAIT();
}
constexpr int CV_IN = 32 * 200, CV_BR = 16 * 32, CV_OUT = 32 * 32, CV_W = 32 * 256;
constexpr int CV_O_BR = CV_IN, CV_O_OUT = CV_O_BR + 3 * CV_BR, CV_O_W13 = CV_O_OUT + CV_OUT, CV_O_W2 = CV_O_W13 + 2 * CV_W, CV_NIT = CV_O_W2 + CV_W;
__device__ __forceinline__ void conv_weights(Frame& F, int l, int it_lo, int it_hi, int wg_lo) {
    phase_ids(F); l = launder_s(l); KArgs a = kargs();
    if ((int)blockIdx.x < wg_lo) return;
    LAS float* scr = (LAS float*)(F.ldsl + F.wave * 16640);
    constexpr int I_IN = CV_IN, I_BR = CV_BR, I_OUT = CV_OUT, I_W = CV_W;
    bf16* WIN = (bf16*)(F.ws + WS_WIN); bf16* WBR = (bf16*)(F.ws + WS_WBR); bf16* WOUT = (bf16*)(F.ws + WS_WOUT);
    bf16* W13 = (bf16*)(F.ws + (l ? WS_W13B : WS_W13)); bf16* W2 = (bf16*)(F.ws + (l ? WS_W2B : WS_W2));
    for (int it = it_lo + ((int)blockIdx.x - wg_lo) * 8 + F.wave; it < it_hi; it += (F.G - wg_lo) * 8) {
        int r = it;
        if (r < I_IN) { const int kb = r / 200, nb = r % 200; tr_item(ain(a, I_WIN) + (size_t)l * D * INC, INC, WIN, D, kb * 64, nb * 64, nb * 64, scr, F.lane); continue; } r -= I_IN;
        if (r < 3 * I_BR) { const int br = r / I_BR, q = r % I_BR, kb = q / 32, nb = q % 32;
            tr_item(ain(a, I_WBA + br) + (size_t)l * 1024 * D, D, WBR + (size_t)br * D * 1024, 1024, kb * 64, nb * 64, nb * 64, scr, F.lane); continue; } r -= 3 * I_BR;
        if (r < I_OUT) { const int kb = r / 32, nb = r % 32; tr_item(ain(a, I_WOUT) + (size_t)l * D * D, D, WOUT, D, kb * 64, nb * 64, nb * 64, scr, F.lane); continue; } r -= I_OUT;
        if (r < 2 * I_W) { const int which = r / I_W, q = r % I_W, e = q / 256, q2 = q % 256, kb = q2 / 8, nb = q2 % 8;
            const int n0 = nb * 64; const int drow = e * 1024 + (n0 / 128) * 256 + (n0 % 128) + which * 128;
            tr_item(ain(a, which ? I_W3 : I_W1) + ((size_t)l * NE + e) * D * DE, DE, W13, D, kb * 64, n0, drow, scr, F.lane); continue; } r -= 2 * I_W;
        { const int e = r / 256, q2 = r % 256, kb = q2 / 32, nb = q2 % 32;
            tr_item(ain(a, I_W2) + ((size_t)l * NE + e) * DE * D, D, W2, DE, kb * 64, nb * 64, e * D + nb * 64, scr, F.lane); }
    }
}

__device__ __forceinline__ void p0_misc(Frame& F) {
    phase_ids(F); KArgs a = kargs();
    LAS float* sl = (LAS float*)F.ldsl;
    LAS float* red = sl + 9 * 2048;
    const float* c = ain(a, I_C); const float* cc = ain(a, I_CCTX);
    float* mod = (float*)(F.ws + WS_MOD);
    if (blockIdx.x < 192 || F.G < 192) {
        for (int idx = F.tid; idx < 9 * 2048; idx += 512) { const int b = idx >> 11, k = idx & 2047; const float v = b < 8 ? c[b * 2048 + k] : cc[k]; sl[idx] = v / (1.0f + expf(-v)); }
        __syncthreads();
        for (int it = blockIdx.x; it < 192; it += F.G) {
            const int l = it / 96, cb = it % 96, col = cb * 128 + 2 * F.lane;
            const float* wp = ain(a, I_WADA) + ((size_t)l * D + F.wave * 256) * (NMOD * D) + col;
            float ax[9], ay[9];
#pragma unroll
            for (int b = 0; b < 9; ++b) { ax[b] = 0.f; ay[b] = 0.f; }
            for (int k = 0; k < 256; k += 8) {
                f32x2 w[8];
#pragma unroll
                for (int u = 0; u < 8; ++u) w[u] = *(const f32x2*)(wp + (size_t)(k + u) * (NMOD * D));
#pragma unroll
                for (int u = 0; u < 8; ++u)
#pragma unroll
                    for (int b = 0; b < 9; ++b) { const float s = sl[b * 2048 + F.wave * 256 + k + u]; ax[b] += s * w[u].x; ay[b] += s * w[u].y; }
            }
#pragma unroll
            for (int b = 0; b < 9; ++b) { red[(F.wave * 9 + b) * 128 + 2 * F.lane] = ax[b]; red[(F.wave * 9 + b) * 128 + 2 * F.lane + 1] = ay[b]; }
            __syncthreads();
            for (int o = F.tid; o < 9 * 128; o += 512) { const int b = o >> 7, ci = o & 127; float s = 0.f;
#pragma unroll
                for (int w = 0; w < 8; ++w) s += red[(w * 9 + b) * 128 + ci];
                mod[((size_t)l * 9 + b) * (NMOD * D) + cb * 128 + ci] = s + ain(a, I_BADA)[(size_t)l * (NMOD * D) + cb * 128 + ci]; }
            __syncthreads();
        }
    }
    { float* rc = (float*)(F.ws + WS_ROPE); float* rs = rc + 2048 * 64;
      for (int idx = blockIdx.x * 512 + F.tid; idx < 2048 * 64; idx += F.G * 512) { const int t = idx >> 6, j = idx & 63, jj = j & 31;
          const float inv = 1.0f / powf(10000.0f, (float)(2 * jj) / 64.0f); const float pos = (float)(j < 32 ? (t >> 6) : (t & 63));
          float s, co; sincosf(pos * inv, &s, &co); rc[idx] = co; rs[idx] = s; } }
    if (blockIdx.x == 0 && F.wave < 2) { const int l = F.wave; const float* dl = ain(a, I_DLAM) + (size_t)l * 4 * 128;
        float s01 = dl[F.lane] * dl[128 + F.lane] + dl[64 + F.lane] * dl[192 + F.lane];
        float s23 = dl[256 + F.lane] * dl[384 + F.lane] + dl[320 + F.lane] * dl[448 + F.lane];
        s01 = wave_sum(s01); s23 = wave_sum(s23);
        const float li = l == 0 ? 0.2f : 0.3555090676f;
        if (F.lane == 0) ((float*)(F.ws + WS_MISC + MISC_LAM))[l] = expf(s01) - expf(s23) + li; }
    { bf16* wr = (bf16*)(F.ws + WS_MISC + MISC_WR);
      for (int idx = blockIdx.x * 512 + F.tid; idx < 2 * 48 * 2048; idx += F.G * 512) { const int l = idx / (48 * 2048), rem = idx % (48 * 2048), e = rem >> 11, k = rem & 2047;
          float w = 0.f; if (e < 4) w = ain(a, I_WGRP)[((size_t)l * D + k) * 4 + e]; else if (e < 36) w = ain(a, I_WRT)[((size_t)l * D + k) * 32 + (e - 4)];
          const unsigned hi = cvt_pk(w, 0.f) & 0xffffu; const float lo = w - bflo(hi);
          wr[((size_t)(l * 2 + 0) * 48 + e) * 2048 + k] = (bf16)hi; wr[((size_t)(l * 2 + 1) * 48 + e) * 2048 + k] = (bf16)(cvt_pk(lo, 0.f) & 0xffffu); } }
    { float* spt = (float*)(F.ws + WS_MISC + MISC_SP); for (int idx = blockIdx.x * 512 + F.tid; idx < 2 * 2 * 1024; idx += F.G * 512) spt[idx] = log1pf(expf(-ain(a, I_LLAM)[idx])); }
    { bf16* lw = (bf16*)(F.ws + WS_LRUW);
      for (int idx = blockIdx.x * 512 + F.tid; idx < 2 * 2 * 2 * 8 * 128 * 128; idx += F.G * 512) {
          const int cidx = idx & 127, d = (idx >> 7) & 127, n = (idx >> 14) & 7, dir = (idx >> 17) & 1, mat = (idx >> 18) & 1, l = idx >> 19;
          const float w = ain(a, mat ? I_LWX : I_LWA)[((((size_t)l * 2 + dir) * 8 + n) * 128 + cidx) * 128 + d];
          lw[idx] = (bf16)(cvt_pk(w, 0.f) & 0xffffu); } }
}

__device__ __forceinline__ void row_split(int r, int& b, int& i) { b = r / TB; i = r - b * TB; }
__device__ __forceinline__ size_t hrow_off(int b, int i, bool& ctx) { ctx = i < CTXL; return ctx ? ((size_t)b * CTXL + i) * D : ((size_t)b * SEQ + (i - CTXL)) * D; }

__device__ __forceinline__ void norm_mod(f32x4 (&v)[8], const float* g, const float* shift, const float* scale, int lane) {
    float ss = 0.f;
#pragma unroll
    for (int j = 0; j < 8; ++j) ss += (v[j][0] * v[j][0] + v[j][1] * v[j][1]) + (v[j][2] * v[j][2] + v[j][3] * v[j][3]);
    ss = wave_sum(ss);
    const float rs = rsqrtf(ss * (1.0f / D) + EPS);
#pragma unroll
    for (int j = 0; j < 8; ++j) { const int c = (lane + 64 * j) * 4; const f32x4 gg = *(const f32x4*)(g + c), sh = *(const f32x4*)(shift + c), sc = *(const f32x4*)(scale + c);
        v[j] = v[j] * rs * gg * (sc + 1.0f) + sh; }
}

__device__ __forceinline__ void wave_rows(const Frame& F, int total, int& r0, int& r1) { const int rpw = (total + F.NGW - 1) / F.NGW; r0 = F.gw * rpw; r1 = r0 + rpw < total ? r0 + rpw : total; if (r0 > total) r0 = total; }
__device__ __forceinline__ const float* hrow_ptr(const float* hl, const float* hc, int r, int& bidx) { int b, i; row_split(r, b, i); bool ctx; const size_t off = hrow_off(b, i, ctx); bidx = ctx ? 8 : b; return (ctx ? hc : hl) + off; }
__device__ __forceinline__ void pa_norm1(Frame& F, int l) {
    phase_ids(F); l = launder_s(l); KArgs a = kargs();
    const float* hl = l == 0 ? ain(a, I_X) : aout(a); const float* hc = l == 0 ? ain(a, I_CTX) : (const float*)(F.ws + WS_HC);
    const float* mod = (const float*)(F.ws + WS_MOD) + (size_t)l * 9 * (NMOD * D);
    const float* g = ain(a, I_N1G) + (size_t)l * D; bf16* U = (bf16*)(F.ws + WS_ACT);
    int r0, r1; wave_rows(F, ROWS, r0, r1);
    f32x4 cur[8], nxt[8], Gc[8], Sc[8]; int bcur = -1, bi;
    if (r0 < r1) { const f32x4* xr = (const f32x4*)hrow_ptr(hl, hc, r0, bi) + F.lane;
#pragma unroll
        for (int j = 0; j < 8; ++j) cur[j] = xr[64 * j]; }
    for (int r = r0; r < r1; ++r) {
        int bnx = bi;
        if (r + 1 < r1) { const f32x4* xr = (const f32x4*)hrow_ptr(hl, hc, r + 1, bnx) + F.lane;
#pragma unroll
            for (int j = 0; j < 8; ++j) nxt[j] = xr[64 * j]; }
        if (bi != bcur) { bcur = bi; const float* mb = mod + (size_t)bi * (NMOD * D);
#pragma unroll
            for (int j = 0; j < 8; ++j) { const int c = (F.lane + 64 * j) * 4; Gc[j] = *(const f32x4*)(g + c) * (*(const f32x4*)(mb + D + c) + 1.0f); Sc[j] = *(const f32x4*)(mb + c); } }
        float ss = 0.f;
#pragma unroll
        for (int j = 0; j < 8; ++j) ss += (cur[j][0] * cur[j][0] + cur[j][1] * cur[j][1]) + (cur[j][2] * cur[j][2] + cur[j][3] * cur[j][3]);
        ss = wave_sum(ss); const float rs = rsqrtf(ss * (1.0f / D) + EPS);
        v2u* o = (v2u*)(U + (size_t)r * D) + F.lane;
#pragma unroll
        for (int j = 0; j < 8; ++j) { const f32x4 y = cur[j] * rs * Gc[j] + Sc[j]; v2u w; w.x = cvt_pk(y[0], y[1]); w.y = cvt_pk(y[2], y[3]); o[64 * j] = w; }
#pragma unroll
        for (int j = 0; j < 8; ++j) cur[j] = nxt[j];
        bi = bnx;
    }
}

struct QkCtx { const float *qna, *kna, *qnc, *knc; f32x4 cs, sn; float sgn; int half, li; };
__device__ __forceinline__ int qk_col(const QkCtx& q, int it, const float*& g) {
    const int hidx = 2 * it + q.half; int colbase;
    if (hidx < 8) { colbase = C_AQ + hidx * 128; g = q.qna; } else if (hidx < 16) { colbase = C_AK + (hidx - 8) * 128; g = q.kna; }
    else if (hidx < 24) { colbase = C_CQ + (hidx - 16) * 128; g = q.qnc; } else { colbase = C_CK + (hidx - 24) * 128; g = q.knc; }
    return colbase + 4 * q.li;
}
__device__ __forceinline__ v2u qk_math(const v2u raw, const float* g, const QkCtx& q) {
    f32x4 x = {bflo(raw.x), bfhi(raw.x), bflo(raw.y), bfhi(raw.y)};
    float ss = (x[0] * x[0] + x[1] * x[1]) + (x[2] * x[2] + x[3] * x[3]);
    ss = row16_sum(ss); ss += __shfl_xor(ss, 16);
    const float rn = rsqrtf(ss * (1.0f / 128.0f) + EPS);
    const f32x4 gg = *(const f32x4*)(g + 4 * q.li);
    f32x4 y = x * rn * gg;
    f32x4 pr; pr[0] = dpp_f<0x128>(0.f, y[0]); pr[1] = dpp_f<0x128>(0.f, y[1]); pr[2] = dpp_f<0x128>(0.f, y[2]); pr[3] = dpp_f<0x128>(0.f, y[3]);
    y = y * q.cs + pr * q.sn * q.sgn;
    v2u w; w.x = cvt_pk(y[0], y[1]); w.y = cvt_pk(y[2], y[3]); return w;
}
template <int N> __device__ __forceinline__ void qk_heads(bf16* prow, const QkCtx& q, const int (&its)[N]) {
    v2u raw[N]; int col[N]; const float* g[N];
#pragma unroll
    for (int k = 0; k < N; ++k) { col[k] = qk_col(q, its[k], g[k]); raw[k] = *(const v2u*)(prow + col[k]); }
#pragma unroll
    for (int k = 0; k < N; ++k) raw[k] = qk_math(raw[k], g[k], q);
#pragma unroll
    for (int k = 0; k < N; ++k) *(v2u*)(prow + col[k]) = raw[k];
}
__device__ __forceinline__ void pc_qk(Frame& F, int l) {
    phase_ids(F); l = launder_s(l); KArgs a = kargs();
    bf16* PROJ = (bf16*)(F.ws + WS_PROJ);
    const float* rc = (const float*)(F.ws + WS_ROPE); const float* rs = rc + 2048 * 64;
    QkCtx q; q.qna = ain(a, I_QNA) + l * 128; q.kna = ain(a, I_KNA) + l * 128; q.qnc = ain(a, I_QNC) + l * 128; q.knc = ain(a, I_KNC) + l * 128;
    q.half = F.lane >> 5; q.li = F.lane & 31; q.sgn = (q.li & 8) ? 1.0f : -1.0f;
    for (int r = F.gw; r < ROWS; r += F.NGW) {
        int b, i; row_split(r, b, i); const bool lat = i >= CTXL; const int t = i - CTXL;
        bf16* prow = PROJ + (size_t)r * INC;
        q.cs = (f32x4){1.f, 1.f, 1.f, 1.f}; q.sn = (f32x4){0.f, 0.f, 0.f, 0.f};
        if (lat) { const int ti = t * 64 + (q.li >> 4) * 32 + 4 * (q.li & 7); q.cs = *(const f32x4*)(rc + ti); q.sn = *(const f32x4*)(rs + ti); }
        if (l == 1 && !lat) { const int its[5] = {4, 5, 6, 7, 12}; qk_heads<5>(prow, q, its); }
        else { const int its[13] = {0, 1, 2, 3, 4, 5, 6, 7, 8, 9, 10, 11, 12}; qk_heads<13>(prow, q, its); }
    }
}

template <bool FWD> __device__ __forceinline__ void row_scan(float& A, float& H) {
#define RS_STEP(N) { const float Ap = dpp_f<(FWD ? 0x110 : 0x100) + N>(1.0f, A); const float Hp = dpp_f<(FWD ? 0x110 : 0x100) + N>(0.0f, H); H = fmaf(A, Hp, H); A = A * Ap; }
    RS_STEP(1) RS_STEP(2) RS_STEP(4) RS_STEP(8)
#undef RS_STEP
}
__device__ __forceinline__ void pc_lru(Frame& F, int l) {
    phase_ids(F); l = launder_s(l); KArgs a = kargs();
    const bf16* PROJ = (const bf16*)(F.ws + WS_PROJ);
    bf16* hloc = (bf16*)(F.ws + WS_BIG); bf16* acum = hloc + (size_t)2 * ROWS * 1024;
    float* cA = (float*)(F.ws + WS_CARRY); float* cH = cA + CARRY_N;
    const bf16* LW = (const bf16*)(F.ws + WS_LRUW);
    const float* SP = (const float*)(F.ws + WS_MISC + MISC_SP) + (size_t)l * 2 * 1024;
    const float* convw = ain(a, I_CONVW) + (size_t)l * 4 * 1024; const float* convb = ain(a, I_CONVB) + (size_t)l * 1024;
    const int dir = F.wave >> 2, cq = F.wave & 3, tl = F.lane & 15, q4 = F.lane >> 4;
    const int ct = F.tid >> 4, ch0 = (F.tid & 15) * 8;
    const int NU = NB * NCH * 8;
    int n_cur = -1, n_cw = -1; bf16x8 Wa[2][4], Wx[2][4]; f32x4 ba[2], bx[2], sp[2], cb0, cb1, cw0[4], cw1[4];
    v4u raw[4]; int u = blockIdx.x;
#define LRU_LOAD(U) { const int n_ = (U) & 7, bc_ = (U) >> 3, c_ = bc_ % NCH, b_ = bc_ / NCH; const int r0_ = b_ * TB + c_ * 32; \
        const int lo_ = (c_ < 8) ? b_ * TB : b_ * TB + CTXL, hi_ = (c_ < 8) ? b_ * TB + CTXL : (b_ + 1) * TB; \
        _Pragma("unroll") for (int k = 0; k < 4; ++k) { const int rr = r0_ + ct - 2 + k; raw[k] = (v4u){0u, 0u, 0u, 0u}; \
            if (rr >= lo_ && rr < hi_) raw[k] = *(const v4u*)(PROJ + (size_t)rr * INC + C_BX + n_ * 128 + ch0); } }
    if (u < NU) LRU_LOAD(u);
    int buf = 0;
    for (; u < NU; u += F.G) {
        const int n = u & 7, bc = u >> 3, c = bc % NCH, b = bc / NCH; const int r0 = b * TB + c * 32;
        LAS bf16* xcb = (LAS bf16*)(F.ldsl + buf * 25600); LAS float* xcf = (LAS float*)(F.ldsl + buf * 25600 + 8704);
        if (n != n_cw) { n_cw = n; const int chg = n * 128 + ch0; cb0 = *(const f32x4*)(convb + chg); cb1 = *(const f32x4*)(convb + chg + 4);
#pragma unroll
            for (int k = 0; k < 4; ++k) { cw0[k] = *(const f32x4*)(convw + k * 1024 + chg); cw1[k] = *(const f32x4*)(convw + k * 1024 + chg + 4); } }
        { float acc8[8];
#pragma unroll
          for (int e = 0; e < 4; ++e) { acc8[e] = cb0[e]; acc8[4 + e] = cb1[e]; }
#pragma unroll
          for (int k = 0; k < 4; ++k) { const v4u rw = raw[k];
              const f32x4 w0 = cw0[k], w1 = cw1[k];
              acc8[0] += w0[0] * bflo(rw.x); acc8[1] += w0[1] * bfhi(rw.x); acc8[2] += w0[2] * bflo(rw.y); acc8[3] += w0[3] * bfhi(rw.y);
              acc8[4] += w1[0] * bflo(rw.z); acc8[5] += w1[1] * bfhi(rw.z); acc8[6] += w1[2] * bflo(rw.w); acc8[7] += w1[3] * bfhi(rw.w); }
          v4u pk; pk.x = cvt_pk(acc8[0], acc8[1]); pk.y = cvt_pk(acc8[2], acc8[3]); pk.z = cvt_pk(acc8[4], acc8[5]); pk.w = cvt_pk(acc8[6], acc8[7]);
          *(LAS v4u*)(xcb + ct * 136 + ch0) = pk;
          *(LAS f32x4*)(xcf + ct * 132 + ch0) = (f32x4){acc8[0], acc8[1], acc8[2], acc8[3]}; *(LAS f32x4*)(xcf + ct * 132 + ch0 + 4) = (f32x4){acc8[4], acc8[5], acc8[6], acc8[7]}; }
        __syncthreads();
        if (u + F.G < NU) LRU_LOAD(u + F.G);
        if (n != n_cur) { n_cur = n;
#pragma unroll
            for (int nt = 0; nt < 2; ++nt) { const int chA = cq * 32 + nt * 16 + tl;
#pragma unroll
                for (int k = 0; k < 4; ++k) {
                    Wa[nt][k] = *(const bf16x8*)(LW + ((((size_t)(l * 2 + 0) * 2 + dir) * 8 + n) * 128 + chA) * 128 + k * 32 + q4 * 8);
                    Wx[nt][k] = *(const bf16x8*)(LW + ((((size_t)(l * 2 + 1) * 2 + dir) * 8 + n) * 128 + chA) * 128 + k * 32 + q4 * 8); }
                const int chg = n * 128 + cq * 32 + nt * 16 + 4 * q4;
                ba[nt] = *(const f32x4*)(ain(a, I_LBA) + ((size_t)l * 2 + dir) * 1024 + chg); bx[nt] = *(const f32x4*)(ain(a, I_LBX) + ((size_t)l * 2 + dir) * 1024 + chg);
                sp[nt] = *(const f32x4*)(SP + (size_t)dir * 1024 + chg); } }
#pragma unroll
        for (int nt = 0; nt < 2; ++nt) {
            const int chl = cq * 32 + nt * 16 + 4 * q4;
            f32x4 av[2], hv[2];
#pragma unroll
            for (int mt = 0; mt < 2; ++mt) {
                f32x4 ra = {0.f, 0.f, 0.f, 0.f}, rx = {0.f, 0.f, 0.f, 0.f};
#pragma unroll
                for (int k = 0; k < 4; ++k) { const bf16x8 X = *(const LAS bf16x8*)(xcb + (mt * 16 + tl) * 136 + k * 32 + q4 * 8);
                    ra = __builtin_amdgcn_mfma_f32_16x16x32_bf16(Wa[nt][k], X, ra, 0, 0, 0); rx = __builtin_amdgcn_mfma_f32_16x16x32_bf16(Wx[nt][k], X, rx, 0, 0, 0); }
                const f32x4 xv = *(const LAS f32x4*)(xcf + (mt * 16 + tl) * 132 + chl);
#pragma unroll
                for (int j = 0; j < 4; ++j) { const float rg = sigmoidf_(ra[j] + ba[nt][j]), ig = sigmoidf_(rx[j] + bx[nt][j]);
                    const float la = -8.0f * rg * sp[nt][j]; const float aa = __expf(la); const float mult = sqrtf(fmaxf(1.0f - aa * aa, 0.0f));
                    av[mt][j] = aa; hv[mt][j] = mult * ig * xv[j]; }
            }
            f32x4 cAo, cHo;
#pragma unroll
            for (int j = 0; j < 4; ++j) {
                float A0 = av[0][j], H0 = hv[0][j], A1 = av[1][j], H1 = hv[1][j];
                if (dir == 0) { row_scan<true>(A0, H0); row_scan<true>(A1, H1);
                    const float Ac = __shfl(A0, (F.lane & 48) | 15), Hc = __shfl(H0, (F.lane & 48) | 15);
                    H1 = fmaf(A1, Hc, H1); A1 = A1 * Ac; cAo[j] = A1; cHo[j] = H1; }
                else { row_scan<false>(A0, H0); row_scan<false>(A1, H1);
                    const float Ac = __shfl(A1, (F.lane & 48)), Hc = __shfl(H1, (F.lane & 48));
                    H0 = fmaf(A0, Hc, H0); A0 = A0 * Ac; cAo[j] = A0; cHo[j] = H0; }
                av[0][j] = A0; hv[0][j] = H0; av[1][j] = A1; hv[1][j] = H1;
            }
#pragma unroll
            for (int mt = 0; mt < 2; ++mt) { const size_t o = ((size_t)dir * ROWS + r0 + mt * 16 + tl) * 1024 + n * 128 + chl;
                v2u wh, wa; wh.x = cvt_pk(hv[mt][0], hv[mt][1]); wh.y = cvt_pk(hv[mt][2], hv[mt][3]); wa.x = cvt_pk(av[mt][0], av[mt][1]); wa.y = cvt_pk(av[mt][2], av[mt][3]);
                *(v2u*)(hloc + o) = wh; *(v2u*)(acum + o) = wa; }
            if (tl == (dir == 0 ? 15 : 0)) { const size_t ci = (((size_t)dir * NB + b) * NCH + c) * 1024 + n * 128 + chl; *(f32x4*)(cA + ci) = cAo; *(f32x4*)(cH + ci) = cHo; }
        }
        buf ^= 1;
    }
#undef LRU_LOAD
}

__device__ __forceinline__ void pd_chain(Frame& F) {
    phase_ids(F);
    const float* cA = (const float*)(F.ws + WS_CARRY); const float* cH = cA + CARRY_N; float* Hin = (float*)(F.ws + WS_CARRY) + 2 * CARRY_N;
    for (int blk = blockIdx.x; blk < 32; blk += F.G) {
        const int idx = blk * 512 + F.tid, dir = idx >> 13, b = (idx >> 10) & 7, ch = idx & 1023;
        const size_t base = (((size_t)dir * NB + b) * NCH) * 1024 + ch; float H = 0.f;
        if (dir == 0) { for (int c = 0; c < NCH; ++c) { Hin[base + (size_t)c * 1024] = H; H = cA[base + (size_t)c * 1024] * H + cH[base + (size_t)c * 1024]; } }
        else { for (int c = 7; c >= 0; --c) { Hin[base + (size_t)c * 1024] = H; H = cA[base + (size_t)c * 1024] * H + cH[base + (size_t)c * 1024]; }
               for (int c = NCH - 1; c >= 8; --c) { Hin[base + (size_t)c * 1024] = H; H = cA[base + (size_t)c * 1024] * H + cH[base + (size_t)c * 1024]; } }
    }
}
__device__ __forceinline__ void pd_attn(Frame& F, int l) {
    phase_ids(F); l = launder_s(l);
    const bf16* PROJ = (const bf16*)(F.ws + WS_PROJ); bf16* OA = (bf16*)(F.ws + WS_OA); bf16* YC = (bf16*)(F.ws + WS_YC);
    constexpr int NLAT = NB * 8 * 24, NCTX = NB * 24;
    const int nun = NLAT + (l == 0 ? NCTX : 0);
    for (int u = blockIdx.x; u < nun; u += F.G) {
        int hh, b, q0row, seq;
        if (u < NLAT) {
            int qb;
            if (F.G == 256) {
                const int xcd = blockIdx.x & 7, slot = blockIdx.x >> 3, sg = (u >> 8) * 8 + xcd, k = sg % 6; b = sg / 6; qb = slot & 7;
                hh = k < 4 ? (2 * k + (slot >> 4)) * 2 + ((slot >> 3) & 1) : 16 + (k - 4) * 4 + (slot >> 3);
            } else { qb = u & 7; hh = (u >> 3) % 24; b = u / 192; }
            q0row = b * TB + CTXL + qb * 256; seq = TB; }
        else { const int v = u - NLAT; hh = v % 24; b = v / 24; q0row = b * TB; seq = CTXL; }
        const bf16* kb = PROJ + (size_t)b * TB * INC; const bf16* qp = PROJ + (size_t)q0row * INC;
        const bf16 *Q, *K, *V; bf16* O; int ldo;
        if (hh < 16) { const int m = hh >> 1, vh = hh & 1; Q = qp + C_AQ + m * 128; K = kb + C_AK + m * 128; V = kb + C_AV + (m >> 1) * 256 + vh * 128; O = OA + (size_t)q0row * D + m * 256 + vh * 128; ldo = D; }
        else { const int hq = hh - 16; Q = qp + C_CQ + hq * 128; K = kb + C_CK + (hq >> 2) * 128; V = kb + C_CV + (hq >> 2) * 128; O = YC + (size_t)q0row * 1024 + hq * 128; ldo = 1024; }
        att::attn_dense_body(Q, K, V, O, ldo, seq, (char*)F.lds);
        __syncthreads();
    }
}

__device__ __forceinline__ void pe_combine(Frame& F, int l) {
    phase_ids(F); l = launder_s(l); KArgs a = kargs();
    const bf16* OA = (const bf16*)(F.ws + WS_OA); bf16* YA = (bf16*)(F.ws + WS_YA); bf16* YB = (bf16*)(F.ws + WS_YB); const bf16* PROJ = (const bf16*)(F.ws + WS_PROJ);
    const bf16* hloc = (const bf16*)(F.ws + WS_BIG); const bf16* acum = hloc + (size_t)2 * ROWS * 1024;
    const float* Hin = (const float*)(F.ws + WS_CARRY) + 2 * CARRY_N;
    const float lam = ((const float*)(F.ws + WS_MISC + MISC_LAM))[l]; const float omli = 1.0f - (l == 0 ? 0.2f : 0.3555090676f);
    const f32x4 sg = *(const f32x4*)(ain(a, I_SUBN) + (size_t)l * 256 + 4 * F.lane);
    int r0, r1; wave_rows(F, ROWS, r0, r1);
#define PE_SKIP(r) (l == 1 && ((r) % TB) < CTXL)
    { v2u cur[8], nxt[8]; int r = r0; while (r < r1 && PE_SKIP(r)) ++r; bool have = r < r1;
      if (have) {
#pragma unroll
          for (int m = 0; m < 8; ++m) cur[m] = *(const v2u*)(OA + (size_t)r * D + m * 256 + 4 * F.lane); }
      while (have) {
          int rn = r + 1; while (rn < r1 && PE_SKIP(rn)) ++rn; const bool hn = rn < r1;
          if (hn) {
#pragma unroll
              for (int m = 0; m < 8; ++m) nxt[m] = *(const v2u*)(OA + (size_t)rn * D + m * 256 + 4 * F.lane); }
#pragma unroll
          for (int h = 0; h < 4; ++h) { const v2u p = cur[2 * h], q = cur[2 * h + 1];
              f32x4 o = {bflo(p.x) - lam * bflo(q.x), bfhi(p.x) - lam * bfhi(q.x), bflo(p.y) - lam * bflo(q.y), bfhi(p.y) - lam * bfhi(q.y)};
              float ss = (o[0] * o[0] + o[1] * o[1]) + (o[2] * o[2] + o[3] * o[3]); ss = wave_sum(ss);
              const float rn2 = rsqrtf(ss * (1.0f / 256.0f) + EPS) * omli;
              o = o * rn2 * sg; v2u w; w.x = cvt_pk(o[0], o[1]); w.y = cvt_pk(o[2], o[3]); *(v2u*)(YA + (size_t)r * 1024 + h * 256 + 4 * F.lane) = w; }
#pragma unroll
          for (int m = 0; m < 8; ++m) cur[m] = nxt[m];
          r = rn; have = hn; } }
    { v4u cur[2][5], nxt[2][5]; f32x4 Hf[2][2], Hb[2][2]; int ccur = -1;
#define PE_LD(X, r) { _Pragma("unroll") for (int hv = 0; hv < 2; ++hv) { const int ch = F.lane * 16 + hv * 8; \
          X[hv][0] = *(const v4u*)(hloc + (size_t)(r) * 1024 + ch); X[hv][1] = *(const v4u*)(acum + (size_t)(r) * 1024 + ch); \
          X[hv][2] = *(const v4u*)(hloc + ((size_t)ROWS + (r)) * 1024 + ch); X[hv][3] = *(const v4u*)(acum + ((size_t)ROWS + (r)) * 1024 + ch); \
          X[hv][4] = *(const v4u*)(PROJ + (size_t)(r) * INC + C_BY + ch); } }
      int r = r0; while (r < r1 && PE_SKIP(r)) ++r; bool have = r < r1;
      if (have) PE_LD(cur, r);
      while (have) {
          int rn = r + 1; while (rn < r1 && PE_SKIP(rn)) ++rn; const bool hn = rn < r1;
          if (hn) PE_LD(nxt, rn);
          const int b = r / TB, i = r - b * TB, c = i >> 5, cc = b * NCH + c;
          if (cc != ccur) { ccur = cc; const size_t hf = ((size_t)(0 * NB + b) * NCH + c) * 1024, hb = ((size_t)(1 * NB + b) * NCH + c) * 1024;
#pragma unroll
              for (int hv = 0; hv < 2; ++hv) { const int ch = F.lane * 16 + hv * 8;
                  Hf[hv][0] = *(const f32x4*)(Hin + hf + ch); Hf[hv][1] = *(const f32x4*)(Hin + hf + ch + 4); Hb[hv][0] = *(const f32x4*)(Hin + hb + ch); Hb[hv][1] = *(const f32x4*)(Hin + hb + ch + 4); } }
#pragma unroll
          for (int hv = 0; hv < 2; ++hv) { const int ch = F.lane * 16 + hv * 8;
              const v4u lf = cur[hv][0], af = cur[hv][1], lb = cur[hv][2], ab = cur[hv][3], by = cur[hv][4];
              const f32x4 Hf0 = Hf[hv][0], Hf1 = Hf[hv][1], Hb0 = Hb[hv][0], Hb1 = Hb[hv][1];
              float y[8];
#define FIX(e, LF, AF, LB, AB, BY, HF, HB, GET) { const float hsum = GET(LF) + GET(AF) * HF + GET(LB) + GET(AB) * HB; const float x = GET(BY); \
                  const float u2 = 0.7978845608f * (x + 0.044715f * x * x * x); const float th = 1.0f - 2.0f / (1.0f + __expf(2.0f * u2)); y[e] = hsum * 0.5f * x * (1.0f + th); }
              FIX(0, lf.x, af.x, lb.x, ab.x, by.x, Hf0[0], Hb0[0], bflo) FIX(1, lf.x, af.x, lb.x, ab.x, by.x, Hf0[1], Hb0[1], bfhi)
              FIX(2, lf.y, af.y, lb.y, ab.y, by.y, Hf0[2], Hb0[2], bflo) FIX(3, lf.y, af.y, lb.y, ab.y, by.y, Hf0[3], Hb0[3], bfhi)
              FIX(4, lf.z, af.z, lb.z, ab.z, by.z, Hf1[0], Hb1[0], bflo) FIX(5, lf.z, af.z, lb.z, ab.z, by.z, Hf1[1], Hb1[1], bfhi)
              FIX(6, lf.w, af.w, lb.w, ab.w, by.w, Hf1[2], Hb1[2], bflo) FIX(7, lf.w, af.w, lb.w, ab.w, by.w, Hf1[3], Hb1[3], bfhi)
#undef FIX
              v4u w; w.x = cvt_pk(y[0], y[1]); w.y = cvt_pk(y[2], y[3]); w.z = cvt_pk(y[4], y[5]); w.w = cvt_pk(y[6], y[7]);
              *(v4u*)(YB + (size_t)r * 1024 + ch) = w; }
#pragma unroll
          for (int hv = 0; hv < 2; ++hv)
#pragma unroll
              for (int k = 0; k < 5; ++k) cur[hv][k] = nxt[hv][k];
          r = rn; have = hn; }
#undef PE_LD
    }
#undef PE_SKIP
}

__device__ __forceinline__ void ph_norm2_route(Frame& F, int l) {
    phase_ids(F); l = launder_s(l); KArgs a = kargs();
    const float* hl = aout(a); const float* hc = (const float*)(F.ws + WS_HC);
    const float* mod = (const float*)(F.ws + WS_MOD) + (size_t)l * 9 * (NMOD * D);
    const float* g = ain(a, I_N2G) + (size_t)l * D; bf16* V = (bf16*)(F.ws + WS_ACT);
    LAS bf16* Thi = (LAS bf16*)F.ldsl; LAS bf16* Tlo = (LAS bf16*)(F.ldsl + 65792);
    LAS float* red = (LAS float*)F.ldsl;
    LAS float* logit = (LAS float*)(F.ldsl + 24576);
    const bf16* wr = (const bf16*)(F.ws + WS_MISC + MISC_WR) + (size_t)l * 2 * 48 * 2048;
    unsigned* cnt = (unsigned*)(F.ws + WS_CTL) + CW_CNT + 64 * l;
    int* tok_e = (int*)(F.ws + WS_ROUTE + RT_E); int* tok_pos = (int*)(F.ws + WS_ROUTE + RT_POS); float* tok_p = (float*)(F.ws + WS_ROUTE + RT_P);
    int* list = (int*)(F.ws + WS_BIG);
    const int l15 = F.lane & 15, l4 = F.lane >> 4;
    for (int blk = blockIdx.x; blk < ROWS / 16; blk += F.G) {
        if (l == 1 && (blk % (TB / 16)) < CTXL / 16) continue;
#pragma unroll
        for (int rr = 0; rr < 2; ++rr) { const int lr = F.wave * 2 + rr, r = blk * 16 + lr;
            int b, i; row_split(r, b, i); bool ctx; const size_t off = hrow_off(b, i, ctx);
            const f32x4* xr = (const f32x4*)((ctx ? hc : hl) + off) + F.lane;
            f32x4 v[8];
#pragma unroll
            for (int j = 0; j < 8; ++j) v[j] = xr[64 * j];
            const float* mb = mod + (size_t)(ctx ? 8 : b) * (NMOD * D);
            norm_mod(v, g, mb + 3 * D, mb + 4 * D, F.lane);
            v2u* o = (v2u*)(V + (size_t)r * D) + F.lane;
#pragma unroll
            for (int j = 0; j < 8; ++j) { v2u w; w.x = cvt_pk(v[j][0], v[j][1]); w.y = cvt_pk(v[j][2], v[j][3]); o[64 * j] = w;
                v2u wl; wl.x = cvt_pk(v[j][0] - bflo(w.x), v[j][1] - bfhi(w.x)); wl.y = cvt_pk(v[j][2] - bflo(w.y), v[j][3] - bfhi(w.y));
                *(LAS v2u*)(Thi + lr * 2056 + (F.lane + 64 * j) * 4) = w; *(LAS v2u*)(Tlo + lr * 2056 + (F.lane + 64 * j) * 4) = wl; } }
        __syncthreads();
        f32x4 acc[3];
#pragma unroll
        for (int ct = 0; ct < 3; ++ct) acc[ct] = (f32x4){0.f, 0.f, 0.f, 0.f};
#pragma unroll 4
        for (int ks = 0; ks < 8; ++ks) { const int k0 = (F.wave * 8 + ks) * 32 + l4 * 8;
            const bf16x8 Ah = *(const LAS bf16x8*)(Thi + l15 * 2056 + k0), Al = *(const LAS bf16x8*)(Tlo + l15 * 2056 + k0);
#pragma unroll
            for (int ct = 0; ct < 3; ++ct) { const bf16x8 Bh = *(const bf16x8*)(wr + (size_t)(ct * 16 + l15) * 2048 + k0), Bl = *(const bf16x8*)(wr + (size_t)(48 + ct * 16 + l15) * 2048 + k0);
                acc[ct] = __builtin_amdgcn_mfma_f32_16x16x32_bf16(Ah, Bh, acc[ct], 0, 0, 0);
                acc[ct] = __builtin_amdgcn_mfma_f32_16x16x32_bf16(Ah, Bl, acc[ct], 0, 0, 0);
                acc[ct] = __builtin_amdgcn_mfma_f32_16x16x32_bf16(Al, Bh, acc[ct], 0, 0, 0); } }
        __syncthreads();
#pragma unroll
        for (int ct = 0; ct < 3; ++ct)
#pragma unroll
            for (int j = 0; j < 4; ++j) red[(F.wave * 16 + l4 * 4 + j) * 48 + ct * 16 + l15] = acc[ct][j];
        __syncthreads();
        for (int o = F.tid; o < 16 * 36; o += 512) { const int row = o / 36, e = o % 36; float s = 0.f;
#pragma unroll
            for (int w = 0; w < 8; ++w) s += red[(w * 16 + row) * 48 + e];
            s += e < 4 ? ain(a, I_BGRP)[l * 4 + e] : ain(a, I_BRT)[l * 32 + (e - 4)];
            logit[o] = s; }
        __syncthreads();
        if (F.tid < 16) { const LAS float* lg = logit + F.tid * 36; const int r = blk * 16 + F.tid;
            int gi = 0; float gm = lg[0];
            for (int e = 1; e < 4; ++e) { const float v = lg[e]; if (v > gm) { gm = v; gi = e; } }
            float gs = 0.f; for (int e = 0; e < 4; ++e) gs += expf(lg[e] - gm);
            const float gw = 1.0f / gs;
            const LAS float* el = lg + 4 + gi * 8;
            int i1 = 0; float v1 = el[0];
            for (int e = 1; e < 8; ++e) { const float v = el[e]; if (v > v1) { v1 = v; i1 = e; } }
            int i2 = -1; float v2 = -3.0e38f;
            for (int e = 0; e < 8; ++e) { const float v = el[e]; if (e != i1 && v > v2) { v2 = v; i2 = e; } }
            const float p1 = 1.0f / (1.0f + expf(v2 - v1)); const float p2 = 1.0f - p1;
            const int e1 = gi * 8 + i1, e2 = gi * 8 + i2;
            const unsigned pos1 = atomicAdd(&cnt[e1], 1u), pos2 = atomicAdd(&cnt[e2], 1u);
            list[(size_t)e1 * pg8::LCAP + pos1] = 2 * r; list[(size_t)e2 * pg8::LCAP + pos2] = 2 * r + 1;
            tok_e[2 * r] = e1; tok_e[2 * r + 1] = e2; tok_pos[2 * r] = (int)pos1; tok_pos[2 * r + 1] = (int)pos2; tok_p[2 * r] = p1 * gw; tok_p[2 * r + 1] = p2 * gw; }
        __syncthreads();
    }
}

constexpr int LDS_TAB_OFF = LDS_MISC_OFF + 64;
__device__ __forceinline__ LAS int* moe_tables(Frame& F, int l) {
    LAS int* tab = (LAS int*)(F.ldsl + LDS_TAB_OFF);
    const unsigned* cnt = (const unsigned*)(F.ws + WS_CTL) + CW_CNT + 64 * l;
    if (F.tid == 0) { int run = 0, nt = 0;
        for (int e = 0; e < NE; ++e) { const int c = (int)__hip_atomic_load(&cnt[e], __ATOMIC_RELAXED, __HIP_MEMORY_SCOPE_AGENT); tab[pg8::MT_CNT + e] = c; tab[pg8::MT_BASE + e] = run;
            const int n = (c + 255) >> 8; for (int t = 0; t < n; ++t) { tab[pg8::MT_E + nt] = e; tab[pg8::MT_P0 + nt] = t * 256; ++nt; } run += n * 256; }
        tab[pg8::MT_BASE + NE] = run; tab[0] = nt; }
    __syncthreads();
    return tab;
}

__device__ __forceinline__ void pl_moe_combine(Frame& F, int l) {
    phase_ids(F); l = launder_s(l); KArgs a = kargs();
    float* hl = aout(a); float* hc = (float*)(F.ws + WS_HC);
    const float* mod = (const float*)(F.ws + WS_MOD) + (size_t)l * 9 * (NMOD * D);
    const bf16* YS = (const bf16*)(F.ws + WS_BIG);
    const int* tok_e = (const int*)(F.ws + WS_ROUTE + RT_E); const int* tok_pos = (const int*)(F.ws + WS_ROUTE + RT_POS); const float* tok_p = (const float*)(F.ws + WS_ROUTE + RT_P);
    const LAS int* tab = moe_tables(F, l);
    int r0, r1; wave_rows(F, ROWS, r0, r1);
    int md0 = 0, md1 = 0; float mp0 = 0.f, mp1 = 0.f;
    if (r0 + F.lane < r1) { const int r = r0 + F.lane; md0 = tab[pg8::MT_BASE + (tok_e[2 * r] & 31)] + tok_pos[2 * r]; md1 = tab[pg8::MT_BASE + (tok_e[2 * r + 1] & 31)] + tok_pos[2 * r + 1]; mp0 = tok_p[2 * r]; mp1 = tok_p[2 * r + 1]; }
    f32x4 hcur[8], hnxt[8]; v2u y0c[8], y1c[8], y0n[8], y1n[8]; int bi = 0; bool have = false;
#define PL_SKIP(r) (l == 1 && ((r) % TB) < CTXL)
#define PL_LOAD(H, Y0, Y1, r, BI) { const f32x4* hp_ = (const f32x4*)hrow_ptr(hl, hc, (r), BI) + F.lane; const int k_ = (r) - r0; \
        const int d0_ = __shfl(md0, k_), d1_ = __shfl(md1, k_); const v2u* a0_ = (const v2u*)(YS + (size_t)d0_ * D) + F.lane; const v2u* a1_ = (const v2u*)(YS + (size_t)d1_ * D) + F.lane; \
        _Pragma("unroll") for (int j = 0; j < 8; ++j) { H[j] = hp_[64 * j]; Y0[j] = a0_[64 * j]; Y1[j] = a1_[64 * j]; } }
    int r = r0; while (r < r1 && PL_SKIP(r)) ++r;
    if (r < r1) { PL_LOAD(hcur, y0c, y1c, r, bi); have = true; }
    while (have) {
        int rn = r + 1; while (rn < r1 && PL_SKIP(rn)) ++rn;
        int bnx = bi; const bool hn = rn < r1;
        if (hn) PL_LOAD(hnxt, y0n, y1n, rn, bnx);
        const float p0 = __shfl(mp0, r - r0), p1 = __shfl(mp1, r - r0);
        const float* mg = mod + (size_t)bi * (NMOD * D) + 5 * D;
        int bdummy; float* hp = (float*)hrow_ptr(hl, hc, r, bdummy);
#pragma unroll
        for (int j = 0; j < 8; ++j) { const int c = (F.lane + 64 * j) * 4; const v2u u0 = y0c[j], u1 = y1c[j];
            const f32x4 g = *(const f32x4*)(mg + c); f32x4 h = hcur[j];
            h[0] += g[0] * (p0 * bflo(u0.x) + p1 * bflo(u1.x)); h[1] += g[1] * (p0 * bfhi(u0.x) + p1 * bfhi(u1.x));
            h[2] += g[2] * (p0 * bflo(u0.y) + p1 * bflo(u1.y)); h[3] += g[3] * (p0 * bfhi(u0.y) + p1 * bfhi(u1.y));
            *(f32x4*)(hp + c) = h; }
#pragma unroll
        for (int j = 0; j < 8; ++j) { hcur[j] = hnxt[j]; y0c[j] = y0n[j]; y1c[j] = y1n[j]; }
        r = rn; bi = bnx; have = hn;
    }
#undef PL_LOAD
#undef PL_SKIP
}

constexpr int PH_PER_LAYER = 12, N_PHASES = 1 + 2 * PH_PER_LAYER;
#ifndef PHMASK
#define PHMASK 0xffffffffu
#endif
#define EN(j) ((PHMASK >> (j)) & 1u)
#define IN(k) (lo <= (k) && (k) < hi)
#define SEAM(k) do { if (IN(k) && IN((k) + 1)) xcd_barrier(bar); } while (0)
#ifndef REPMASK
#define REPMASK 0u
#endif
#define RUNPH(j, k, ...) if (EN(j) && IN(p + k)) { { __VA_ARGS__ } if constexpr (((REPMASK) >> (j)) & 1u) { __syncthreads(); { __VA_ARGS__ } } }
template <int l> __device__ __forceinline__ void layer_phases(Frame& F, const int lo, const int hi, const XcdBarrier& bar) {
        constexpr int p = 1 + l * PH_PER_LAYER;
        constexpr int LAT = (l == 1);
        constexpr int NPAN = LAT ? 64 : 72;
        RUNPH(1, 0,  pa_norm1(F, l); if (l > 0) { __syncthreads(); conv_weights(F, l, CV_O_OUT, CV_O_W13, 0); } )
        SEAM(p + 0);
        RUNPH(2, 1,  phase_ids(F); unsigned char* ws = F.ws; KArgs a = kargs(); const int ll = launder_s(l);
            pg8::Gemm1Order S{pg8::make_gb((const bf16*)(ws + WS_ACT), D, (const bf16*)(ws + WS_WIN), D), F.G, (int)blockIdx.x, LAT};
            pg8::EpiBf16T<true> E{(bf16*)(ws + WS_PROJ), INC, 0xffff, ain(a, I_BGATE) + (size_t)ll * 3 * D}; pg8::gemm_phase(F.ldsl, D, D, D, S, E);
            if (l == 0) { __syncthreads(); conv_weights(F, 1, CV_O_W13, CV_O_W13 + 10240, (72 * 50) % F.G); } )
        SEAM(p + 1);
        if (EN(3) && IN(p + 2)) { pc_qk(F, l); __syncthreads(); pc_lru(F, l); if constexpr (((REPMASK) >> 3) & 1u) { __syncthreads(); pc_lru(F, l); } }
        SEAM(p + 2);
        RUNPH(4, 3,  pd_chain(F); pd_attn(F, l); )
        SEAM(p + 3);
        RUNPH(5, 4,  pe_combine(F, l); )
        SEAM(p + 4);
        RUNPH(6, 5,  phase_ids(F); unsigned char* ws = F.ws;
            pg8::BranchOrder S{ pg8::StaticOrder{pg8::make_gb((const bf16*)(ws + WS_YA), 1024, (const bf16*)(ws + WS_WBR), 1024), NPAN, D / 256, F.G, (int)blockIdx.x, LAT},
                                (size_t)(WS_YB - WS_YA) };
            static_assert(WS_YC - WS_YB == WS_YB - WS_YA, "branch inputs equally spaced");
            pg8::EpiChain E{(bf16*)(ws + WS_ACT), (const bf16*)(ws + WS_PROJ)}; pg8::gemm_phase(F.ldsl, 1024, 1024, 1024, S, E);
            if (l == 0) { __syncthreads(); conv_weights(F, 1, CV_O_W13 + 10240, CV_NIT, (72 * 8) % F.G); } )
        SEAM(p + 5);
        RUNPH(7, 6,  phase_ids(F); unsigned char* ws = F.ws; KArgs a = kargs(); const int ll = launder_s(l);
            pg8::StaticOrder S{pg8::make_gb((const bf16*)(ws + WS_ACT), D, (const bf16*)(ws + WS_WOUT), D), NPAN, D / 256, F.G, (int)blockIdx.x, LAT};
            pg8::EpiWout E{ll == 0 ? ain(a, I_X) : (const float*)aout(a), ll == 0 ? ain(a, I_CTX) : (const float*)(ws + WS_HC), aout(a), (float*)(ws + WS_HC), (const float*)(ws + WS_MOD) + (size_t)ll * 9 * (NMOD * D)};
            pg8::gemm_phase(F.ldsl, D, D, D, S, E);
            if (l == 0) { __syncthreads(); conv_weights(F, 1, 0, CV_O_OUT, (72 * 8) % F.G); } )
        SEAM(p + 6);
        RUNPH(8, 7,  ph_norm2_route(F, l); )
        SEAM(p + 7);
        RUNPH(10, 9,  phase_ids(F); unsigned char* ws = F.ws; const LAS int* tab = moe_tables(F, l);
            pg8::MoeOrderG S{pg8::make_gb((const bf16*)(ws + WS_ACT), D, (const bf16*)(ws + (l ? WS_W13B : WS_W13)), D), tab, (const int*)(ws + WS_BIG), (unsigned)(D * 2), 4, F.G, (int)blockIdx.x};
            pg8::EpiUp E{(bf16*)(ws + WS_OA)}; pg8::gemm_phase(F.ldsl, D, D, D, S, E); )
        SEAM(p + 9);
        RUNPH(11, 10,  phase_ids(F); unsigned char* ws = F.ws; const LAS int* tab = moe_tables(F, l);
            pg8::MoeOrder S{pg8::make_gb((const bf16*)(ws + WS_OA), DE, (const bf16*)(ws + (l ? WS_W2B : WS_W2)), DE), tab, nullptr, 0u, 8, F.G, (int)blockIdx.x};
            pg8::EpiBf16 E{(bf16*)(ws + WS_BIG), D, 7, nullptr}; pg8::gemm_phase(F.ldsl, DE, DE, DE, S, E); )
        SEAM(p + 10);
        RUNPH(12, 11,  pl_moe_combine(F, l); )
        SEAM(p + 11);
}
__global__ void __launch_bounds__(512, 2) mega_fwd(Args args) {
    extern __shared__ __attribute__((aligned(16))) unsigned char lds[];
    Frame F;
    F.lds0 = lds; F.lds = lds; F.ldsl = (LAS unsigned char*)lds; F.ws = args.ws;
    F.tid = threadIdx.x; F.lane = F.tid & 63; F.wave = __builtin_amdgcn_readfirstlane(F.tid >> 6);
    F.G = gridDim.x; F.gw = blockIdx.x * 8 + F.wave; F.NGW = F.G * 8;
    volatile LAS unsigned* misc = (volatile LAS unsigned*)(F.ldsl + LDS_MISC_OFF);
    if (F.tid < 4) misc[F.tid] = 0u;
    __syncthreads();
    const int lo = args.ph_lo, hi = args.ph_hi;
    XcdBarrier bar; bar.bar = (unsigned*)(args.ws + WS_CTL) + CW_BAR; bar.x = 0; bar.st = misc;
    if (hi - lo > 1) bar = xcd_barrier_post((unsigned*)(args.ws + WS_CTL) + CW_BAR, misc);
    if (EN(0) && IN(0)) { p0_misc(F); __syncthreads(); conv_weights(F, 0, 0, CV_NIT, 0); if constexpr ((REPMASK) & 1u) { __syncthreads(); conv_weights(F, 0, 0, CV_NIT, 0); } }
    SEAM(0);
    layer_phases<0>(F, lo, hi, bar);
    layer_phases<1>(F, lo, hi, bar);
#undef IN
#undef SEAM
}

#ifndef MK_SINGLE
#define MK_SINGLE 1
#endif
extern "C" void kernel_launch(void* const* d_in, const int* in_sizes, int n_in, void* d_out, int out_size, void* d_ws, size_t ws_size, hipStream_t stream) {
    static int grid = 0;
    if (grid == 0) {
        if (n_in != 34 || out_size != NB * SEQ * D || ws_size < WS_END) { fprintf(stderr, "kernel_launch: unexpected shapes (n_in %d out %d ws %zu, need ws >= %zu)\n", n_in, out_size, ws_size, (size_t)WS_END); grid = -1; return; }
        int dev = 0, cus = 0, per_cu = 0;
        if (hipGetDevice(&dev) != hipSuccess || hipDeviceGetAttribute(&cus, hipDeviceAttributeMultiprocessorCount, dev) != hipSuccess) { grid = -1; return; }
        if (hipFuncSetAttribute((const void*)mega_fwd, hipFuncAttributeMaxDynamicSharedMemorySize, LDS_BYTES) != hipSuccess) { fprintf(stderr, "kernel_launch: hipFuncSetAttribute failed\n"); grid = -1; return; }
        if (hipOccupancyMaxActiveBlocksPerMultiprocessor(&per_cu, (const void*)mega_fwd, 512, LDS_BYTES) != hipSuccess || per_cu < 1) fprintf(stderr, "kernel_launch: occupancy query says %d\n", per_cu);
        (void)hipGetLastError();
        grid = cus;
    }
    if (grid < 0) return;
    (void)hipMemsetAsync((char*)d_ws + WS_CTL, 0, CTL_ZERO_BYTES, stream);
    Args a{};
    for (int i = 0; i < 34; ++i) a.in[i] = (const float*)d_in[i];
    a.out = (float*)d_out; a.ws = (unsigned char*)d_ws;
#if MK_SINGLE
    a.ph_lo = 0; a.ph_hi = N_PHASES;
    hipLaunchKernelGGL(mega_fwd, dim3(grid), dim3(512), LDS_BYTES, stream, a);
#else
    for (int p = 0; p < N_PHASES; ++p) { a.ph_lo = p; a.ph_hi = p + 1; hipLaunchKernelGGL(mega_fwd, dim3(grid), dim3(512), LDS_BYTES, stream, a); }
#endif
    const hipError_t le = hipPeekAtLastError();
    if (le != hipSuccess) fprintf(stderr, "kernel_launch: launch failed: %s\n", hipGetErrorName(le));
}
```

```cpp
#include <hip/hip_runtime.h>
#include <cstdio>
#include <cstdint>

#define GAS __attribute__((address_space(1)))
#define LAS __attribute__((address_space(3)))
typedef unsigned short bf16;
typedef unsigned v4u __attribute__((ext_vector_type(4)));
typedef unsigned v2u __attribute__((ext_vector_type(2)));
typedef float f32x4 __attribute__((ext_vector_type(4)));
typedef float f32x2 __attribute__((ext_vector_type(2)));
typedef short bf16x8 __attribute__((ext_vector_type(8)));
#define LDS_WAIT() asm volatile("s_waitcnt lgkmcnt(0)" ::: "memory")
#define VM_WAIT() asm volatile("s_waitcnt vmcnt(0)" ::: "memory")

constexpr int D = 2048, NB = 8, SEQ = 2048, CTXL = 256, TB = SEQ + CTXL, ROWS = NB * TB;
constexpr int INC = 12800;
constexpr int C_AQ = 0, C_AK = 1024, C_AV = 2048, C_BX = 3072, C_BY = 4096, C_CQ = 5120, C_CK = 6144, C_CV = 6400, C_G = 6656;
constexpr int NE = 32, DE = 512, NMOD = 6;
constexpr int MS = 45056;
constexpr int NCH = TB / 32;
constexpr float EPS = 1e-6f;

constexpr size_t MiB = 1u << 20;
constexpr size_t WS_CTL = 0, CTL_ZERO_BYTES = 1 * MiB;
constexpr size_t WS_MOD = 1 * MiB;
constexpr size_t WS_ROPE = 2 * MiB;
constexpr size_t WS_MISC = 3 * MiB;
constexpr size_t WS_LRUW = 4 * MiB;
constexpr size_t WS_ROUTE = 6 * MiB;
constexpr size_t WS_CARRY = 8 * MiB;
constexpr size_t WS_WIN = 24 * MiB;
constexpr size_t WS_WBR = 74 * MiB;
constexpr size_t WS_WOUT = 86 * MiB;
constexpr size_t WS_W13 = 94 * MiB;
constexpr size_t WS_W2 = 222 * MiB;
constexpr size_t WS_HC = 286 * MiB;
constexpr size_t WS_H16L = 158 * MiB;
constexpr size_t WS_ACT = 302 * MiB;
constexpr size_t WS_PROJ = 374 * MiB;
constexpr size_t WS_BIG = 824 * MiB;
constexpr size_t WS_OA = 1000 * MiB;
constexpr size_t WS_YA = 1072 * MiB;
constexpr size_t WS_YB = 1108 * MiB;
constexpr size_t WS_YC = 1144 * MiB;
constexpr size_t WS_WING8 = WS_WIN + (size_t)C_G * D * 2;
constexpr size_t WS_V8 = WS_YA;
constexpr size_t WS_U8 = WS_OA;
constexpr size_t WS_W13B = 1185 * MiB;
constexpr size_t WS_W2B = 1313 * MiB;
constexpr size_t WS_END = 1377 * MiB;
constexpr int CW_BAR = 4096;
constexpr int CW_CNT = 8192;
constexpr size_t MISC_LAM = 0;
constexpr size_t MISC_TILE = 1024;
constexpr size_t MISC_WR = 4096;
constexpr size_t MISC_QKG = 1000 * 1024;
constexpr size_t MISC_SP = 960 * 1024;
constexpr size_t RT_E = 0, RT_POS = 256 * 1024, RT_P = 512 * 1024, RT_DEST = 768 * 1024;
constexpr size_t CARRY_N = (size_t)2 * NB * NCH * 1024;
constexpr int LDS_BYTES = 147456;
constexpr int LDS_MISC_OFF = 135168;
constexpr int LDS_SSX_OFF = 139264;

__device__ __forceinline__ float bf2f(unsigned short b) { return __uint_as_float(((unsigned)b) << 16); }
__device__ __forceinline__ float bflo(unsigned u) { return __uint_as_float(u << 16); }
__device__ __forceinline__ float bfhi(unsigned u) { return __uint_as_float(u & 0xffff0000u); }
typedef __bf16 bf16x2_t_ __attribute__((ext_vector_type(2))); typedef float f32x2_t_ __attribute__((ext_vector_type(2)));
__device__ __forceinline__ unsigned cvt_pk(float lo, float hi) { const f32x2_t_ v = {lo, hi}; return __builtin_bit_cast(unsigned, __builtin_convertvector(v, bf16x2_t_)); }
__device__ __forceinline__ float sigmoidf_(float x) { return __builtin_amdgcn_rcpf(1.0f + __expf(-x)); }
template <int CTRL> __device__ __forceinline__ float dpp_f(float oldv, float src) {
    return __builtin_bit_cast(float, __builtin_amdgcn_update_dpp(__builtin_bit_cast(int, oldv), __builtin_bit_cast(int, src), CTRL, 0xf, 0xf, false));
}

__device__ __forceinline__ float row16_sum(float v) {
    v += dpp_f<0xB1>(0.f, v); v += dpp_f<0x4E>(0.f, v); v += dpp_f<0x141>(0.f, v); v += dpp_f<0x140>(0.f, v); return v;
}
__device__ __forceinline__ float wave_sum(float v) {
    v = row16_sum(v); v += __shfl_xor(v, 16);
    { auto rr = __builtin_amdgcn_permlane32_swap(__float_as_uint(v), __float_as_uint(v), false, false); v = __uint_as_float(rr[0]) + __uint_as_float(rr[1]); }
    return v;
}
namespace pg8 {
constexpr int BM = 256, BK = 64, HALF = 128, HTB = HALF * BK * 2, STAGE_BYTES = 8 * HTB, NXCD = 8, WGM = 8;
__host__ __device__ __forceinline__ int lds_byte(int r, int c) { const int st = (r >> 4) * 2 + (c >> 5), rr = r & 15, cc = c & 31, ob = rr * 64 + cc * 2; return st * 1024 + (ob ^ (((ob >> 9) & 1) << 5)); }
__host__ __device__ __forceinline__ void stage_rc(int b, int& R, int& C) { const int st = b / 1024, sb = b % 1024, swz = sb ^ (((sb >> 9) & 1) << 5); R = (st >> 1) * 16 + swz / 64; C = (st & 1) * 32 + (swz % 64) / 2; }
__host__ __device__ __forceinline__ int perm32(int rho) { const int n = rho >> 4, i = rho & 15; return 8 * (i >> 2) + 4 * n + (i & 3); }
typedef int v4i_ __attribute__((ext_vector_type(4))); typedef int v8i_ __attribute__((ext_vector_type(8)));
struct Unit { int pm, pn, fl; };
struct GB { const char* A; const char* B; size_t tA, tB; };
__device__ __forceinline__ GB make_gb(const void* A, int lda, const void* B, int ldb, int es = 2) { GB g; g.A = (const char*)A; g.B = (const char*)B; g.tA = (size_t)BM * lda * es; g.tB = (size_t)BM * ldb * es; return g; }
__device__ __forceinline__ void static_tile(int nM, int nN, int L, int& pm, int& pn) {
    const int nwg = nM * nN; int wgid = L; { const int q = nwg / NXCD, r = nwg % NXCD, xcd = wgid % NXCD, off = wgid / NXCD; wgid = (xcd < r ? xcd * (q + 1) : r * (q + 1) + (xcd - r) * q) + off; }
    const int nig = WGM * nN, gid = wgid / nig, fm = gid * WGM, gsz = (nM - fm) < WGM ? (nM - fm) : WGM;
    pm = fm + ((wgid % nig) % gsz); pn = (wgid % nig) / gsz;
}
__device__ __forceinline__ int lat_panel(int pl) { return (pl >> 3) * 9 + 1 + (pl & 7); }
struct StaticOrder {
    static constexpr bool GATHER = false; __device__ __forceinline__ unsigned rowoff(const Unit&, int) const { return 0u; }
    GB gb; int nM, nN, G, c, lat;
    __device__ __forceinline__ bool next(int i, Unit& u) const {
        const long L = (long)i * G + c; if (L >= (long)nM * nN) return false;
        int pm, pn; static_tile(nM, nN, (int)L, pm, pn); u.pm = lat ? lat_panel(pm) : pm; u.pn = pn; u.fl = 0; return true;
    }
    __device__ __forceinline__ const char* a_base(const Unit& u) const { return gb.A + (size_t)u.pm * gb.tA; }
    __device__ __forceinline__ const char* b_base(const Unit& u) const { return gb.B + (size_t)u.pn * gb.tB; }
    __device__ __forceinline__ bool zero_after(const Unit&) const { return true; }
};
struct Gemm1Order {
    static constexpr bool GATHER = false; __device__ __forceinline__ unsigned rowoff(const Unit&, int) const { return 0u; }
    GB gb; int G, c, l1, nN;
    __device__ __forceinline__ bool next(int i, Unit& u) const {
        const long L = (long)i * G + c; int pm, pn; u.fl = 0;
        if (!l1) { if (L >= 72 * nN) return false; static_tile(72, nN, (int)L, pm, pn); }
        else if (L < 64 * nN) { static_tile(64, nN, (int)L, pm, pn); pm = lat_panel(pm); }
        else { const int q = (int)L - 64 * nN; if (q >= 8 * 14) return false; const int k = q % 14; pm = (q / 14) * 9; pn = k < 12 ? 4 + k : 12 + k; }
        u.pm = pm; u.pn = pn; return true;
    }
    __device__ __forceinline__ const char* a_base(const Unit& u) const { return gb.A + (size_t)u.pm * gb.tA; }
    __device__ __forceinline__ const char* b_base(const Unit& u) const { return gb.B + (size_t)u.pn * gb.tB; }
    __device__ __forceinline__ bool zero_after(const Unit&) const { return true; }
};
struct BranchOrder {
    static constexpr bool GATHER = false; __device__ __forceinline__ unsigned rowoff(const Unit&, int) const { return 0u; }
    StaticOrder so; size_t astride;
    __device__ __forceinline__ bool next(int i, Unit& u) const { if (!so.next(i / 3, u)) return false; u.fl = i % 3; return true; }
    __device__ __forceinline__ const char* a_base(const Unit& u) const { return so.gb.A + (size_t)u.fl * astride + (size_t)u.pm * so.gb.tA; }
    __device__ __forceinline__ const char* b_base(const Unit& u) const { return so.gb.B + (size_t)u.fl * ((size_t)D * 1024 * 2) + (size_t)u.pn * so.gb.tB; }
    __device__ __forceinline__ bool zero_after(const Unit& u) const { return u.fl == 2; }
};
constexpr int MT_E = 1, MT_P0 = 193, MT_CNT = 385, MT_BASE = 417, MT_WORDS = 452, LCAP = 2 * ROWS;
template <bool G_> struct MoeOrderT {
    static constexpr bool GATHER = G_;
    GB gb; const LAS int* tab; const int* list; unsigned rowbytes; int NT, G, c;
    __device__ __forceinline__ bool next(int i, Unit& u) const {
        const long L0 = (long)i * G + c; const int nwg = tab[0] * NT; if (L0 >= nwg) return false;
        int L = (int)L0; { const int q = nwg / NXCD, r = nwg % NXCD, xcd = L % NXCD, off = L / NXCD; L = (xcd < r ? xcd * (q + 1) : r * (q + 1) + (xcd - r) * q) + off; }
        const int mt = L / NT, pnl = L % NT;
        u.pm = mt; u.pn = tab[MT_E + mt] * NT + pnl; u.fl = 0; return true;
    }
    __device__ __forceinline__ const char* a_base(const Unit& u) const { return gb.A + (size_t)u.pm * gb.tA; }
    __device__ __forceinline__ const char* b_base(const Unit& u) const { return gb.B + (size_t)u.pn * gb.tB; }
    __device__ __forceinline__ bool zero_after(const Unit&) const { return true; }
    __device__ __forceinline__ unsigned rowoff(const Unit& u, int row) const {
        const int e = tab[MT_E + u.pm], pos = tab[MT_P0 + u.pm] + row; const int ent = pos < tab[MT_CNT + e] ? list[(size_t)e * LCAP + pos] : 0;
        return (unsigned)(ent >> 1) * rowbytes;
    }
};
typedef MoeOrderT<false> MoeOrder;
typedef MoeOrderT<true> MoeOrderG;
template <bool GATE> struct EpiBf16T {
    static constexpr bool PERM = true;
    bf16* O; int ldc; int pn_mask; const float* bgate; int pn_add; float sc;
    __device__ __forceinline__ void operator()(f32x4 (&acc)[2][2][4][2], const Unit& u, int wr, int wc, int fr, int fq) const {
        const int pnc = (u.pn & pn_mask) + pn_add; const int row0 = u.pm * BM + wr * 64 + fr; const int col0 = pnc * BM + wc * 32 + 8 * fq;
        const bool gate = GATE && (pnc >= C_G / BM);
        f32x4 bg[2][2];
        if (gate) {
#pragma unroll
            for (int bj = 0; bj < 2; ++bj) { bg[bj][0] = *(const f32x4*)(bgate + (col0 - C_G) + bj * HALF); bg[bj][1] = *(const f32x4*)(bgate + (col0 - C_G) + bj * HALF + 4); } }
#pragma unroll
        for (int ai = 0; ai < 2; ++ai)
#pragma unroll
            for (int m = 0; m < 4; ++m) { bf16* rowp = O + (size_t)(row0 + ai * HALF + m * 16) * ldc + col0;
#pragma unroll
                for (int bj = 0; bj < 2; ++bj) { f32x4 v0 = acc[ai][bj][m][0] * sc, v1 = acc[ai][bj][m][1] * sc;
                    if (gate) {
#pragma unroll
                        for (int e = 0; e < 4; ++e) { v0[e] = sigmoidf_(v0[e] + bg[bj][0][e]); v1[e] = sigmoidf_(v1[e] + bg[bj][1][e]); } }
                    v4u w; w.x = cvt_pk(v0[0], v0[1]); w.y = cvt_pk(v0[2], v0[3]); w.z = cvt_pk(v1[0], v1[1]); w.w = cvt_pk(v1[2], v1[3]);
                    *(v4u*)(rowp + bj * HALF) = w; } }
    }
};
typedef EpiBf16T<false> EpiBf16;
struct EpiProj {
    static constexpr bool PERM = true;
    bf16* O; int ldc; const float* qkg; const float* rc; const float* rs; LAS float* ssx;
    __device__ __forceinline__ void operator()(f32x4 (&acc)[2][2][4][2], const Unit& u, int wr, int wc, int fr, int fq) const {
        const int pn = u.pn; const bool qk = pn < 8 || (pn >= 20 && pn <= 24);
        const int row0 = u.pm * BM + wr * 64 + fr;
        if (!qk) { const int col0 = pn * BM + wc * 32 + 8 * fq;
#pragma unroll
            for (int ai = 0; ai < 2; ++ai)
#pragma unroll
                for (int m = 0; m < 4; ++m) { bf16* rowp = O + (size_t)(row0 + ai * HALF + m * 16) * ldc + col0;
#pragma unroll
                    for (int bj = 0; bj < 2; ++bj) { const f32x4 v0 = acc[ai][bj][m][0], v1 = acc[ai][bj][m][1];
                        v4u w; w.x = cvt_pk(v0[0], v0[1]); w.y = cvt_pk(v0[2], v0[3]); w.z = cvt_pk(v1[0], v1[1]); w.w = cvt_pk(v1[2], v1[3]);
                        *(v4u*)(rowp + bj * HALF) = w; } }
            return; }
        const float* gvec = qkg + (pn < 4 ? 0 : (pn < 8 ? 128 : (pn < 24 ? 256 : 384)));
        const int g = 4 * wc + fq, base = (g < 8 ? 0 : 64) + 4 * (g & 7);
        const f32x4 ga = *(const f32x4*)(gvec + base), gb = *(const f32x4*)(gvec + base + 32);
#pragma unroll
        for (int ai = 0; ai < 2; ++ai)
#pragma unroll
            for (int m = 0; m < 4; ++m)
#pragma unroll
                for (int bj = 0; bj < 2; ++bj) { const f32x4 x0 = acc[ai][bj][m][0], x1 = acc[ai][bj][m][1];
                    float sq = (x0[0] * x0[0] + x0[1] * x0[1]) + (x0[2] * x0[2] + x0[3] * x0[3]) + (x1[0] * x1[0] + x1[1] * x1[1]) + (x1[2] * x1[2] + x1[3] * x1[3]);
                    sq += __shfl_xor(sq, 16); sq += __shfl_xor(sq, 32);
                    if (fq == 0) ssx[((ai * HALF + wr * 64 + m * 16 + fr) * 2 + bj) * 4 + wc] = sq; }
        asm volatile("s_waitcnt lgkmcnt(0)" ::: "memory"); __builtin_amdgcn_s_barrier(); asm volatile("" ::: "memory");
        const int pj = u.pm % 9; const bool lat = pj != 0; const int t0 = (pj - 1) * 256;
#pragma unroll
        for (int ai = 0; ai < 2; ++ai)
#pragma unroll
            for (int m = 0; m < 4; ++m) { const int rowl = ai * HALF + wr * 64 + m * 16 + fr;
                f32x4 cs = {1.f, 1.f, 1.f, 1.f}, sn = {0.f, 0.f, 0.f, 0.f};
                if (lat) { const int ti = (t0 + rowl) * 64 + (g < 8 ? 0 : 32) + 4 * (g & 7); cs = *(const f32x4*)(rc + ti); sn = *(const f32x4*)(rs + ti); }
                bf16* rowp = O + (size_t)(u.pm * BM + rowl) * ldc + pn * BM + 8 * g;
#pragma unroll
                for (int bj = 0; bj < 2; ++bj) { const f32x4 pp = *(const LAS f32x4*)(ssx + (rowl * 2 + bj) * 4);
                    const float rn = rsqrtf(((pp[0] + pp[1]) + (pp[2] + pp[3])) * (1.0f / 128.0f) + EPS);
                    const f32x4 y0 = acc[ai][bj][m][0] * rn * ga, y1 = acc[ai][bj][m][1] * rn * gb;
                    const f32x4 o0 = y0 * cs - y1 * sn, o1 = y1 * cs + y0 * sn;
                    v4u w; w.x = cvt_pk(o0[0], o0[1]); w.y = cvt_pk(o0[2], o0[3]); w.z = cvt_pk(o1[0], o1[1]); w.w = cvt_pk(o1[2], o1[3]);
                    *(v4u*)(rowp + bj * HALF) = w; } }
    }
};
struct EpiChain {
    static constexpr bool PERM = true;
    bf16* Mb; const bf16* proj;
    __device__ __forceinline__ void operator()(f32x4 (&acc)[2][2][4][2], const Unit& u, int wr, int wc, int fr, int fq) const {
        const int row0 = u.pm * BM + wr * 64 + fr, col0 = u.pn * BM + wc * 32 + 8 * fq; const int br = u.fl;
        const bf16* gp = proj + C_G + br * D + col0;
        v4u ga[2][2], gb[2][2];
#define EC_LOAD(buf, g_) do { const size_t row_ = (size_t)(row0 + ((g_) >> 2) * HALF + ((g_) & 3) * 16); _Pragma("unroll") for (int bj = 0; bj < 2; ++bj) { \
            ga[buf][bj] = *(const v4u*)(gp + row_ * INC + bj * HALF); if (br < 2) gb[buf][bj] = *(const v4u*)(gp + row_ * INC + D + bj * HALF); } } while (0)
        EC_LOAD(0, 0);
#pragma unroll
        for (int g8 = 0; g8 < 8; ++g8) { const int ai = g8 >> 2, m = g8 & 3, cb = g8 & 1; const size_t row = (size_t)(row0 + ai * HALF + m * 16);
            if (g8 < 7) EC_LOAD(cb ^ 1, g8 + 1);
            asm volatile("" ::: "memory");
#pragma unroll
            for (int bj = 0; bj < 2; ++bj) { const v4u a = ga[cb][bj];
                f32x4 g0 = {bflo(a.x), bfhi(a.x), bflo(a.y), bfhi(a.y)}, g1 = {bflo(a.z), bfhi(a.z), bflo(a.w), bfhi(a.w)};
                if (br < 2) { const v4u b = gb[cb][bj];
                    g0[0] *= __builtin_amdgcn_rcpf(bflo(b.x)); g0[1] *= __builtin_amdgcn_rcpf(bfhi(b.x)); g0[2] *= __builtin_amdgcn_rcpf(bflo(b.y)); g0[3] *= __builtin_amdgcn_rcpf(bfhi(b.y));
                    g1[0] *= __builtin_amdgcn_rcpf(bflo(b.z)); g1[1] *= __builtin_amdgcn_rcpf(bfhi(b.z)); g1[2] *= __builtin_amdgcn_rcpf(bflo(b.w)); g1[3] *= __builtin_amdgcn_rcpf(bfhi(b.w));
                    acc[ai][bj][m][0] *= g0; acc[ai][bj][m][1] *= g1; }
                else { const f32x4 v0 = acc[ai][bj][m][0] * g0, v1 = acc[ai][bj][m][1] * g1; v4u w; w.x = cvt_pk(v0[0], v0[1]); w.y = cvt_pk(v0[2], v0[3]); w.z = cvt_pk(v1[0], v1[1]); w.w = cvt_pk(v1[2], v1[3]);
                    *(v4u*)(Mb + row * D + col0 + bj * HALF) = w; } }
        }
#undef EC_LOAD
    }
};
template <bool BB> struct EpiWout {
    static constexpr bool PERM = true;
    const void* base_lat; const void* base_ctx; bf16* out_lat; bf16* out_ctx; const float* modl;
    __device__ __forceinline__ void operator()(f32x4 (&acc)[2][2][4][2], const Unit& u, int wr, int wc, int fr, int fq) const {
        const int b = u.pm / 9, j = u.pm % 9; const bool ctx = (j == 0);
        const size_t r0 = ctx ? (size_t)b * CTXL : (size_t)b * SEQ + (size_t)(j - 1) * 256;
        const char* bp = (const char*)(ctx ? base_ctx : base_lat) + r0 * D * (BB ? 2 : 4); bf16* op = (ctx ? out_ctx : out_lat) + r0 * D;
        const float* mg = modl + (size_t)(ctx ? 8 : b) * (NMOD * D) + 2 * D;
        const int rl0 = wr * 64 + fr, col0 = u.pn * BM + wc * 32 + 8 * fq;
        f32x4 gq[2][2], bs[2][2][2]; v4u bb[2][2];
#pragma unroll
        for (int bj = 0; bj < 2; ++bj)
#pragma unroll
            for (int hf = 0; hf < 2; ++hf) gq[bj][hf] = *(const f32x4*)(mg + col0 + bj * HALF + 4 * hf);
#define EW_LOAD(buf, g_) do { const size_t ro_ = (size_t)(rl0 + ((g_) >> 2) * HALF + ((g_) & 3) * 16) * D + col0; _Pragma("unroll") for (int bj = 0; bj < 2; ++bj) { \
            if constexpr (BB) bb[buf][bj] = *(const v4u*)(bp + (ro_ + bj * HALF) * 2); \
            else { bs[buf][bj][0] = *(const f32x4*)(bp + (ro_ + bj * HALF) * 4); bs[buf][bj][1] = *(const f32x4*)(bp + (ro_ + bj * HALF) * 4 + 16); } } } while (0)
        EW_LOAD(0, 0);
#pragma unroll
        for (int g8 = 0; g8 < 8; ++g8) { const int ai = g8 >> 2, m = g8 & 3, cb = g8 & 1; const size_t ro = (size_t)(rl0 + ai * HALF + m * 16) * D + col0;
            if (g8 < 7) EW_LOAD(cb ^ 1, g8 + 1);
            asm volatile("" ::: "memory");
#pragma unroll
            for (int bj = 0; bj < 2; ++bj) { f32x4 b0, b1;
                if constexpr (BB) { const v4u x = bb[cb][bj]; b0 = (f32x4){bflo(x.x), bfhi(x.x), bflo(x.y), bfhi(x.y)}; b1 = (f32x4){bflo(x.z), bfhi(x.z), bflo(x.w), bfhi(x.w)}; }
                else { b0 = bs[cb][bj][0]; b1 = bs[cb][bj][1]; }
                const f32x4 y0 = b0 + gq[bj][0] * acc[ai][bj][m][0], y1 = b1 + gq[bj][1] * acc[ai][bj][m][1];
                v4u w; w.x = cvt_pk(y0[0], y0[1]); w.y = cvt_pk(y0[2], y0[3]); w.z = cvt_pk(y1[0], y1[1]); w.w = cvt_pk(y1[2], y1[3]); *(v4u*)(op + ro + bj * HALF) = w; }
        }
#undef EW_LOAD
    }
};
struct EpiUp {
    static constexpr bool PERM = true;
    bf16* HB; float sc;
    __device__ __forceinline__ void operator()(f32x4 (&acc)[2][2][4][2], const Unit& u, int wr, int wc, int fr, int fq) const {
        const int row0 = u.pm * BM + wr * 64 + fr; const int col0 = (u.pn & 3) * HALF + wc * 32 + 8 * fq;
#pragma unroll
        for (int ai = 0; ai < 2; ++ai)
#pragma unroll
            for (int m = 0; m < 4; ++m) { bf16* rowp = HB + (size_t)(row0 + ai * HALF + m * 16) * DE + col0;
                f32x4 h0, h1;
#pragma unroll
                for (int e = 0; e < 4; ++e) { const float a0 = acc[ai][0][m][0][e] * sc, a1 = acc[ai][0][m][1][e] * sc;
                    h0[e] = a0 * sigmoidf_(a0) * (acc[ai][1][m][0][e] * sc); h1[e] = a1 * sigmoidf_(a1) * (acc[ai][1][m][1][e] * sc); }
                v4u w; w.x = cvt_pk(h0[0], h0[1]); w.y = cvt_pk(h0[2], h0[3]); w.z = cvt_pk(h1[0], h1[1]); w.w = cvt_pk(h1[2], h1[3]);
                *(v4u*)rowp = w; }
    }
};

template <class Epi, class Sched, int ES = 2>
__device__ __forceinline__ void gemm_phase(LAS unsigned char* lds, const int lda, const int ldb, const int K, const Sched& S, const Epi& E) {
    constexpr bool ALIGN_EPI = true;
    int tid_ = threadIdx.x; asm volatile("" : "+v"(tid_));
    const int tid = tid_, wid = __builtin_amdgcn_readfirstlane(tid >> 6), lane = tid & 63, wr = wid >> 2, wc = wid & 3, fr = lane & 15, fq = lane >> 4;
    const int nt = K * ES / (BK * 2);
    constexpr bool GATH = Sched::GATHER;
    unsigned voffA[2], voffB[2]; int gR[2]; unsigned gC[2];
    unsigned vc[2][2], vn[2][2];
#pragma unroll
    for (int i = 0; i < 2; ++i) { int R, C; stage_rc(tid * 16 + i * 8192, R, C); const int Rb = Epi::PERM ? ((R & ~31) + perm32(R & 31)) : R;
        voffA[i] = (unsigned)(R * lda * ES + C * 2); voffB[i] = (unsigned)(Rb * ldb * ES + C * 2); gR[i] = R; gC[i] = (unsigned)C * 2u; }
    const size_t kstep = (size_t)(BK * 2);
    const size_t hstepA = (size_t)HALF * lda * ES, hstepB = (size_t)HALF * ldb * ES;
    const unsigned ldsw = (unsigned)wid * 1024u;
    const int aoff = lds_byte(wr * 64 + fr, fq * 8), boff = lds_byte(wc * 32 + fr, fq * 8);
#define PG8_SA(b, h) (((b) * 2 + (h)) * HTB)
#define PG8_SB(b, h) ((4 + (b) * 2 + (h)) * HTB)
#define PG8_STAGE(bufoff, gbase, voff) do { _Pragma("unroll") for (int _i = 0; _i < 2; ++_i) \
        __builtin_amdgcn_global_load_lds((const unsigned*)((const char*)(gbase) + (voff)[_i]), (LAS unsigned*)(lds + (bufoff) + ldsw + _i * 8192), 16, 0, 0); } while (0)
#define PG8_STAGE_A(bufoff, ptr, h, kb) do { if constexpr (GATH) { _Pragma("unroll") for (int _i = 0; _i < 2; ++_i) \
        __builtin_amdgcn_global_load_lds((const unsigned*)(S.gb.A + (size_t)(kb) + vc[h][_i]), (LAS unsigned*)(lds + (bufoff) + ldsw + _i * 8192), 16, 0, 0); } else PG8_STAGE(bufoff, ptr, voffA); } while (0)
#define PG8_ROWOFFS(dst, u) do { _Pragma("unroll") for (int _h = 0; _h < 2; ++_h) _Pragma("unroll") for (int _i = 0; _i < 2; ++_i) dst[_h][_i] = S.rowoff(u, _h * HALF + gR[_i]) + gC[_i]; } while (0)
#define PG8_LD16(off) (*(const LAS v4i_*)(lds + (off)))
#define PG8_LDA(dst, b, h) do { _Pragma("unroll") for (int m = 0; m < 4; ++m) { if constexpr (ES == 2) { _Pragma("unroll") for (int k = 0; k < 2; ++k) dst[m][k] = *(const LAS bf16x8*)(lds + PG8_SA(b, h) + aoff + m * 2048 + k * 1024); } \
        else dst##8[m] = __builtin_shufflevector(PG8_LD16(PG8_SA(b, h) + aoff + m * 2048), PG8_LD16(PG8_SA(b, h) + aoff + m * 2048 + 1024), 0, 1, 2, 3, 4, 5, 6, 7); } } while (0)
#define PG8_LDB(dst, b, h) do { _Pragma("unroll") for (int n = 0; n < 2; ++n) { if constexpr (ES == 2) { _Pragma("unroll") for (int k = 0; k < 2; ++k) dst[n][k] = *(const LAS bf16x8*)(lds + PG8_SB(b, h) + boff + n * 2048 + k * 1024); } \
        else dst##8[n] = __builtin_shufflevector(PG8_LD16(PG8_SB(b, h) + boff + n * 2048), PG8_LD16(PG8_SB(b, h) + boff + n * 2048 + 1024), 0, 1, 2, 3, 4, 5, 6, 7); } } while (0)
#define PG8_MMA(ai, bj, At, Bt) do { __builtin_amdgcn_s_setprio(1); if constexpr (ES == 2) { _Pragma("unroll") for (int m = 0; m < 4; ++m) _Pragma("unroll") for (int n = 0; n < 2; ++n) _Pragma("unroll") for (int k = 0; k < 2; ++k) \
        acc[ai][bj][m][n] = __builtin_amdgcn_mfma_f32_16x16x32_bf16(Bt[n][k], At[m][k], acc[ai][bj][m][n], 0, 0, 0); } else { _Pragma("unroll") for (int m = 0; m < 4; ++m) _Pragma("unroll") for (int n = 0; n < 2; ++n) \
        asm("v_mfma_scale_f32_16x16x128_f8f6f4 %0, %1, %2, %0, %3, %3 op_sel_hi:[0,0,0]" : "+v"(acc[ai][bj][m][n]) : "v"(Bt##8[n]), "v"(At##8[m]), "v"(sc8_)); } \
        __builtin_amdgcn_s_setprio(0); } while (0)
#define PG8_WAIT_V(n) asm volatile("s_waitcnt vmcnt(" #n ")" ::: "memory")
#define PG8_WAIT_L(n) asm volatile("s_waitcnt lgkmcnt(" #n ")" ::: "memory")
#define PG8_BAR __builtin_amdgcn_s_barrier()
#define PG8_SCHED __builtin_amdgcn_sched_barrier(0)
    Unit cur, nxt; int ui = 0;
    if (!S.next(0, cur)) return;
    f32x4 acc[2][2][4][2];
#pragma unroll
    for (int a = 0; a < 2; ++a)
#pragma unroll
        for (int b = 0; b < 2; ++b)
#pragma unroll
            for (int m = 0; m < 4; ++m)
#pragma unroll
                for (int n = 0; n < 2; ++n) acc[a][b][m][n] = (f32x4){0.f, 0.f, 0.f, 0.f};
    int sc8_ = 0x7F7F7F7F; asm volatile("" : "+v"(sc8_));
    bf16x8 At[4][2], B0[2][2], B1[2][2]; v8i_ At8[4], B08[2], B18[2];
    const char* cA = S.a_base(cur); const char* cB = S.b_base(cur);
    if constexpr (GATH) { PG8_ROWOFFS(vc, cur); }
    PG8_STAGE(PG8_SB(0, 0), cB, voffB); PG8_STAGE(PG8_SB(0, 1), cB + hstepB, voffB); PG8_STAGE_A(PG8_SA(0, 0), cA, 0, 0); PG8_STAGE_A(PG8_SA(0, 1), cA + hstepA, 1, 0);
    if (wr == 1) PG8_BAR;
    PG8_WAIT_V(2); PG8_BAR;
    PG8_STAGE(PG8_SB(1, 0), cB + kstep, voffB); PG8_STAGE_A(PG8_SA(1, 0), cA + kstep, 0, kstep); PG8_STAGE(PG8_SB(1, 1), cB + hstepB + kstep, voffB);
    PG8_WAIT_V(6); PG8_BAR;
    for (;;) {
        const bool has_next = S.next(ui + 1, nxt);
        const char* nA = has_next ? S.a_base(nxt) : cA; const char* nB = has_next ? S.b_base(nxt) : cB;
        if constexpr (GATH) { if (has_next) { PG8_ROWOFFS(vn, nxt); } else {
#pragma unroll
            for (int _h = 0; _h < 2; ++_h) { vn[_h][0] = vc[_h][0]; vn[_h][1] = vc[_h][1]; } } }
        for (int t = 0; t < nt; t += 2) {
            const bool last = (t == nt - 2);
            const char* a1 = cA + (size_t)(t + 1) * kstep;
            const char* a2 = last ? nA : cA + (size_t)(t + 2) * kstep; const char* b2 = last ? nB : cB + (size_t)(t + 2) * kstep;
            const char* a3 = a2 + kstep; const char* b3 = b2 + kstep;
            const size_t k1 = (size_t)(t + 1) * kstep, k2 = last ? 0 : (size_t)(t + 2) * kstep, k3 = k2 + kstep;
            PG8_LDB(B0, 0, 0); PG8_LDB(B1, 0, 1); PG8_SCHED; PG8_LDA(At, 0, 0); PG8_STAGE_A(PG8_SA(1, 1), a1 + hstepA, 1, k1);
            if constexpr (GATH) { if (last) {
#pragma unroll
                for (int _h = 0; _h < 2; ++_h) { vc[_h][0] = vn[_h][0]; vc[_h][1] = vn[_h][1]; } } }
            PG8_WAIT_V(8); PG8_WAIT_L(0); PG8_BAR; PG8_MMA(0, 0, At, B0); PG8_MMA(0, 1, At, B1); PG8_BAR; PG8_SCHED;
            PG8_LDA(At, 0, 1); PG8_STAGE(PG8_SB(0, 0), b2, voffB); PG8_STAGE(PG8_SB(0, 1), b2 + hstepB, voffB); PG8_STAGE_A(PG8_SA(0, 0), a2, 0, k2);
            PG8_WAIT_V(8); PG8_WAIT_L(0); PG8_BAR; PG8_MMA(1, 0, At, B0); PG8_MMA(1, 1, At, B1); PG8_BAR; PG8_SCHED;
            PG8_LDB(B0, 1, 0); PG8_LDB(B1, 1, 1); PG8_SCHED; PG8_LDA(At, 1, 0); PG8_STAGE_A(PG8_SA(0, 1), a2 + hstepA, 1, k2);
            PG8_WAIT_V(8); PG8_WAIT_L(0); PG8_BAR; PG8_MMA(0, 0, At, B0); PG8_MMA(0, 1, At, B1); PG8_BAR; PG8_SCHED;
            PG8_LDA(At, 1, 1); PG8_STAGE(PG8_SB(1, 0), b3, voffB); PG8_STAGE(PG8_SB(1, 1), b3 + hstepB, voffB); PG8_STAGE_A(PG8_SA(1, 0), a3, 0, k3);
            PG8_WAIT_V(8); PG8_WAIT_L(0); PG8_BAR; PG8_MMA(1, 0, At, B0); PG8_MMA(1, 1, At, B1); PG8_BAR; PG8_SCHED;
        }
        if constexpr (ALIGN_EPI) { if (wr == 0) PG8_BAR; }
        if constexpr (ES == 1) {
#define PG8_TIE8(pre, a_, b_) asm volatile(pre : "+v"(acc[a_][b_][0][0]), "+v"(acc[a_][b_][0][1]), "+v"(acc[a_][b_][1][0]), "+v"(acc[a_][b_][1][1]), "+v"(acc[a_][b_][2][0]), "+v"(acc[a_][b_][2][1]), "+v"(acc[a_][b_][3][0]), "+v"(acc[a_][b_][3][1]))
            PG8_TIE8("s_nop 7\n\ts_nop 7\n\ts_nop 7\n\ts_nop 7", 0, 0); PG8_TIE8("", 0, 1); PG8_TIE8("", 1, 0); PG8_TIE8("", 1, 1);
#undef PG8_TIE8
        }
        { int fr2 = fr, fq2 = fq; asm volatile("" : "+v"(fr2), "+v"(fq2)); E(acc, cur, wr, wc, fr2, fq2); }
        if (!has_next) break;
        if (S.zero_after(cur)) {
#pragma unroll
        for (int a = 0; a < 2; ++a)
#pragma unroll
            for (int b = 0; b < 2; ++b)
#pragma unroll
                for (int m = 0; m < 4; ++m)
#pragma unroll
                    for (int n = 0; n < 2; ++n) acc[a][b][m][n] = (f32x4){0.f, 0.f, 0.f, 0.f}; }
        cur = nxt; cA = nA; cB = nB; ++ui;
        if constexpr (ALIGN_EPI) { if (wr == 1) PG8_BAR; }
    }
    PG8_WAIT_V(0);
    if constexpr (!ALIGN_EPI) { if (wr == 0) PG8_BAR; }
    PG8_BAR;
#undef PG8_SA
#undef PG8_SB
#undef PG8_STAGE
#undef PG8_LDA
#undef PG8_LD16
#undef PG8_STAGE_A
#undef PG8_ROWOFFS
#undef PG8_LDB
#undef PG8_MMA
#undef PG8_WAIT_V
#undef PG8_WAIT_L
#undef PG8_BAR
#undef PG8_SCHED
}
}

namespace att {
constexpr int AD = 128, NW = 8, QBLK = 32, KVBLK = 64;
constexpr float SCALE = 0.088388347648318440f;
constexpr float THR = 8.f;
constexpr int LDQ = INC, LDK = INC;
constexpr size_t SHM_V = KVBLK * AD * 2, SHM_K = KVBLK * AD * 2, SHM_ATTN = 2 * SHM_V + 2 * SHM_K + NW * 64 * 4;
using s16x4 = __attribute__((ext_vector_type(4))) short;
using f32x16 = __attribute__((ext_vector_type(16))) float;
#define KSWZ(row, colB) ((row) * 256 + ((colB) ^ (((row) & 7) << 4)))
#define SBAR() __builtin_amdgcn_sched_barrier(0)
__device__ __forceinline__ int crow(int r, int hi) { return (r & 3) + 8 * (r >> 2) + 4 * hi; }
__device__ __forceinline__ void partialSM(f32x16& p0, f32x16& p1, float& m_reg, float& mn, float& alpha) {
  constexpr float C = SCALE * 1.4426950408889634f;
  float pmax = p0[0]; for (int r = 1; r < 16; ++r) pmax = fmaxf(pmax, p0[r]); for (int r = 0; r < 16; ++r) pmax = fmaxf(pmax, p1[r]);
  { auto rr = __builtin_amdgcn_permlane32_swap(__float_as_uint(pmax), __float_as_uint(pmax), false, false);
    pmax = fmaxf(__uint_as_float(rr[0]), __uint_as_float(rr[1])); }
  if (__builtin_expect(__all(pmax - m_reg <= THR / SCALE), 1)) { mn = m_reg; alpha = 1.f; }
  else { mn = fmaxf(m_reg, pmax); alpha = __builtin_amdgcn_exp2f((m_reg - mn) * C); m_reg = mn; }
  float mnC = -mn * C;
  for (int r = 0; r < 16; ++r) p0[r] = fmaf(p0[r], C, mnC); for (int r = 0; r < 16; ++r) p1[r] = fmaf(p1[r], C, mnC);
  for (int r = 0; r < 16; ++r) p0[r] = __builtin_amdgcn_exp2f(p0[r]);
}
__device__ __forceinline__ void finishSM(f32x16& p0, f32x16& p1, float alpha, float& l_reg, bf16x8& pa0, bf16x8& pa1, bf16x8& pa2, bf16x8& pa3) {
  for (int r = 0; r < 16; ++r) p1[r] = __builtin_amdgcn_exp2f(p1[r]);
  float ps = 0; for (int r = 0; r < 16; ++r) ps += p0[r]; for (int r = 0; r < 16; ++r) ps += p1[r];
  { auto rr = __builtin_amdgcn_permlane32_swap(__float_as_uint(ps), __float_as_uint(ps), false, false);
    ps = __uint_as_float(rr[0]) + __uint_as_float(rr[1]); }
  l_reg = l_reg * alpha + ps;
#define PK4(P, BASE, OUT) do { unsigned a0 = cvt_pk(P[BASE + 0], P[BASE + 1]), a1 = cvt_pk(P[BASE + 2], P[BASE + 3]);   \
    unsigned b0 = cvt_pk(P[BASE + 4], P[BASE + 5]), b1 = cvt_pk(P[BASE + 6], P[BASE + 7]);                              \
    auto r0 = __builtin_amdgcn_permlane32_swap(a0, b0, false, false); auto r1 = __builtin_amdgcn_permlane32_swap(a1, b1, false, false); \
    v4u w = {r0[0], r1[0], r0[1], r1[1]}; OUT = *reinterpret_cast<bf16x8*>(&w); } while (0)
  PK4(p0, 0, pa0); PK4(p0, 8, pa1); PK4(p1, 0, pa2); PK4(p1, 8, pa3);
#undef PK4
}
__device__ __forceinline__ void qkt(f32x16& p0, f32x16& p1, const bf16* Ks, const bf16x8* qr, int r32, int hi) {
  p0 = f32x16{}; p1 = f32x16{};
  for (int d0 = 0; d0 < 8; ++d0) { int cb = (d0 * 16 + hi * 8) * 2;
    bf16x8 b0 = *reinterpret_cast<const bf16x8*>((const char*)Ks + KSWZ(r32, cb));
    bf16x8 b1 = *reinterpret_cast<const bf16x8*>((const char*)Ks + KSWZ(32 + r32, cb));
    p0 = __builtin_amdgcn_mfma_f32_32x32x16_bf16(b0, qr[d0], p0, 0, 0, 0);
    p1 = __builtin_amdgcn_mfma_f32_32x32x16_bf16(b1, qr[d0], p1, 0, 0, 0); }
}
__device__ __forceinline__ int v_st(int k, int c) { const int kk = (k & ~0xC) | ((k & 4) << 1) | ((k & 8) >> 1); return ((kk >> 3) * 4 + (c >> 5)) * 512 + ((kk & 7) * 32 + (c & 31)) * 2; }
__device__ __forceinline__ int v_rd_base(int lane) { return ((lane & 3) << 3) | (((lane >> 2) & 3) << 6) | (((lane >> 4) & 1) << 5) | (((lane >> 5) & 1) << 8); }
constexpr int v_rd_off(int d0, int ks, int half) { return d0 * 512 + ks * 4096 + half * 2048; }
template <int OFF> __device__ __forceinline__ s16x4 tr_read(int vb) {
  s16x4 r; asm volatile("ds_read_b64_tr_b16 %0, %1 offset:%2" : "=&v"(r) : "v"(vb), "i"(OFF) : "memory"); return r;
}
template <int D0> __device__ __forceinline__ void pv_one(f32x16& od, int vb, bf16x8 pa0, bf16x8 pa1, bf16x8 pa2, bf16x8 pa3) {
  const s16x4 l0 = tr_read<v_rd_off(D0, 0, 0)>(vb), h0 = tr_read<v_rd_off(D0, 0, 1)>(vb), l1 = tr_read<v_rd_off(D0, 1, 0)>(vb), h1 = tr_read<v_rd_off(D0, 1, 1)>(vb);
  const s16x4 l2 = tr_read<v_rd_off(D0, 2, 0)>(vb), h2 = tr_read<v_rd_off(D0, 2, 1)>(vb), l3 = tr_read<v_rd_off(D0, 3, 0)>(vb), h3 = tr_read<v_rd_off(D0, 3, 1)>(vb);
  asm volatile("s_waitcnt lgkmcnt(0)" ::: "memory"); SBAR();
#define PK(L, H) (bf16x8){L[0], L[1], L[2], L[3], H[0], H[1], H[2], H[3]}
  od = __builtin_amdgcn_mfma_f32_32x32x16_bf16(pa0, PK(l0, h0), od, 0, 0, 0);
  od = __builtin_amdgcn_mfma_f32_32x32x16_bf16(pa1, PK(l1, h1), od, 0, 0, 0);
  od = __builtin_amdgcn_mfma_f32_32x32x16_bf16(pa2, PK(l2, h2), od, 0, 0, 0);
  od = __builtin_amdgcn_mfma_f32_32x32x16_bf16(pa3, PK(l3, h3), od, 0, 0, 0);
#undef PK
}
__device__ __forceinline__ void pv_d0(f32x16* o, int vb, bf16x8 pa0, bf16x8 pa1, bf16x8 pa2, bf16x8 pa3) {
  pv_one<0>(o[0], vb, pa0, pa1, pa2, pa3); pv_one<1>(o[1], vb, pa0, pa1, pa2, pa3); pv_one<2>(o[2], vb, pa0, pa1, pa2, pa3); pv_one<3>(o[3], vb, pa0, pa1, pa2, pa3);
}
__device__ __forceinline__ void attn_dense_body(const bf16* __restrict__ Qb, const bf16* __restrict__ Kh, const bf16* __restrict__ Vh,
                                                bf16* __restrict__ Ob, int ldo, int seq, char* lds) {
  constexpr int SDEPTH = 2;
  int tid_ = threadIdx.x; asm volatile("" : "+v"(tid_));
  const int tid = tid_, wid = tid >> 6, lane = tid & 63, r32 = lane & 31, hi = lane >> 5;
  bf16* V_lds = (bf16*)lds; bf16* K_lds = (bf16*)(lds + 2 * SHM_V);
  float* ws = (float*)(lds + 2 * SHM_V + 2 * SHM_K) + wid * 64; float* li_l = ws; float* al_l = ws + 32;
  float m_reg = -1e30f, l_reg = 0; f32x16 o[4] = {}; bf16x8 qr[8];
  const bf16* Qw = Qb + (long)(wid * QBLK + r32) * LDQ + hi * 8;
#pragma unroll
  for (int d0 = 0; d0 < 8; ++d0) qr[d0] = *reinterpret_cast<const bf16x8*>(Qw + d0 * 16);
  const int sr = tid >> 4, sc = (tid & 15) * 8, vst0 = v_st(sr, sc), vst1 = v_st(32 + sr, sc);
  const int vb0 = (int)(uintptr_t)V_lds + v_rd_base(lane);
  struct { bf16x8 vs0, vs1, ks0, ks1; } sr_[SDEPTH];
#define SLOAD(i, k0) do { sr_[i].vs0 = *(const bf16x8*)(&Vh[(long)((k0) + sr) * LDK + sc]); sr_[i].vs1 = *(const bf16x8*)(&Vh[(long)((k0) + 32 + sr) * LDK + sc]); \
    sr_[i].ks0 = *(const bf16x8*)(&Kh[(long)((k0) + sr) * LDK + sc]); sr_[i].ks1 = *(const bf16x8*)(&Kh[(long)((k0) + 32 + sr) * LDK + sc]); } while (0)
#define SWRITE(b, i) do { *(bf16x8*)((char*)V_lds + (b) * SHM_V + vst0) = sr_[i].vs0;          \
    *(bf16x8*)((char*)V_lds + (b) * SHM_V + vst1) = sr_[i].vs1; int kc = sc * 2;               \
    *(bf16x8*)((char*)K_lds + (b) * SHM_K + KSWZ(sr, kc)) = sr_[i].ks0;                       \
    *(bf16x8*)((char*)K_lds + (b) * SHM_K + KSWZ(32 + sr, kc)) = sr_[i].ks1; } while (0)
#define SWAIT() asm volatile("s_waitcnt vmcnt(4)" ::: "memory")
#define RESC(a) do { if (__any((a) < 1.f)) { if (hi == 0) al_l[r32] = (a); asm volatile("s_waitcnt lgkmcnt(0)" ::: "memory"); \
    for (int d = 0; d < 4; ++d) for (int r = 0; r < 16; ++r) o[d][r] *= al_l[crow(r, hi)]; } } while (0)
  f32x16 pA0, pA1, pB0, pB1; float mnA, mnB, alA, alB; bf16x8 pa0, pa1, pa2, pa3; const int NT = seq / KVBLK;
  constexpr int SE = 0, SO = SDEPTH - 1;
  SLOAD(SE, 0); asm volatile("s_waitcnt vmcnt(0)" ::: "memory"); SWRITE(0, SE); __syncthreads();
  qkt(pA0, pA1, K_lds, qr, r32, hi); partialSM(pA0, pA1, m_reg, mnA, alA);
  SLOAD(SO, KVBLK); if (2 < NT) SLOAD(SE, 2 * KVBLK);
  SWAIT(); SWRITE(1, SO); __syncthreads();
  for (int j = 1; j + 1 < NT; j += 2) {
    SBAR(); qkt(pB0, pB1, (bf16*)((char*)K_lds + SHM_K), qr, r32, hi);
    finishSM(pA0, pA1, alA, l_reg, pa0, pa1, pa2, pa3); SBAR();
    SLOAD(SO, (j + SDEPTH) * KVBLK); SBAR();
    pv_d0(o, vb0, pa0, pa1, pa2, pa3); partialSM(pB0, pB1, m_reg, mnB, alB);
    __syncthreads(); SWAIT(); SWRITE(0, SE);
    RESC(alB); __syncthreads();
    SBAR(); qkt(pA0, pA1, K_lds, qr, r32, hi);
    finishSM(pB0, pB1, alB, l_reg, pa0, pa1, pa2, pa3); SBAR();
    if (j + 3 < NT) SLOAD(SE, (j + 1 + SDEPTH) * KVBLK); SBAR();
    pv_d0(o, vb0 + (int)SHM_V, pa0, pa1, pa2, pa3); partialSM(pA0, pA1, m_reg, mnA, alA);
    __syncthreads(); SWAIT(); SWRITE(1, SO);
    RESC(alA); __syncthreads();
  }
  SBAR(); qkt(pB0, pB1, (bf16*)((char*)K_lds + SHM_K), qr, r32, hi);
  finishSM(pA0, pA1, alA, l_reg, pa0, pa1, pa2, pa3); SBAR();
  pv_d0(o, vb0, pa0, pa1, pa2, pa3); partialSM(pB0, pB1, m_reg, mnB, alB);
  __syncthreads(); RESC(alB);
  finishSM(pB0, pB1, alB, l_reg, pa0, pa1, pa2, pa3); SBAR();
  pv_d0(o, vb0 + (int)SHM_V, pa0, pa1, pa2, pa3);
  if (hi == 0) li_l[r32] = l_reg; asm volatile("s_waitcnt lgkmcnt(0)" ::: "memory");
  float rli[16];
#pragma unroll
  for (int r = 0; r < 16; ++r) rli[r] = __builtin_amdgcn_rcpf(li_l[crow(r, hi)]);
  bf16* Ow = Ob + (long)(wid * QBLK) * ldo;
#pragma unroll
  for (int r = 0; r < 16; ++r) { int orow = crow(r, hi);
    for (int d0 = 0; d0 < 4; ++d0) Ow[(long)orow * ldo + d0 * 32 + r32] = (bf16)(cvt_pk(o[d0][r] * rli[r], 0.f) & 0xffffu); }
#undef SLOAD
#undef SWRITE
#undef SWAIT
#undef RESC
}
constexpr int DV_VB = 2 * (int)SHM_V, DV_KOFF = 3 * DV_VB, DV_WSOFF = DV_KOFF + 2 * (int)SHM_K;
#define TRL(D0, KS, HF) tr_read<((D0) >> 2) * (int)SHM_V + v_rd_off((D0) & 3, KS, HF)>(vb)
#define TRLV(D0, KS, HF, VB) tr_read<((D0) >> 2) * (int)SHM_V + v_rd_off((D0) & 3, KS, HF)>(VB)
#define DV_RDV(s_, D0, KS0, VB) do { s_##0 = TRLV(D0, KS0, 0, VB); s_##1 = TRLV(D0, KS0, 1, VB); s_##2 = TRLV(D0, (KS0) + 1, 0, VB); s_##3 = TRLV(D0, (KS0) + 1, 1, VB); } while (0)
#define DV_RD(s_, D0, KS0) do { s_##0 = TRL(D0, KS0, 0); s_##1 = TRL(D0, KS0, 1); s_##2 = TRL(D0, (KS0) + 1, 0); s_##3 = TRL(D0, (KS0) + 1, 1); } while (0)
#define DV_PK(L, H) (bf16x8){L[0], L[1], L[2], L[3], H[0], H[1], H[2], H[3]}
#define DV_MM(s_, D0, P0, P1) do { o[D0] = __builtin_amdgcn_mfma_f32_32x32x16_bf16(P0, DV_PK(s_##0, s_##1), o[D0], 0, 0, 0); o[D0] = __builtin_amdgcn_mfma_f32_32x32x16_bf16(P1, DV_PK(s_##2, s_##3), o[D0], 0, 0, 0); } while (0)
#define DV_W(n) do { asm volatile("s_waitcnt lgkmcnt(" #n ")" ::: "memory"); SBAR(); } while (0)
#define DV_KRD(s_, d0) do { const int a_ = kb ^ ((d0) << 5); asm volatile("ds_read_b128 %0, %2\n\tds_read_b128 %1, %2 offset:8192" : "=&v"(s_##0), "=&v"(s_##1) : "v"(a_) : "memory"); } while (0)
#define DV_QM(s_, d0) do { p0 = __builtin_amdgcn_mfma_f32_32x32x16_bf16(s_##0, qr[d0], p0, 0, 0, 0); p1 = __builtin_amdgcn_mfma_f32_32x32x16_bf16(s_##1, qr[d0], p1, 0, 0, 0); \
    asm volatile("" : "+v"(p0), "+v"(p1)); } while (0)
#define DV_EX(P, i) do { P[2 * (i)] = __builtin_amdgcn_exp2f(P[2 * (i)]); P[2 * (i) + 1] = __builtin_amdgcn_exp2f(P[2 * (i) + 1]); } while (0)
#define DV_EXS(P, i) do { DV_EX(P, i); ps += P[2 * (i)] + P[2 * (i) + 1]; } while (0)
#define DV_PK4(P, BASE, OUT) do { unsigned a0_ = cvt_pk(P[BASE + 0], P[BASE + 1]), a1_ = cvt_pk(P[BASE + 2], P[BASE + 3]);   \
    unsigned b0_ = cvt_pk(P[BASE + 4], P[BASE + 5]), b1_ = cvt_pk(P[BASE + 6], P[BASE + 7]);                              \
    auto r0_ = __builtin_amdgcn_permlane32_swap(a0_, b0_, false, false); auto r1_ = __builtin_amdgcn_permlane32_swap(a1_, b1_, false, false); \
    v4u w_ = {r0_[0], r1_[0], r0_[1], r1_[1]}; OUT = *reinterpret_cast<bf16x8*>(&w_); } while (0)
template <int NDT>
__device__ __forceinline__ void attn_dv256_body(const bf16* __restrict__ Qb, const bf16* __restrict__ Kh, const bf16* __restrict__ Vh,
                                                bf16* __restrict__ Ob, int ldo, int seq, char* lds, LAS unsigned char* ldsl) {
  constexpr float C = SCALE * 1.4426950408889634f;
  int tid_ = threadIdx.x; asm volatile("" : "+v"(tid_));
  const int tid = tid_, wid = __builtin_amdgcn_readfirstlane(tid >> 6), lane = tid & 63, r32 = lane & 31, hi = lane >> 5;
  float* ws = (float*)(lds + DV_WSOFF) + wid * 64; float* li_l = ws; float* al_l = ws + 32;
  float m_reg = -1e30f, l_reg = 0; f32x16 o[NDT] = {}; bf16x8 qr[8];
  const bf16* Qw = Qb + (long)(wid * QBLK + r32) * LDQ + hi * 8;
#pragma unroll
  for (int d0 = 0; d0 < 8; ++d0) qr[d0] = *reinterpret_cast<const bf16x8*>(Qw + d0 * 16);
  const int krow = wid * 4 + (lane >> 4);
  const unsigned ksrc = (unsigned)(krow * LDK + (((lane & 15) ^ (krow & 7)) << 3)) * 2u;
  const int kk = ((wid >> 1) << 3) | ((lane >> 2) & 7), vk = (kk & ~0xC) | ((kk & 4) << 1) | ((kk & 8) >> 1);
  const unsigned vsrc = (unsigned)(vk * LDK + ((((lane >> 5) & 1) | ((wid & 1) << 1)) << 5) + ((lane & 3) << 3)) * 2u;
  const unsigned ldsw = (unsigned)wid * 1024u;
  const int vbase = (int)(uintptr_t)ldsl + v_rd_base(lane);
  const int kbase = (int)(uintptr_t)ldsl + DV_KOFF + r32 * 256 + ((hi << 4) ^ ((r32 & 7) << 4));
#define DV_GLL(src, dst) __builtin_amdgcn_global_load_lds((const unsigned*)(src), (LAS unsigned*)(dst), 16, 0, 0)
#define DV_DMA(kbuf, voff, k0) do { const char* kp_ = (const char*)(Kh + (size_t)(k0) * LDK); const char* vp_ = (const char*)(Vh + (size_t)(k0) * LDK); \
    _Pragma("unroll") for (int i_ = 0; i_ < 2; ++i_) { \
      DV_GLL(kp_ + (size_t)i_ * (32 * LDK * 2) + ksrc, ldsl + DV_KOFF + (kbuf) * (int)SHM_K + ldsw + i_ * 8192); \
      DV_GLL(vp_ + (size_t)i_ * (32 * LDK * 2) + vsrc, ldsl + (voff) + ldsw + i_ * 8192); \
      if constexpr (NDT == 8) DV_GLL(vp_ + (size_t)i_ * (32 * LDK * 2) + 256 + vsrc, ldsl + (voff) + (int)SHM_V + ldsw + i_ * 8192); } } while (0)
#define DV_RESC(a) do { if (__any((a) < 1.f)) { if (hi == 0) al_l[r32] = (a); asm volatile("s_waitcnt lgkmcnt(0)" ::: "memory"); \
    for (int d = 0; d < NDT; ++d) for (int r = 0; r < 16; ++r) o[d][r] *= al_l[crow(r, hi)]; } } while (0)
  const int NT = seq / KVBLK;
  int b0 = 0, b1 = DV_VB, b2 = 2 * DV_VB;
  DV_DMA(0, b0, 0); if (NT > 1) DV_DMA(1, b1, KVBLK);
  asm volatile("s_waitcnt vmcnt(0)" ::: "memory"); __syncthreads();
  bf16x8 pp2 = {}, pp3 = {};
  bf16x8 ka0, ka1, kb0, kb1;
  { const int kb = kbase; DV_KRD(ka, 0); DV_KRD(kb, 1); }
#pragma unroll 1
  for (int j = 0; j < NT; ++j) {
    f32x16 p0 = {}, p1 = {}; float alpha, pmax, mnC, ps; bf16x8 pa0, pa1; s16x4 a0, a1, a2, a3, c0, c1, c2, c3;
    const int vbX = vbase + (j == 0 ? b0 : b2), vbY = vbase + b0;
    {
      bf16x8 kc0, kc1; const int kb = kbase + (j & 1) * (int)SHM_K;
      SBAR();
      DV_KRD(kc, 2); DV_W(4); DV_QM(ka, 0);
      DV_KRD(ka, 3); DV_W(4); DV_QM(kb, 1);
      DV_KRD(kb, 4); DV_W(4); DV_QM(kc, 2);
      DV_KRD(kc, 5); DV_W(4); DV_QM(ka, 3);
      DV_KRD(ka, 6); DV_W(4); DV_QM(kb, 4);
      DV_KRD(kb, 7); DV_W(4); DV_QM(kc, 5);
      DV_RDV(a, 0, 2, vbX); DV_RDV(c, 1, 2, vbX);
      DV_W(10); DV_QM(ka, 6);
      DV_W(8); DV_QM(kb, 7);
    }
    {
      const int vb = vbX; ps = 0.f;
#define DV_SM_MAX0() do { pmax = p0[0]; for (int r = 1; r < 16; ++r) pmax = fmaxf(pmax, p0[r]); } while (0)
#define DV_SM_MAX1() do { for (int r = 0; r < 16; ++r) pmax = fmaxf(pmax, p1[r]); } while (0)
#define DV_SM_M() do { { auto rr = __builtin_amdgcn_permlane32_swap(__float_as_uint(pmax), __float_as_uint(pmax), false, false); pmax = fmaxf(__uint_as_float(rr[0]), __uint_as_float(rr[1])); } \
        const bool keep = __all(pmax - m_reg <= THR / SCALE); const float mn = keep ? m_reg : fmaxf(m_reg, pmax);     \
        alpha = __builtin_amdgcn_exp2f((m_reg - mn) * C); m_reg = mn; mnC = -mn * C; } while (0)
#define DV_SM_F(P) do { for (int r = 0; r < 16; ++r) P[r] = fmaf(P[r], C, mnC); } while (0)
      if constexpr (NDT == 8) {
        DV_W(4); DV_MM(a, 0, pp2, pp3);
        DV_SM_MAX0();
        DV_RD(a, 2, 2); DV_W(4); DV_MM(c, 1, pp2, pp3);
        DV_SM_MAX1();
        DV_RD(c, 3, 2); DV_W(4); DV_MM(a, 2, pp2, pp3);
        DV_SM_M(); DV_SM_F(p0);
        DV_RD(a, 4, 2); DV_W(4); DV_MM(c, 3, pp2, pp3);
        DV_SM_F(p1);
        DV_EXS(p0, 0);
        DV_RD(c, 5, 2); DV_W(4); DV_MM(a, 4, pp2, pp3);
        DV_EXS(p0, 1); DV_EXS(p0, 2);
        DV_RD(a, 6, 2); DV_W(4); DV_MM(c, 5, pp2, pp3);
        DV_EXS(p0, 3); DV_EXS(p0, 4);
        DV_RD(c, 7, 2); DV_W(4); DV_MM(a, 6, pp2, pp3);
        DV_EXS(p0, 5); DV_EXS(p0, 6);
        DV_RDV(a, 0, 0, vbY); DV_W(4); DV_MM(c, 7, pp2, pp3);
        DV_EXS(p0, 7);
        DV_RDV(c, 1, 0, vbY);
      } else {
        DV_W(4); DV_MM(a, 0, pp2, pp3);
        DV_SM_MAX0(); DV_SM_MAX1();
        DV_RD(a, 2, 2); DV_W(4); DV_MM(c, 1, pp2, pp3);
        DV_SM_M(); DV_SM_F(p0); DV_SM_F(p1);
        DV_RD(c, 3, 2); DV_W(4); DV_MM(a, 2, pp2, pp3);
        DV_EXS(p0, 0); DV_EXS(p0, 1); DV_EXS(p0, 2); DV_EXS(p0, 3);
        DV_RDV(a, 0, 0, vbY); DV_W(4); DV_MM(c, 3, pp2, pp3);
        DV_EXS(p0, 4); DV_EXS(p0, 5); DV_EXS(p0, 6); DV_EXS(p0, 7);
        DV_RDV(c, 1, 0, vbY);
      }
#undef DV_SM_MAX0
#undef DV_SM_MAX1
#undef DV_SM_M
#undef DV_SM_F
      DV_PK4(p0, 0, pa0); DV_PK4(p0, 8, pa1);
      DV_W(0);
    }
    DV_RESC(alpha);
    asm volatile("s_waitcnt vmcnt(0)" ::: "memory"); __syncthreads();
    {
      const int vb = vbY; SBAR();
      if constexpr (NDT == 8) {
        DV_MM(a, 0, pa0, pa1); DV_EXS(p1, 0);
        DV_RD(a, 2, 0); DV_W(4); DV_MM(c, 1, pa0, pa1); DV_EXS(p1, 1);
        DV_RD(c, 3, 0); DV_W(4); DV_MM(a, 2, pa0, pa1); DV_EXS(p1, 2);
        DV_RD(a, 4, 0); DV_W(4); DV_MM(c, 3, pa0, pa1); DV_EXS(p1, 3);
        DV_RD(c, 5, 0); DV_W(4); DV_MM(a, 4, pa0, pa1); DV_EXS(p1, 4);
        DV_RD(a, 6, 0); DV_W(4); DV_MM(c, 5, pa0, pa1); DV_EXS(p1, 5);
        DV_RD(c, 7, 0); DV_W(4); DV_MM(a, 6, pa0, pa1); DV_EXS(p1, 6);
        { const int kb = kbase + ((j + 1) & 1) * (int)SHM_K; DV_KRD(ka, 0); DV_KRD(kb, 1); }
        DV_W(4); DV_MM(c, 7, pa0, pa1); DV_EXS(p1, 7);
      } else {
        DV_MM(a, 0, pa0, pa1); DV_EXS(p1, 0); DV_EXS(p1, 1);
        DV_RD(a, 2, 0); DV_W(4); DV_MM(c, 1, pa0, pa1); DV_EXS(p1, 2); DV_EXS(p1, 3);
        DV_RD(c, 3, 0); DV_W(4); DV_MM(a, 2, pa0, pa1); DV_EXS(p1, 4); DV_EXS(p1, 5);
        { const int kb = kbase + ((j + 1) & 1) * (int)SHM_K; DV_KRD(ka, 0); DV_KRD(kb, 1); }
        DV_W(4); DV_MM(c, 3, pa0, pa1); DV_EXS(p1, 6); DV_EXS(p1, 7);
      }
      if (j + 2 < NT) DV_DMA(j & 1, b2, (j + 2) * KVBLK);
      { auto rr = __builtin_amdgcn_permlane32_swap(__float_as_uint(ps), __float_as_uint(ps), false, false); ps = __uint_as_float(rr[0]) + __uint_as_float(rr[1]); }
      l_reg = l_reg * alpha + ps;
      DV_PK4(p1, 0, pp2); DV_PK4(p1, 8, pp3);
      DV_W(0);
    }
    { const int t = b0; b0 = b1; b1 = b2; b2 = t; }
  }
  {
    s16x4 a0, a1, a2, a3, c0, c1, c2, c3; const int vb = vbase + b2; SBAR();
    DV_RD(a, 0, 2); DV_RD(c, 1, 2);
    DV_W(4); DV_MM(a, 0, pp2, pp3);
    DV_RD(a, 2, 2); DV_W(4); DV_MM(c, 1, pp2, pp3);
    if constexpr (NDT == 8) {
      DV_RD(c, 3, 2); DV_W(4); DV_MM(a, 2, pp2, pp3);
      DV_RD(a, 4, 2); DV_W(4); DV_MM(c, 3, pp2, pp3);
      DV_RD(c, 5, 2); DV_W(4); DV_MM(a, 4, pp2, pp3);
      DV_RD(a, 6, 2); DV_W(4); DV_MM(c, 5, pp2, pp3);
      DV_RD(c, 7, 2); DV_W(4); DV_MM(a, 6, pp2, pp3);
      DV_W(0); DV_MM(c, 7, pp2, pp3);
    } else {
      DV_RD(c, 3, 2); DV_W(4); DV_MM(a, 2, pp2, pp3);
      DV_W(0); DV_MM(c, 3, pp2, pp3);
    }
  }
  asm volatile("s_waitcnt lgkmcnt(0)" ::: "memory"); __builtin_amdgcn_s_barrier();
  if (hi == 0) li_l[r32] = l_reg; asm volatile("s_waitcnt lgkmcnt(0)" ::: "memory");
  float rli[16];
#pragma unroll
  for (int r = 0; r < 16; ++r) rli[r] = __builtin_amdgcn_rcpf(li_l[crow(r, hi)]);
  bf16* Ow = Ob + (long)(wid * QBLK) * ldo;
#pragma unroll
  for (int r = 0; r < 16; ++r) { int orow = crow(r, hi);
#pragma unroll
    for (int d0 = 0; d0 < NDT; ++d0) Ow[(long)orow * ldo + d0 * 32 + r32] = (bf16)(cvt_pk(o[d0][r] * rli[r], 0.f) & 0xffffu); }
#undef DV_GLL
#undef DV_DMA
#undef DV_RESC
}
#undef TRL
#undef TRLV
#undef DV_RDV
#undef DV_RD
#undef DV_PK
#undef DV_MM
#undef DV_W
#undef DV_KRD
#undef DV_QM
#undef DV_EX
#undef DV_EXS
#undef DV_PK4
}

#define XB_TMO      128
#define XB_XCNT(j)  (256  + 64 * (j))
#define XB_XSUB(j)  (1280 + 64 * (j))
#define XB_XGEN(j)  (2304 + 64 * (j))
#define XB_TOP      3328
#define XB_TOPGEN   3392
#define XCD_BAR_WORDS 3456
#define XB_SPIN_CAP (1u << 18)
__device__ __forceinline__ unsigned xb_ld(unsigned* p)              { return __hip_atomic_load(p, __ATOMIC_RELAXED, __HIP_MEMORY_SCOPE_AGENT); }
__device__ __forceinline__ unsigned xb_add(unsigned* p, unsigned v) { return __hip_atomic_fetch_add(p, v, __ATOMIC_RELAXED, __HIP_MEMORY_SCOPE_AGENT); }
__device__ __forceinline__ unsigned xb_xcc_id() { return (unsigned)__builtin_amdgcn_s_getreg((3 << 11) | 20) & 0xFu; }
#define XB_SPIN(cond, bar) do { unsigned _sp = 0; while (cond) { __builtin_amdgcn_s_sleep(1); \
    if ((++_sp & 255u) == 0u) { if (xb_ld(&(bar)[XB_TMO])) break; if (_sp > XB_SPIN_CAP) { atomicAdd(&(bar)[XB_TMO], 1u); break; } } } } while (0)
struct XcdBarrier { unsigned* bar; unsigned x; volatile LAS unsigned* st; };
__device__ __forceinline__ XcdBarrier xcd_barrier_post(unsigned* bar, volatile LAS unsigned* st) {
    XcdBarrier b; b.bar = bar; b.x = xb_xcc_id(); b.st = st;
    if (threadIdx.x == 0) (void)xb_add(&bar[XB_XCNT(b.x)], 1u);
    return b;
}
__device__ __forceinline__ void xcd_barrier_complete(unsigned* bar, unsigned x, unsigned& nloc, unsigned& nx) {
    const unsigned G = gridDim.x * gridDim.y * gridDim.z;
    unsigned sum, cnt, mine, sp = 0u;
    for (;;) {
        sum = 0u; cnt = 0u; mine = 0u;
#pragma unroll
        for (unsigned j = 0; j < 16; ++j) { const unsigned c = xb_ld(&bar[XB_XCNT(j)]); sum += c; cnt += (c > 0u) ? 1u : 0u; mine = (j == x) ? c : mine; }
        if (sum == G) break;
        __builtin_amdgcn_s_sleep(1);
        if ((++sp & 255u) == 0u) { if (xb_ld(&bar[XB_TMO])) break; if (sp > XB_SPIN_CAP) { atomicAdd(&bar[XB_TMO], 1u); break; } }
    }
    nloc = mine > 0u ? mine : 1u; nx = cnt > 0u ? cnt : 1u;
}
__device__ __forceinline__ void xcd_barrier(const XcdBarrier& b) {
    asm volatile("s_waitcnt vmcnt(0)" ::: "memory");
    __syncthreads();
    if (threadIdx.x == 0) {
        unsigned* bar = b.bar;
        __builtin_amdgcn_s_waitcnt(0);
        unsigned nloc = b.st[0], nx = b.st[1];
        if (nloc == 0u) { xcd_barrier_complete(bar, b.x, nloc, nx); b.st[0] = nloc; b.st[1] = nx; }
        const unsigned old = xb_add(&bar[XB_XSUB(b.x)], 1u);
        const unsigned gen = old / nloc;
        if (old + 1u == (gen + 1u) * nloc) {
            __builtin_amdgcn_fence(__ATOMIC_RELEASE, "agent");
            asm volatile("s_waitcnt vmcnt(0)" ::: "memory");
            const unsigned og = xb_add(&bar[XB_TOP], 1u);
            const unsigned tg = og / nx;
            if (og + 1u == (tg + 1u) * nx) xb_add(&bar[XB_TOPGEN], 1u);
            else XB_SPIN(xb_ld(&bar[XB_TOPGEN]) == tg, bar);
            __builtin_amdgcn_fence(__ATOMIC_ACQUIRE, "agent");
            xb_add(&bar[XB_XGEN(b.x)], 1u);
            asm volatile("s_waitcnt vmcnt(0)" ::: "memory");
        } else {
            XB_SPIN(xb_ld(&bar[XB_XGEN(b.x)]) == gen, bar);
            __builtin_amdgcn_fence(__ATOMIC_ACQUIRE, "agent");
            asm volatile("s_waitcnt vmcnt(0)" ::: "memory");
        }
    }
    __syncthreads();
}

struct Args { const float* in[34]; float* out; unsigned char* ws; int ph_lo, ph_hi; };
typedef const __attribute__((address_space(4))) Args* KArgs;
template <class T> __device__ __forceinline__ T* as_global(T* p) { return (T*)(GAS T*)p; }
__device__ __forceinline__ KArgs kargs() { KArgs p = (KArgs)__builtin_amdgcn_kernarg_segment_ptr(); asm volatile("" : "+s"(p)); return p; }
__device__ __forceinline__ const float* ain(KArgs a, int i) { return as_global(a->in[i]); }
__device__ __forceinline__ float* aout(KArgs a) { return as_global(a->out); }
struct Frame {
    unsigned char* lds; unsigned char* lds0;
    LAS unsigned char* ldsl;
    unsigned char* ws;
    int tid, lane, wave, G, gw, NGW;
};
enum { I_X = 0, I_C, I_CTX, I_CCTX, I_WADA, I_BADA, I_N1G, I_N2G, I_WIN, I_BGATE, I_QNA, I_KNA, I_DLAM, I_SUBN, I_QNC, I_KNC, I_CONVW, I_CONVB,
       I_LWA, I_LBA, I_LWX, I_LBX, I_LLAM, I_WBA, I_WBB, I_WBC, I_WOUT, I_WGRP, I_BGRP, I_WRT, I_BRT, I_W1, I_W3, I_W2 };

__device__ __forceinline__ void phase_ids(Frame& F) {
    int t = threadIdx.x; asm volatile("" : "+v"(t)); F.tid = t; F.lane = t & 63; F.wave = __builtin_amdgcn_readfirstlane(t >> 6); F.gw = blockIdx.x * 8 + F.wave;
    GAS unsigned char* w = (GAS unsigned char*)kargs()->ws; asm volatile("" : "+s"(w)); F.ws = (unsigned char*)w; F.lds = F.lds0; F.ldsl = (LAS unsigned char*)F.lds0;
}
__device__ __forceinline__ int launder_s(int v) { asm volatile("" : "+s"(v)); return v; }
__host__ __device__ __forceinline__ int qk_perm(int n) { const int q = n >> 5, i = n & 31; return 8 * (((q >> 1) << 3) + (i >> 2)) + (i & 3) + ((q & 1) << 2); }
__device__ __forceinline__ void tr_item(const float* __restrict__ W, int N, bf16* __restrict__ WT, int K, int k0, int n0, int drow0, LAS float* scr, int lane, bool hperm = false) {
#pragma unroll 8
    for (int i = 0; i < 64; ++i) scr[i * 65 + lane] = __builtin_nontemporal_load(&W[(size_t)(k0 + i) * N + n0 + lane]);
    LDS_WAIT();
    const int c = lane & 7;
#pragma unroll
    for (int j = 0; j < 8; ++j) { const int n = (lane >> 3) + 8 * j; const LAS float* s = scr + (8 * c) * 65 + n;
        v4u o; o.x = cvt_pk(s[0], s[65]); o.y = cvt_pk(s[130], s[195]); o.z = cvt_pk(s[260], s[325]); o.w = cvt_pk(s[390], s[455]);
        const int drow = hperm ? (drow0 & ~127) + qk_perm((drow0 & 127) + n) : drow0 + n;
        *(v4u*)(WT + (size_t)drow * K + k0 + 8 * c) = o; }
    LDS_WAIT();
}
__device__ __forceinline__ void tr_item8(const float* __restrict__ W, int N, unsigned char* __restrict__ WT, int K, int k0, int n0, int drow0, float scale, LAS float* scr, int lane) {
#pragma unroll 8
    for (int i = 0; i < 64; ++i) scr[i * 65 + lane] = __builtin_nontemporal_load(&W[(size_t)(k0 + i) * N + n0 + lane]);
    LDS_WAIT();
    const int c = lane & 7;
#pragma unroll
    for (int j = 0; j < 8; ++j) { const int n = (lane >> 3) + 8 * j; const LAS float* s = scr + (8 * c) * 65 + n;
        unsigned lo = 0u, hi = 0u;
        lo = __builtin_amdgcn_cvt_pk_fp8_f32(s[0] * scale, s[65] * scale, lo, false); lo = __builtin_amdgcn_cvt_pk_fp8_f32(s[130] * scale, s[195] * scale, lo, true);
        hi = __builtin_amdgcn_cvt_pk_fp8_f32(s[260] * scale, s[325] * scale, hi, false); hi = __builtin_amdgcn_cvt_pk_fp8_f32(s[390] * scale, s[455] * scale, hi, true);
        v2u o; o.x = lo; o.y = hi; *(v2u*)(WT + (size_t)(drow0 + n) * K + k0 + 8 * c) = o; }
    LDS_WAIT();
}
constexpr int CV_IN = 32 * 200, CV_BR = 16 * 32, CV_OUT = 32 * 32, CV_W = 32 * 256;
constexpr int CV_O_BR = CV_IN, CV_O_OUT = CV_O_BR + 3 * CV_BR, CV_O_W13 = CV_O_OUT + CV_OUT, CV_O_W2 = CV_O_W13 + 2 * CV_W, CV_NIT = CV_O_W2 + CV_W;
__device__ __forceinline__ void conv_weights(Frame& F, int l, int it_lo, int it_hi, int wg_lo) {
    phase_ids(F); l = launder_s(l); KArgs a = kargs();
    if ((int)blockIdx.x < wg_lo) return;
    LAS float* scr = (LAS float*)(F.ldsl + F.wave * 16640);
    constexpr int I_IN = CV_IN, I_BR = CV_BR, I_OUT = CV_OUT, I_W = CV_W;
    bf16* WIN = (bf16*)(F.ws + WS_WIN); bf16* WBR = (bf16*)(F.ws + WS_WBR); bf16* WOUT = (bf16*)(F.ws + WS_WOUT);
    bf16* W13 = (bf16*)(F.ws + (l ? WS_W13B : WS_W13)); bf16* W2 = (bf16*)(F.ws + (l ? WS_W2B : WS_W2));
    for (int it = it_lo + ((int)blockIdx.x - wg_lo) * 8 + F.wave; it < it_hi; it += (F.G - wg_lo) * 8) {
        int r = it;
        if (r < I_IN) { const int kb = r / 200, nb = r % 200;
            if (nb * 64 < C_G) { const int n0 = nb * 64; const bool qk = n0 < C_AV || (n0 >= C_CQ && n0 < C_CV);
                tr_item(ain(a, I_WIN) + (size_t)l * D * INC, INC, WIN, D, kb * 64, n0, n0, scr, F.lane, qk); }
            else tr_item8(ain(a, I_WIN) + (size_t)l * D * INC, INC, F.ws + WS_WING8, D, kb * 64, nb * 64, nb * 64 - C_G, 64.0f, scr, F.lane);
            continue; } r -= I_IN;
        if (r < 3 * I_BR) { const int br = r / I_BR, q = r % I_BR, kb = q / 32, nb = q % 32;
            tr_item(ain(a, I_WBA + br) + (size_t)l * 1024 * D, D, WBR + (size_t)br * D * 1024, 1024, kb * 64, nb * 64, nb * 64, scr, F.lane); continue; } r -= 3 * I_BR;
        if (r < I_OUT) { const int kb = r / 32, nb = r % 32; tr_item(ain(a, I_WOUT) + (size_t)l * D * D, D, WOUT, D, kb * 64, nb * 64, nb * 64, scr, F.lane); continue; } r -= I_OUT;
        if (r < 2 * I_W) { const int which = r / I_W, q = r % I_W, e = q / 256, q2 = q % 256, kb = q2 / 8, nb = q2 % 8;
            const int n0 = nb * 64; const int drow = e * 1024 + (n0 / 128) * 256 + (n0 % 128) + which * 128;
            tr_item8(ain(a, which ? I_W3 : I_W1) + ((size_t)l * NE + e) * D * DE, DE, (unsigned char*)W13, D, kb * 64, n0, drow, 64.0f, scr, F.lane); continue; } r -= 2 * I_W;
        { const int e = r / 256, q2 = r % 256, kb = q2 / 32, nb = q2 % 32;
            tr_item(ain(a, I_W2) + ((size_t)l * NE + e) * DE * D, D, W2, DE, kb * 64, nb * 64, e * D + nb * 64, scr, F.lane); }
    }
}

__device__ __forceinline__ void p0_misc(Frame& F) {
    phase_ids(F); KArgs a = kargs();
    LAS float* sl = (LAS float*)F.ldsl;
    LAS float* red = sl + 9 * 2048;
    const float* c = ain(a, I_C); const float* cc = ain(a, I_CCTX);
    float* mod = (float*)(F.ws + WS_MOD);
    if (blockIdx.x < 192 || F.G < 192) {
        for (int idx = F.tid; idx < 9 * 2048; idx += 512) { const int b = idx >> 11, k = idx & 2047; const float v = b < 8 ? c[b * 2048 + k] : cc[k]; sl[idx] = v / (1.0f + expf(-v)); }
        __syncthreads();
        for (int it = blockIdx.x; it < 192; it += F.G) {
            const int l = it / 96, cb = it % 96, col = cb * 128 + 2 * F.lane;
            const float* wp = ain(a, I_WADA) + ((size_t)l * D + F.wave * 256) * (NMOD * D) + col;
            float ax[9], ay[9];
#pragma unroll
            for (int b = 0; b < 9; ++b) { ax[b] = 0.f; ay[b] = 0.f; }
            for (int k = 0; k < 256; k += 8) {
                f32x2 w[8];
#pragma unroll
                for (int u = 0; u < 8; ++u) w[u] = __builtin_nontemporal_load((const f32x2*)(wp + (size_t)(k + u) * (NMOD * D)));
#pragma unroll
                for (int u = 0; u < 8; ++u)
#pragma unroll
                    for (int b = 0; b < 9; ++b) { const float s = sl[b * 2048 + F.wave * 256 + k + u]; ax[b] += s * w[u].x; ay[b] += s * w[u].y; }
            }
#pragma unroll
            for (int b = 0; b < 9; ++b) { red[(F.wave * 9 + b) * 128 + 2 * F.lane] = ax[b]; red[(F.wave * 9 + b) * 128 + 2 * F.lane + 1] = ay[b]; }
            __syncthreads();
            for (int o = F.tid; o < 9 * 128; o += 512) { const int b = o >> 7, ci = o & 127; float s = 0.f;
#pragma unroll
                for (int w = 0; w < 8; ++w) s += red[(w * 9 + b) * 128 + ci];
                mod[((size_t)l * 9 + b) * (NMOD * D) + cb * 128 + ci] = s + ain(a, I_BADA)[(size_t)l * (NMOD * D) + cb * 128 + ci]; }
            __syncthreads();
        }
    }
    { float* rc = (float*)(F.ws + WS_ROPE); float* rs = rc + 2048 * 64;
      for (int idx = blockIdx.x * 512 + F.tid; idx < 2048 * 64; idx += F.G * 512) { const int t = idx >> 6, j = idx & 63, jj = j & 31;
          const float inv = 1.0f / powf(10000.0f, (float)(2 * jj) / 64.0f); const float pos = (float)(j < 32 ? (t >> 6) : (t & 63));
          float s, co; sincosf(pos * inv, &s, &co); rc[idx] = co; rs[idx] = s; } }
    if (blockIdx.x == 0 && F.wave < 2) { const int l = F.wave; const float* dl = ain(a, I_DLAM) + (size_t)l * 4 * 128;
        float s01 = dl[F.lane] * dl[128 + F.lane] + dl[64 + F.lane] * dl[192 + F.lane];
        float s23 = dl[256 + F.lane] * dl[384 + F.lane] + dl[320 + F.lane] * dl[448 + F.lane];
        s01 = wave_sum(s01); s23 = wave_sum(s23);
        const float li = l == 0 ? 0.2f : 0.3555090676f;
        if (F.lane == 0) ((float*)(F.ws + WS_MISC + MISC_LAM))[l] = expf(s01) - expf(s23) + li; }
    { bf16* wr = (bf16*)(F.ws + WS_MISC + MISC_WR);
      for (int idx = blockIdx.x * 512 + F.tid; idx < 2 * 48 * 2048; idx += F.G * 512) { const int l = idx / (48 * 2048), rem = idx % (48 * 2048), e = rem >> 11, k = rem & 2047;
          float w = 0.f; if (e < 4) w = ain(a, I_WGRP)[((size_t)l * D + k) * 4 + e]; else if (e < 36) w = ain(a, I_WRT)[((size_t)l * D + k) * 32 + (e - 4)];
          const unsigned hi = cvt_pk(w, 0.f) & 0xffffu; const float lo = w - bflo(hi);
          wr[((size_t)(l * 2 + 0) * 48 + e) * 2048 + k] = (bf16)hi; wr[((size_t)(l * 2 + 1) * 48 + e) * 2048 + k] = (bf16)(cvt_pk(lo, 0.f) & 0xffffu); } }
    { float* qg = (float*)(F.ws + WS_MISC + MISC_QKG); for (int idx = blockIdx.x * 512 + F.tid; idx < 2 * 4 * 128; idx += F.G * 512) { const int l = idx >> 9, w = (idx >> 7) & 3, k = idx & 127;
          qg[idx] = ain(a, w == 0 ? I_QNA : (w == 1 ? I_KNA : (w == 2 ? I_QNC : I_KNC)))[l * 128 + k]; } }
    { float* spt = (float*)(F.ws + WS_MISC + MISC_SP); for (int idx = blockIdx.x * 512 + F.tid; idx < 2 * 2 * 1024; idx += F.G * 512) spt[idx] = log1pf(expf(-ain(a, I_LLAM)[idx])); }
    { bf16* lw = (bf16*)(F.ws + WS_LRUW);
      for (int idx = blockIdx.x * 512 + F.tid; idx < 2 * 2 * 2 * 8 * 128 * 128; idx += F.G * 512) {
          const int cidx = idx & 127, d = (idx >> 7) & 127, n = (idx >> 14) & 7, dir = (idx >> 17) & 1, mat = (idx >> 18) & 1, l = idx >> 19;
          const float w = ain(a, mat ? I_LWX : I_LWA)[((((size_t)l * 2 + dir) * 8 + n) * 128 + cidx) * 128 + d];
          lw[idx] = (bf16)(cvt_pk(w, 0.f) & 0xffffu); } }
}

__device__ __forceinline__ void row_split(int r, int& b, int& i) { b = r / TB; i = r - b * TB; }
__device__ __forceinline__ size_t hrow_off(int b, int i, bool& ctx) { ctx = i < CTXL; return ctx ? ((size_t)b * CTXL + i) * D : ((size_t)b * SEQ + (i - CTXL)) * D; }

__device__ __forceinline__ void norm_mod(f32x4 (&v)[8], const float* g, const float* shift, const float* scale, int lane) {
    float ss = 0.f;
#pragma unroll
    for (int j = 0; j < 8; ++j) ss += (v[j][0] * v[j][0] + v[j][1] * v[j][1]) + (v[j][2] * v[j][2] + v[j][3] * v[j][3]);
    ss = wave_sum(ss);
    const float rs = rsqrtf(ss * (1.0f / D) + EPS);
#pragma unroll
    for (int j = 0; j < 8; ++j) { const int c = (lane + 64 * j) * 4; const f32x4 gg = *(const f32x4*)(g + c), sh = *(const f32x4*)(shift + c), sc = *(const f32x4*)(scale + c);
        v[j] = v[j] * rs * gg * (sc + 1.0f) + sh; }
}

__device__ __forceinline__ void wave_rows(const Frame& F, int total, int& r0, int& r1) { const int rpw = (total + F.NGW - 1) / F.NGW; r0 = F.gw * rpw; r1 = r0 + rpw < total ? r0 + rpw : total; if (r0 > total) r0 = total; }
__device__ __forceinline__ const bf16* hrow_ptr16(const bf16* hl, const bf16* hc, int r, int& bidx) { int b, i; row_split(r, b, i); bool ctx; const size_t off = hrow_off(b, i, ctx); bidx = ctx ? 8 : b; return (ctx ? hc : hl) + off; }
__device__ __forceinline__ const float* hrow_ptr(const float* hl, const float* hc, int r, int& bidx) { int b, i; row_split(r, b, i); bool ctx; const size_t off = hrow_off(b, i, ctx); bidx = ctx ? 8 : b; return (ctx ? hc : hl) + off; }
__device__ __forceinline__ void pa_norm1(Frame& F, int l) {
    phase_ids(F); l = launder_s(l); KArgs a = kargs();
    const float* hl = l == 0 ? ain(a, I_X) : aout(a); const float* hc = l == 0 ? ain(a, I_CTX) : (const float*)(F.ws + WS_HC);
    const float* mod = (const float*)(F.ws + WS_MOD) + (size_t)l * 9 * (NMOD * D);
    const float* g = ain(a, I_N1G) + (size_t)l * D; bf16* U = (bf16*)(F.ws + WS_ACT); unsigned char* U8 = F.ws + WS_U8;
    int r0, r1; wave_rows(F, ROWS, r0, r1);
    f32x4 cur[8], nxt[8], Gc[8], Sc[8]; int bcur = -1, bi;
    if (r0 < r1) { const f32x4* xr = (const f32x4*)hrow_ptr(hl, hc, r0, bi) + F.lane;
#pragma unroll
        for (int j = 0; j < 8; ++j) cur[j] = xr[64 * j]; }
    for (int r = r0; r < r1; ++r) {
        int bnx = bi;
        if (r + 1 < r1) { const f32x4* xr = (const f32x4*)hrow_ptr(hl, hc, r + 1, bnx) + F.lane;
#pragma unroll
            for (int j = 0; j < 8; ++j) nxt[j] = xr[64 * j]; }
        if (bi != bcur) { bcur = bi; const float* mb = mod + (size_t)bi * (NMOD * D);
#pragma unroll
            for (int j = 0; j < 8; ++j) { const int c = (F.lane + 64 * j) * 4; Gc[j] = *(const f32x4*)(g + c) * (*(const f32x4*)(mb + D + c) + 1.0f); Sc[j] = *(const f32x4*)(mb + c); } }
        float ss = 0.f;
#pragma unroll
        for (int j = 0; j < 8; ++j) ss += (cur[j][0] * cur[j][0] + cur[j][1] * cur[j][1]) + (cur[j][2] * cur[j][2] + cur[j][3] * cur[j][3]);
        ss = wave_sum(ss); const float rs = rsqrtf(ss * (1.0f / D) + EPS);
        v2u* o = (v2u*)(U + (size_t)r * D) + F.lane;
#pragma unroll
        for (int j = 0; j < 8; ++j) { const f32x4 y = cur[j] * rs * Gc[j] + Sc[j]; v2u w; w.x = cvt_pk(y[0], y[1]); w.y = cvt_pk(y[2], y[3]); o[64 * j] = w;
            unsigned q8 = 0u; q8 = __builtin_amdgcn_cvt_pk_fp8_f32(y[0], y[1], q8, false); q8 = __builtin_amdgcn_cvt_pk_fp8_f32(y[2], y[3], q8, true); ((unsigned*)(U8 + (size_t)r * D))[F.lane + 64 * j] = q8; }
#pragma unroll
        for (int j = 0; j < 8; ++j) cur[j] = nxt[j];
        bi = bnx;
    }
}

struct QkCtx { const float *qna, *kna, *qnc, *knc; f32x4 cs, sn; float sgn; int half, li; };
__device__ __forceinline__ int qk_col(const QkCtx& q, int it, const float*& g) {
    const int hidx = 2 * it + q.half; int colbase;
    if (hidx < 8) { colbase = C_AQ + hidx * 128; g = q.qna; } else if (hidx < 16) { colbase = C_AK + (hidx - 8) * 128; g = q.kna; }
    else if (hidx < 24) { colbase = C_CQ + (hidx - 16) * 128; g = q.qnc; } else { colbase = C_CK + (hidx - 24) * 128; g = q.knc; }
    return colbase + 4 * q.li;
}
__device__ __forceinline__ v2u qk_math(const v2u raw, const float* g, const QkCtx& q) {
    f32x4 x = {bflo(raw.x), bfhi(raw.x), bflo(raw.y), bfhi(raw.y)};
    float ss = (x[0] * x[0] + x[1] * x[1]) + (x[2] * x[2] + x[3] * x[3]);
    ss = row16_sum(ss); ss += __shfl_xor(ss, 16);
    const float rn = rsqrtf(ss * (1.0f / 128.0f) + EPS);
    const f32x4 gg = *(const f32x4*)(g + 4 * q.li);
    f32x4 y = x * rn * gg;
    f32x4 pr; pr[0] = dpp_f<0x128>(0.f, y[0]); pr[1] = dpp_f<0x128>(0.f, y[1]); pr[2] = dpp_f<0x128>(0.f, y[2]); pr[3] = dpp_f<0x128>(0.f, y[3]);
    y = y * q.cs + pr * q.sn * q.sgn;
    v2u w; w.x = cvt_pk(y[0], y[1]); w.y = cvt_pk(y[2], y[3]); return w;
}
template <int N> __device__ __forceinline__ void qk_heads(bf16* prow, const QkCtx& q, const int (&its)[N]) {
    v2u raw[N]; int col[N]; const float* g[N];
#pragma unroll
    for (int k = 0; k < N; ++k) { col[k] = qk_col(q, its[k], g[k]); raw[k] = *(const v2u*)(prow + col[k]); }
#pragma unroll
    for (int k = 0; k < N; ++k) raw[k] = qk_math(raw[k], g[k], q);
#pragma unroll
    for (int k = 0; k < N; ++k) *(v2u*)(prow + col[k]) = raw[k];
}
__device__ __forceinline__ void pc_qk(Frame& F, int l) {
    phase_ids(F); l = launder_s(l); KArgs a = kargs();
    bf16* PROJ = (bf16*)(F.ws + WS_PROJ);
    const float* rc = (const float*)(F.ws + WS_ROPE); const float* rs = rc + 2048 * 64;
    QkCtx q; q.qna = ain(a, I_QNA) + l * 128; q.kna = ain(a, I_KNA) + l * 128; q.qnc = ain(a, I_QNC) + l * 128; q.knc = ain(a, I_KNC) + l * 128;
    q.half = F.lane >> 5; q.li = F.lane & 31; q.sgn = (q.li & 8) ? 1.0f : -1.0f;
    for (int r = F.gw; r < ROWS; r += F.NGW) {
        int b, i; row_split(r, b, i); const bool lat = i >= CTXL; const int t = i - CTXL;
        bf16* prow = PROJ + (size_t)r * INC;
        q.cs = (f32x4){1.f, 1.f, 1.f, 1.f}; q.sn = (f32x4){0.f, 0.f, 0.f, 0.f};
        if (lat) { const int ti = t * 64 + (q.li >> 4) * 32 + 4 * (q.li & 7); q.cs = *(const f32x4*)(rc + ti); q.sn = *(const f32x4*)(rs + ti); }
        if (l == 1 && !lat) { const int its[5] = {4, 5, 6, 7, 12}; qk_heads<5>(prow, q, its); }
        else { const int its[13] = {0, 1, 2, 3, 4, 5, 6, 7, 8, 9, 10, 11, 12}; qk_heads<13>(prow, q, its); }
    }
}

template <bool FWD> __device__ __forceinline__ void row_scan(float& A, float& H) {
#define RS_STEP(N) { const float Ap = dpp_f<(FWD ? 0x110 : 0x100) + N>(1.0f, A); const float Hp = dpp_f<(FWD ? 0x110 : 0x100) + N>(0.0f, H); H = fmaf(A, Hp, H); A = A * Ap; }
    RS_STEP(1) RS_STEP(2) RS_STEP(4) RS_STEP(8)
#undef RS_STEP
}
__device__ __forceinline__ void pc_lru(Frame& F, int l) {
    phase_ids(F); l = launder_s(l); KArgs a = kargs();
    const bf16* PROJ = (const bf16*)(F.ws + WS_PROJ);
    bf16* hloc = (bf16*)(F.ws + WS_BIG); bf16* acum = hloc + (size_t)2 * ROWS * 1024;
    float* cA = (float*)(F.ws + WS_CARRY); float* cH = cA + CARRY_N;
    const bf16* LW = (const bf16*)(F.ws + WS_LRUW);
    const float* SP = (const float*)(F.ws + WS_MISC + MISC_SP) + (size_t)l * 2 * 1024;
    const float* convw = ain(a, I_CONVW) + (size_t)l * 4 * 1024; const float* convb = ain(a, I_CONVB) + (size_t)l * 1024;
    const int dir = F.wave >> 2, cq = F.wave & 3, tl = F.lane & 15, q4 = F.lane >> 4;
    const int ct = F.tid >> 4, ch0 = (F.tid & 15) * 8;
    const int NU = NB * NCH * 8;
    int n_cur = -1, n_cw = -1; bf16x8 Wa[2][4], Wx[2][4]; f32x4 ba[2], bx[2], sp[2], cb0, cb1, cw0[4], cw1[4];
    v4u raw[4]; int u = blockIdx.x;
#define LRU_LOAD(U) { const int n_ = (U) & 7, bc_ = (U) >> 3, c_ = bc_ % NCH, b_ = bc_ / NCH; const int r0_ = b_ * TB + c_ * 32; \
        const int lo_ = (c_ < 8) ? b_ * TB : b_ * TB + CTXL, hi_ = (c_ < 8) ? b_ * TB + CTXL : (b_ + 1) * TB; \
        _Pragma("unroll") for (int k = 0; k < 4; ++k) { const int rr = r0_ + ct - 2 + k; raw[k] = (v4u){0u, 0u, 0u, 0u}; \
            if (rr >= lo_ && rr < hi_) raw[k] = *(const v4u*)(PROJ + (size_t)rr * INC + C_BX + n_ * 128 + ch0); } }
    if (u < NU) LRU_LOAD(u);
    int buf = 0;
    for (; u < NU; u += F.G) {
        const int n = u & 7, bc = u >> 3, c = bc % NCH, b = bc / NCH; const int r0 = b * TB + c * 32;
        LAS bf16* xcb = (LAS bf16*)(F.ldsl + buf * 25600); LAS float* xcf = (LAS float*)(F.ldsl + buf * 25600 + 8704);
        if (n != n_cw) { n_cw = n; const int chg = n * 128 + ch0; cb0 = *(const f32x4*)(convb + chg); cb1 = *(const f32x4*)(convb + chg + 4);
#pragma unroll
            for (int k = 0; k < 4; ++k) { cw0[k] = *(const f32x4*)(convw + k * 1024 + chg); cw1[k] = *(const f32x4*)(convw + k * 1024 + chg + 4); } }
        { float acc8[8];
#pragma unroll
          for (int e = 0; e < 4; ++e) { acc8[e] = cb0[e]; acc8[4 + e] = cb1[e]; }
#pragma unroll
          for (int k = 0; k < 4; ++k) { const v4u rw = raw[k];
              const f32x4 w0 = cw0[k], w1 = cw1[k];
              acc8[0] += w0[0] * bflo(rw.x); acc8[1] += w0[1] * bfhi(rw.x); acc8[2] += w0[2] * bflo(rw.y); acc8[3] += w0[3] * bfhi(rw.y);
              acc8[4] += w1[0] * bflo(rw.z); acc8[5] += w1[1] * bfhi(rw.z); acc8[6] += w1[2] * bflo(rw.w); acc8[7] += w1[3] * bfhi(rw.w); }
          v4u pk; pk.x = cvt_pk(acc8[0], acc8[1]); pk.y = cvt_pk(acc8[2], acc8[3]); pk.z = cvt_pk(acc8[4], acc8[5]); pk.w = cvt_pk(acc8[6], acc8[7]);
          *(LAS v4u*)(xcb + ct * 136 + ch0) = pk;
          *(LAS f32x4*)(xcf + ct * 132 + ch0) = (f32x4){acc8[0], acc8[1], acc8[2], acc8[3]}; *(LAS f32x4*)(xcf + ct * 132 + ch0 + 4) = (f32x4){acc8[4], acc8[5], acc8[6], acc8[7]}; }
        __syncthreads();
        if (u + F.G < NU) LRU_LOAD(u + F.G);
        if (n != n_cur) { n_cur = n;
#pragma unroll
            for (int nt = 0; nt < 2; ++nt) { const int chA = cq * 32 + nt * 16 + tl;
#pragma unroll
                for (int k = 0; k < 4; ++k) {
                    Wa[nt][k] = *(const bf16x8*)(LW + ((((size_t)(l * 2 + 0) * 2 + dir) * 8 + n) * 128 + chA) * 128 + k * 32 + q4 * 8);
                    Wx[nt][k] = *(const bf16x8*)(LW + ((((size_t)(l * 2 + 1) * 2 + dir) * 8 + n) * 128 + chA) * 128 + k * 32 + q4 * 8); }
                const int chg = n * 128 + cq * 32 + nt * 16 + 4 * q4;
                ba[nt] = *(const f32x4*)(ain(a, I_LBA) + ((size_t)l * 2 + dir) * 1024 + chg); bx[nt] = *(const f32x4*)(ain(a, I_LBX) + ((size_t)l * 2 + dir) * 1024 + chg);
                sp[nt] = *(const f32x4*)(SP + (size_t)dir * 1024 + chg); } }
#pragma unroll
        for (int nt = 0; nt < 2; ++nt) {
            const int chl = cq * 32 + nt * 16 + 4 * q4;
            f32x4 av[2], hv[2];
#pragma unroll
            for (int mt = 0; mt < 2; ++mt) {
                f32x4 ra = {0.f, 0.f, 0.f, 0.f}, rx = {0.f, 0.f, 0.f, 0.f};
#pragma unroll
                for (int k = 0; k < 4; ++k) { const bf16x8 X = *(const LAS bf16x8*)(xcb + (mt * 16 + tl) * 136 + k * 32 + q4 * 8);
                    ra = __builtin_amdgcn_mfma_f32_16x16x32_bf16(Wa[nt][k], X, ra, 0, 0, 0); rx = __builtin_amdgcn_mfma_f32_16x16x32_bf16(Wx[nt][k], X, rx, 0, 0, 0); }
                const f32x4 xv = *(const LAS f32x4*)(xcf + (mt * 16 + tl) * 132 + chl);
#pragma unroll
                for (int j = 0; j < 4; ++j) { const float rg = sigmoidf_(ra[j] + ba[nt][j]), ig = sigmoidf_(rx[j] + bx[nt][j]);
                    const float la = -8.0f * rg * sp[nt][j]; const float aa = __expf(la); const float mult = __builtin_amdgcn_sqrtf(fmaxf(1.0f - aa * aa, 0.0f));
                    av[mt][j] = aa; hv[mt][j] = mult * ig * xv[j]; }
            }
            f32x4 cAo, cHo;
#pragma unroll
            for (int j = 0; j < 4; ++j) {
                float A0 = av[0][j], H0 = hv[0][j], A1 = av[1][j], H1 = hv[1][j];
                if (dir == 0) { row_scan<true>(A0, H0); row_scan<true>(A1, H1);
                    const float Ac = __shfl(A0, (F.lane & 48) | 15), Hc = __shfl(H0, (F.lane & 48) | 15);
                    H1 = fmaf(A1, Hc, H1); A1 = A1 * Ac; cAo[j] = A1; cHo[j] = H1; }
                else { row_scan<false>(A0, H0); row_scan<false>(A1, H1);
                    const float Ac = __shfl(A1, (F.lane & 48)), Hc = __shfl(H1, (F.lane & 48));
                    H0 = fmaf(A0, Hc, H0); A0 = A0 * Ac; cAo[j] = A0; cHo[j] = H0; }
                av[0][j] = A0; hv[0][j] = H0; av[1][j] = A1; hv[1][j] = H1;
            }
#pragma unroll
            for (int mt = 0; mt < 2; ++mt) { const size_t o = ((size_t)dir * ROWS + r0 + mt * 16 + tl) * 1024 + n * 128 + chl;
                v2u wh, wa; wh.x = cvt_pk(hv[mt][0], hv[mt][1]); wh.y = cvt_pk(hv[mt][2], hv[mt][3]); wa.x = cvt_pk(av[mt][0], av[mt][1]); wa.y = cvt_pk(av[mt][2], av[mt][3]);
                *(v2u*)(hloc + o) = wh; *(v2u*)(acum + o) = wa; }
            if (tl == (dir == 0 ? 15 : 0)) { const size_t ci = (((size_t)dir * NB + b) * NCH + c) * 1024 + n * 128 + chl; *(f32x4*)(cA + ci) = cAo; *(f32x4*)(cH + ci) = cHo; }
        }
        buf ^= 1;
    }
#undef LRU_LOAD
}

__device__ __forceinline__ void pd_chain(Frame& F) {
    phase_ids(F);
    const float* cA = (const float*)(F.ws + WS_CARRY); const float* cH = cA + CARRY_N; float* Hin = (float*)(F.ws + WS_CARRY) + 2 * CARRY_N;
    for (int blk = blockIdx.x; blk < 32; blk += F.G) {
        const int idx = blk * 512 + F.tid, dir = idx >> 13, b = (idx >> 10) & 7, ch = idx & 1023;
        const size_t base = (((size_t)dir * NB + b) * NCH) * 1024 + ch; float H = 0.f;
#pragma unroll 1
        for (int s0 = 0; s0 < NCH; s0 += 36) { float av[36], hv[36];
#pragma unroll
            for (int k = 0; k < 36; ++k) { const int s_ = s0 + k, c = dir == 0 ? s_ : (s_ < 8 ? 7 - s_ : 79 - s_); av[k] = cA[base + (size_t)c * 1024]; hv[k] = cH[base + (size_t)c * 1024]; }
#pragma unroll
            for (int k = 0; k < 36; ++k) { const int s_ = s0 + k, c = dir == 0 ? s_ : (s_ < 8 ? 7 - s_ : 79 - s_); Hin[base + (size_t)c * 1024] = H; H = av[k] * H + hv[k]; } }
    }
}
__device__ __forceinline__ void pd_attn(Frame& F, int l) {
    phase_ids(F); l = launder_s(l);
    const bf16* PROJ = (const bf16*)(F.ws + WS_PROJ); bf16* OA = (bf16*)(F.ws + WS_OA); bf16* YC = (bf16*)(F.ws + WS_YC);
    constexpr int NLAT = 1024, NCTX = 128;
    const int nun = NLAT + (l == 0 ? NCTX : 0);
    for (int u = blockIdx.x; u < nun; u += F.G) {
        int b, q0row, seq, hd; bool diff;
        if (u < NLAT) {
            int qb;
            if (F.G == 256) {
                const int rd = u >> 8, xcd = blockIdx.x & 7, slot = blockIdx.x >> 3; qb = slot & 7; diff = rd < 2;
                if (diff) { const int gi = (rd * 8 + xcd) * 2 + (slot >> 4); b = gi >> 2; hd = (gi & 3) * 2 + ((slot >> 3) & 1); }
                else { const int gi = (rd - 2) * 8 + xcd; b = gi >> 1; hd = (gi & 1) * 4 + (slot >> 3); }
            } else { diff = u < 512; const int v = u & 511; qb = v & 7; hd = (v >> 3) & 7; b = v >> 6; }
            q0row = b * TB + CTXL + qb * 256; seq = TB; }
        else { const int v = u - NLAT; diff = v < 64; hd = v & 7; b = (v & 63) >> 3; q0row = b * TB; seq = CTXL; }
        const bf16* kb = PROJ + (size_t)b * TB * INC; const bf16* qp = PROJ + (size_t)q0row * INC;
        if (diff) att::attn_dv256_body<8>(qp + C_AQ + hd * 128, kb + C_AK + hd * 128, kb + C_AV + (hd >> 1) * 256, OA + (size_t)q0row * D + hd * 256, D, seq, (char*)F.lds, F.ldsl);
        else att::attn_dv256_body<4>(qp + C_CQ + hd * 128, kb + C_CK + (hd >> 2) * 128, kb + C_CV + (hd >> 2) * 128, YC + (size_t)q0row * 1024 + hd * 128, 1024, seq, (char*)F.lds, F.ldsl);
    }
}

__device__ __forceinline__ void pe_combine(Frame& F, int l) {
    phase_ids(F); l = launder_s(l); KArgs a = kargs();
    const bf16* OA = (const bf16*)(F.ws + WS_OA); bf16* YA = (bf16*)(F.ws + WS_YA); bf16* YB = (bf16*)(F.ws + WS_YB); const bf16* PROJ = (const bf16*)(F.ws + WS_PROJ);
    const bf16* hloc = (const bf16*)(F.ws + WS_BIG); const bf16* acum = hloc + (size_t)2 * ROWS * 1024;
    const float* Hin = (const float*)(F.ws + WS_CARRY) + 2 * CARRY_N;
    const float lam = ((const float*)(F.ws + WS_MISC + MISC_LAM))[l]; const float omli = 1.0f - (l == 0 ? 0.2f : 0.3555090676f);
    const f32x4 sg = *(const f32x4*)(ain(a, I_SUBN) + (size_t)l * 256 + 4 * F.lane);
    int r0, r1; wave_rows(F, ROWS, r0, r1);
#define PE_SKIP(r) (l == 1 && ((r) % TB) < CTXL)
    { v2u cur[8], nxt[8]; int r = r0; while (r < r1 && PE_SKIP(r)) ++r; bool have = r < r1;
      if (have) {
#pragma unroll
          for (int m = 0; m < 8; ++m) cur[m] = __builtin_nontemporal_load((const v2u*)(OA + (size_t)r * D + m * 256 + 4 * F.lane)); }
      while (have) {
          int rn = r + 1; while (rn < r1 && PE_SKIP(rn)) ++rn; const bool hn = rn < r1;
          if (hn) {
#pragma unroll
              for (int m = 0; m < 8; ++m) nxt[m] = __builtin_nontemporal_load((const v2u*)(OA + (size_t)rn * D + m * 256 + 4 * F.lane)); }
#pragma unroll
          for (int h = 0; h < 4; ++h) { const v2u p = cur[2 * h], q = cur[2 * h + 1];
              f32x4 o = {bflo(p.x) - lam * bflo(q.x), bfhi(p.x) - lam * bfhi(q.x), bflo(p.y) - lam * bflo(q.y), bfhi(p.y) - lam * bfhi(q.y)};
              float ss = (o[0] * o[0] + o[1] * o[1]) + (o[2] * o[2] + o[3] * o[3]); ss = wave_sum(ss);
              const float rn2 = rsqrtf(ss * (1.0f / 256.0f) + EPS) * omli;
              o = o * rn2 * sg; v2u w; w.x = cvt_pk(o[0], o[1]); w.y = cvt_pk(o[2], o[3]); *(v2u*)(YA + (size_t)r * 1024 + h * 256 + 4 * F.lane) = w; }
#pragma unroll
          for (int m = 0; m < 8; ++m) cur[m] = nxt[m];
          r = rn; have = hn; } }
    { v4u cur[2][5], nxt[2][5]; f32x4 Hf[2][2], Hb[2][2]; int ccur = -1;
#define PE_LD(X, r) { _Pragma("unroll") for (int hv = 0; hv < 2; ++hv) { const int ch = F.lane * 16 + hv * 8; \
          X[hv][0] = __builtin_nontemporal_load((const v4u*)(hloc + (size_t)(r) * 1024 + ch)); X[hv][1] = __builtin_nontemporal_load((const v4u*)(acum + (size_t)(r) * 1024 + ch)); \
          X[hv][2] = __builtin_nontemporal_load((const v4u*)(hloc + ((size_t)ROWS + (r)) * 1024 + ch)); X[hv][3] = __builtin_nontemporal_load((const v4u*)(acum + ((size_t)ROWS + (r)) * 1024 + ch)); \
          X[hv][4] = *(const v4u*)(PROJ + (size_t)(r) * INC + C_BY + ch); } }
      int r = r0; while (r < r1 && PE_SKIP(r)) ++r; bool have = r < r1;
      if (have) PE_LD(cur, r);
      while (have) {
          int rn = r + 1; while (rn < r1 && PE_SKIP(rn)) ++rn; const bool hn = rn < r1;
          if (hn) PE_LD(nxt, rn);
          const int b = r / TB, i = r - b * TB, c = i >> 5, cc = b * NCH + c;
          if (cc != ccur) { ccur = cc; const size_t hf = ((size_t)(0 * NB + b) * NCH + c) * 1024, hb = ((size_t)(1 * NB + b) * NCH + c) * 1024;
#pragma unroll
              for (int hv = 0; hv < 2; ++hv) { const int ch = F.lane * 16 + hv * 8;
                  Hf[hv][0] = *(const f32x4*)(Hin + hf + ch); Hf[hv][1] = *(const f32x4*)(Hin + hf + ch + 4); Hb[hv][0] = *(const f32x4*)(Hin + hb + ch); Hb[hv][1] = *(const f32x4*)(Hin + hb + ch + 4); } }
#pragma unroll
          for (int hv = 0; hv < 2; ++hv) { const int ch = F.lane * 16 + hv * 8;
              const v4u lf = cur[hv][0], af = cur[hv][1], lb = cur[hv][2], ab = cur[hv][3], by = cur[hv][4];
              const f32x4 Hf0 = Hf[hv][0], Hf1 = Hf[hv][1], Hb0 = Hb[hv][0], Hb1 = Hb[hv][1];
              float y[8];
#define FIX(e, LF, AF, LB, AB, BY, HF, HB, GET) { const float hsum = GET(LF) + GET(AF) * HF + GET(LB) + GET(AB) * HB; const float x = GET(BY); \
                  const float u2 = 0.7978845608f * (x + 0.044715f * x * x * x); const float th = 1.0f - 2.0f * __builtin_amdgcn_rcpf(1.0f + __expf(2.0f * u2)); y[e] = hsum * 0.5f * x * (1.0f + th); }
              FIX(0, lf.x, af.x, lb.x, ab.x, by.x, Hf0[0], Hb0[0], bflo) FIX(1, lf.x, af.x, lb.x, ab.x, by.x, Hf0[1], Hb0[1], bfhi)
              FIX(2, lf.y, af.y, lb.y, ab.y, by.y, Hf0[2], Hb0[2], bflo) FIX(3, lf.y, af.y, lb.y, ab.y, by.y, Hf0[3], Hb0[3], bfhi)
              FIX(4, lf.z, af.z, lb.z, ab.z, by.z, Hf1[0], Hb1[0], bflo) FIX(5, lf.z, af.z, lb.z, ab.z, by.z, Hf1[1], Hb1[1], bfhi)
              FIX(6, lf.w, af.w, lb.w, ab.w, by.w, Hf1[2], Hb1[2], bflo) FIX(7, lf.w, af.w, lb.w, ab.w, by.w, Hf1[3], Hb1[3], bfhi)
#undef FIX
              v4u w; w.x = cvt_pk(y[0], y[1]); w.y = cvt_pk(y[2], y[3]); w.z = cvt_pk(y[4], y[5]); w.w = cvt_pk(y[6], y[7]);
              *(v4u*)(YB + (size_t)r * 1024 + ch) = w; }
#pragma unroll
          for (int hv = 0; hv < 2; ++hv)
#pragma unroll
              for (int k = 0; k < 5; ++k) cur[hv][k] = nxt[hv][k];
          r = rn; have = hn; }
#undef PE_LD
    }
#undef PE_SKIP
}

__device__ __forceinline__ void ph_norm2_route(Frame& F, int l) {
    phase_ids(F); l = launder_s(l); KArgs a = kargs();
    const bf16* hl = (const bf16*)(F.ws + WS_H16L); const bf16* hc = (const bf16*)(F.ws + WS_HC);
    const float* mod = (const float*)(F.ws + WS_MOD) + (size_t)l * 9 * (NMOD * D);
    const float* g = ain(a, I_N2G) + (size_t)l * D; unsigned char* V8 = F.ws + WS_V8;
    LAS bf16* Thi = (LAS bf16*)F.ldsl; LAS bf16* Tlo = (LAS bf16*)(F.ldsl + 65792);
    LAS float* red = (LAS float*)F.ldsl;
    LAS float* logit = (LAS float*)(F.ldsl + 24576);
    const bf16* wr = (const bf16*)(F.ws + WS_MISC + MISC_WR) + (size_t)l * 2 * 48 * 2048;
    unsigned* cnt = (unsigned*)(F.ws + WS_CTL) + CW_CNT + 64 * l;
    int* tok_e = (int*)(F.ws + WS_ROUTE + RT_E); int* tok_pos = (int*)(F.ws + WS_ROUTE + RT_POS); float* tok_p = (float*)(F.ws + WS_ROUTE + RT_P);
    int* list = (int*)(F.ws + WS_BIG);
    const int l15 = F.lane & 15, l4 = F.lane >> 4;
    const int nblk = l == 1 ? NB * (SEQ / 16) : ROWS / 16;
    bf16x8 PBh[4][3], PBl[4][3];
#pragma unroll
    for (int ks = 0; ks < 4; ++ks) { const int k0 = (F.wave * 8 + ks) * 32 + l4 * 8;
#pragma unroll
        for (int ct = 0; ct < 3; ++ct) { PBh[ks][ct] = *(const bf16x8*)(wr + (size_t)(ct * 16 + l15) * 2048 + k0); PBl[ks][ct] = *(const bf16x8*)(wr + (size_t)(48 + ct * 16 + l15) * 2048 + k0); } }
    int pe1 = 0, pe2 = 0, pr = -1; unsigned pp1 = 0u, pp2 = 0u;
#define PH_FLUSH() do { if (F.tid < 16 && pr >= 0) { list[(size_t)pe1 * pg8::LCAP + pp1] = 2 * pr; list[(size_t)pe2 * pg8::LCAP + pp2] = 2 * pr + 1; tok_pos[2 * pr] = (int)pp1; tok_pos[2 * pr + 1] = (int)pp2; } } while (0)
    for (int vb = blockIdx.x; vb < nblk; vb += F.G) {
        const int blk = l == 1 ? (vb / (SEQ / 16)) * (TB / 16) + CTXL / 16 + vb % (SEQ / 16) : vb;
#pragma unroll
        for (int rr = 0; rr < 2; ++rr) { const int lr = F.wave * 2 + rr, r = blk * 16 + lr;
            int b, i; row_split(r, b, i); bool ctx; const size_t off = hrow_off(b, i, ctx);
            const v2u* xr = (const v2u*)((ctx ? hc : hl) + off) + F.lane;
            f32x4 v[8]; v2u xv[8];
#pragma unroll
            for (int j = 0; j < 8; ++j) xv[j] = xr[64 * j];
#pragma unroll
            for (int j = 0; j < 8; ++j) v[j] = (f32x4){bflo(xv[j].x), bfhi(xv[j].x), bflo(xv[j].y), bfhi(xv[j].y)};
            const float* mb = mod + (size_t)(ctx ? 8 : b) * (NMOD * D);
            norm_mod(v, g, mb + 3 * D, mb + 4 * D, F.lane);
#pragma unroll
            for (int j = 0; j < 8; ++j) { v2u w; w.x = cvt_pk(v[j][0], v[j][1]); w.y = cvt_pk(v[j][2], v[j][3]);
                { unsigned q8 = 0u; q8 = __builtin_amdgcn_cvt_pk_fp8_f32(v[j][0], v[j][1], q8, false); q8 = __builtin_amdgcn_cvt_pk_fp8_f32(v[j][2], v[j][3], q8, true); ((unsigned*)(V8 + (size_t)r * D))[F.lane + 64 * j] = q8; }
                v2u wl; wl.x = cvt_pk(v[j][0] - bflo(w.x), v[j][1] - bfhi(w.x)); wl.y = cvt_pk(v[j][2] - bflo(w.y), v[j][3] - bfhi(w.y));
                *(LAS v2u*)(Thi + lr * 2056 + (F.lane + 64 * j) * 4) = w; *(LAS v2u*)(Tlo + lr * 2056 + (F.lane + 64 * j) * 4) = wl; } }
        __syncthreads();
        f32x4 acc[3];
#pragma unroll
        for (int ct = 0; ct < 3; ++ct) acc[ct] = (f32x4){0.f, 0.f, 0.f, 0.f};
#pragma unroll
        for (int ks = 0; ks < 4; ++ks) { const int k0 = (F.wave * 8 + ks) * 32 + l4 * 8;
            const bf16x8 Ah = *(const LAS bf16x8*)(Thi + l15 * 2056 + k0), Al = *(const LAS bf16x8*)(Tlo + l15 * 2056 + k0);
#pragma unroll
            for (int ct = 0; ct < 3; ++ct) {
                acc[ct] = __builtin_amdgcn_mfma_f32_16x16x32_bf16(Ah, PBh[ks][ct], acc[ct], 0, 0, 0);
                acc[ct] = __builtin_amdgcn_mfma_f32_16x16x32_bf16(Ah, PBl[ks][ct], acc[ct], 0, 0, 0);
                acc[ct] = __builtin_amdgcn_mfma_f32_16x16x32_bf16(Al, PBh[ks][ct], acc[ct], 0, 0, 0); } }
#pragma unroll 2
        for (int ks = 4; ks < 8; ++ks) { const int k0 = (F.wave * 8 + ks) * 32 + l4 * 8;
            const bf16x8 Ah = *(const LAS bf16x8*)(Thi + l15 * 2056 + k0), Al = *(const LAS bf16x8*)(Tlo + l15 * 2056 + k0);
#pragma unroll
            for (int ct = 0; ct < 3; ++ct) { const bf16x8 Bh = *(const bf16x8*)(wr + (size_t)(ct * 16 + l15) * 2048 + k0), Bl = *(const bf16x8*)(wr + (size_t)(48 + ct * 16 + l15) * 2048 + k0);
                acc[ct] = __builtin_amdgcn_mfma_f32_16x16x32_bf16(Ah, Bh, acc[ct], 0, 0, 0);
                acc[ct] = __builtin_amdgcn_mfma_f32_16x16x32_bf16(Ah, Bl, acc[ct], 0, 0, 0);
                acc[ct] = __builtin_amdgcn_mfma_f32_16x16x32_bf16(Al, Bh, acc[ct], 0, 0, 0); } }
        __syncthreads();
#pragma unroll
        for (int ct = 0; ct < 3; ++ct)
#pragma unroll
            for (int j = 0; j < 4; ++j) red[(F.wave * 16 + l4 * 4 + j) * 48 + ct * 16 + l15] = acc[ct][j];
        __syncthreads();
        for (int o = F.tid; o < 16 * 36; o += 512) { const int row = o / 36, e = o % 36; float s = 0.f;
#pragma unroll
            for (int w = 0; w < 8; ++w) s += red[(w * 16 + row) * 48 + e];
            s += e < 4 ? ain(a, I_BGRP)[l * 4 + e] : ain(a, I_BRT)[l * 32 + (e - 4)];
            logit[o] = s; }
        __syncthreads();
        if (F.tid < 16) { const LAS float* lg = logit + F.tid * 36; const int r = blk * 16 + F.tid;
            int gi = 0; float gm = lg[0];
            for (int e = 1; e < 4; ++e) { const float v = lg[e]; if (v > gm) { gm = v; gi = e; } }
            float gs = 0.f; for (int e = 0; e < 4; ++e) gs += expf(lg[e] - gm);
            const float gw = 1.0f / gs;
            const LAS float* el = lg + 4 + gi * 8;
            int i1 = 0; float v1 = el[0];
            for (int e = 1; e < 8; ++e) { const float v = el[e]; if (v > v1) { v1 = v; i1 = e; } }
            int i2 = -1; float v2 = -3.0e38f;
            for (int e = 0; e < 8; ++e) { const float v = el[e]; if (e != i1 && v > v2) { v2 = v; i2 = e; } }
            const float p1 = 1.0f / (1.0f + expf(v2 - v1)); const float p2 = 1.0f - p1;
            const int e1 = gi * 8 + i1, e2 = gi * 8 + i2;
            PH_FLUSH();
            pp1 = atomicAdd(&cnt[e1], 1u); pp2 = atomicAdd(&cnt[e2], 1u); pe1 = e1; pe2 = e2; pr = r;
            tok_e[2 * r] = e1; tok_e[2 * r + 1] = e2; tok_p[2 * r] = p1 * gw; tok_p[2 * r + 1] = p2 * gw; }
        __syncthreads();
    }
    PH_FLUSH();
#undef PH_FLUSH
}


constexpr int LDS_TAB_OFF = LDS_MISC_OFF + 64;
__device__ __forceinline__ LAS int* moe_tables(Frame& F, int l) {
    LAS int* tab = (LAS int*)(F.ldsl + LDS_TAB_OFF);
    const unsigned* cnt = (const unsigned*)(F.ws + WS_CTL) + CW_CNT + 64 * l;
    if (F.tid == 0) { int run = 0, nt = 0;
        for (int e = 0; e < NE; ++e) { const int c = (int)__hip_atomic_load(&cnt[e], __ATOMIC_RELAXED, __HIP_MEMORY_SCOPE_AGENT); tab[pg8::MT_CNT + e] = c; tab[pg8::MT_BASE + e] = run;
            const int n = (c + 255) >> 8; for (int t = 0; t < n; ++t) { tab[pg8::MT_E + nt] = e; tab[pg8::MT_P0 + nt] = t * 256; ++nt; } run += n * 256; }
        tab[pg8::MT_BASE + NE] = run; tab[0] = nt; }
    __syncthreads();
    return tab;
}

template <bool FUSE> __device__ __forceinline__ void pl_moe_combine(Frame& F, int l) {
    phase_ids(F); l = launder_s(l); KArgs a = kargs();
    bf16* hl = (bf16*)(F.ws + WS_H16L); bf16* hc = (bf16*)(F.ws + WS_HC); float* outl = aout(a);
    const float* mod = (const float*)(F.ws + WS_MOD) + (size_t)l * 9 * (NMOD * D);
    const bf16* YS = (const bf16*)(F.ws + WS_BIG);
    const int* tok_e = (const int*)(F.ws + WS_ROUTE + RT_E); const int* tok_pos = (const int*)(F.ws + WS_ROUTE + RT_POS); const float* tok_p = (const float*)(F.ws + WS_ROUTE + RT_P);
    const LAS int* tab = moe_tables(F, l);
    int r0, r1; wave_rows(F, ROWS, r0, r1);
    int md0 = 0, md1 = 0; float mp0 = 0.f, mp1 = 0.f;
    if (r0 + F.lane < r1) { const int r = r0 + F.lane; md0 = tab[pg8::MT_BASE + (tok_e[2 * r] & 31)] + tok_pos[2 * r]; md1 = tab[pg8::MT_BASE + (tok_e[2 * r + 1] & 31)] + tok_pos[2 * r + 1]; mp0 = tok_p[2 * r]; mp1 = tok_p[2 * r + 1]; }
    f32x4 hcur[8]; v2u hcr[8], hnxt[8]; v2u y0c[8], y1c[8], y0n[8], y1n[8]; int bi = 0; bool have = false;
    f32x4 Gc[8], Sc[8]; int bgc = -1; const float* modn = (const float*)(F.ws + WS_MOD) + (size_t)(l + 1) * 9 * (NMOD * D); const float* gn = ain(a, I_N1G) + (size_t)(l + 1) * D;
    bf16* U = (bf16*)(F.ws + WS_ACT); unsigned char* U8 = F.ws + WS_U8;
#define PL_SKIP(r) (l == 1 && ((r) % TB) < CTXL)
#define PL_LOAD(H, Y0, Y1, r, BI) { const v2u* hp_ = (const v2u*)hrow_ptr16(hl, hc, (r), BI) + F.lane; const int k_ = (r) - r0; \
        const int d0_ = __shfl(md0, k_), d1_ = __shfl(md1, k_); const v2u* a0_ = (const v2u*)(YS + (size_t)d0_ * D) + F.lane; const v2u* a1_ = (const v2u*)(YS + (size_t)d1_ * D) + F.lane; \
        _Pragma("unroll") for (int j = 0; j < 8; ++j) { H[j] = hp_[64 * j]; Y0[j] = __builtin_nontemporal_load(a0_ + 64 * j); Y1[j] = __builtin_nontemporal_load(a1_ + 64 * j); } }
    int r = r0; while (r < r1 && PL_SKIP(r)) ++r;
    if (r < r1) { PL_LOAD(hcr, y0c, y1c, r, bi); have = true; }
    while (have) {
        int rn = r + 1; while (rn < r1 && PL_SKIP(rn)) ++rn;
        int bnx = bi; const bool hn = rn < r1;
        if (hn) PL_LOAD(hnxt, y0n, y1n, rn, bnx);
        const float p0 = __shfl(mp0, r - r0), p1 = __shfl(mp1, r - r0);
        const float* mg = mod + (size_t)bi * (NMOD * D) + 5 * D;
        int bdummy; bf16* hp = (bf16*)hrow_ptr16(hl, hc, r, bdummy);
        float* op; { int b_, i_; row_split(r, b_, i_); bool cx_; op = outl + hrow_off(b_, i_, cx_); }
#pragma unroll
        for (int j = 0; j < 8; ++j) { const int c = (F.lane + 64 * j) * 4; const v2u u0 = y0c[j], u1 = y1c[j], hx = hcr[j];
            const f32x4 g = *(const f32x4*)(mg + c); f32x4 h = {bflo(hx.x), bfhi(hx.x), bflo(hx.y), bfhi(hx.y)};
            h[0] += g[0] * (p0 * bflo(u0.x) + p1 * bflo(u1.x)); h[1] += g[1] * (p0 * bfhi(u0.x) + p1 * bfhi(u1.x));
            h[2] += g[2] * (p0 * bflo(u0.y) + p1 * bflo(u1.y)); h[3] += g[3] * (p0 * bfhi(u0.y) + p1 * bfhi(u1.y));
            if constexpr (FUSE) { v2u w; w.x = cvt_pk(h[0], h[1]); w.y = cvt_pk(h[2], h[3]); *(v2u*)(hp + c) = w; } else *(f32x4*)(op + c) = h;
            hcur[j] = h; }
        if constexpr (FUSE) {
            if (bi != bgc) { bgc = bi; const float* mb = modn + (size_t)bi * (NMOD * D);
#pragma unroll
                for (int j = 0; j < 8; ++j) { const int c = (F.lane + 64 * j) * 4; Gc[j] = *(const f32x4*)(gn + c) * (*(const f32x4*)(mb + D + c) + 1.0f); Sc[j] = *(const f32x4*)(mb + c); } }
            float ss = 0.f;
#pragma unroll
            for (int j = 0; j < 8; ++j) ss += (hcur[j][0] * hcur[j][0] + hcur[j][1] * hcur[j][1]) + (hcur[j][2] * hcur[j][2] + hcur[j][3] * hcur[j][3]);
            ss = wave_sum(ss); const float rs = rsqrtf(ss * (1.0f / D) + EPS);
            v2u* o = (v2u*)(U + (size_t)r * D) + F.lane;
#pragma unroll
            for (int j = 0; j < 8; ++j) { const f32x4 y = hcur[j] * rs * Gc[j] + Sc[j]; v2u w; w.x = cvt_pk(y[0], y[1]); w.y = cvt_pk(y[2], y[3]); o[64 * j] = w;
                unsigned q8 = 0u; q8 = __builtin_amdgcn_cvt_pk_fp8_f32(y[0], y[1], q8, false); q8 = __builtin_amdgcn_cvt_pk_fp8_f32(y[2], y[3], q8, true); ((unsigned*)(U8 + (size_t)r * D))[F.lane + 64 * j] = q8; } }
#pragma unroll
        for (int j = 0; j < 8; ++j) { hcr[j] = hnxt[j]; y0c[j] = y0n[j]; y1c[j] = y1n[j]; }
        r = rn; bi = bnx; have = hn;
    }
#undef PL_LOAD
#undef PL_SKIP
}

constexpr int PH_PER_LAYER = 12, N_PHASES = 1 + 2 * PH_PER_LAYER;
#ifndef PHMASK
#define PHMASK 0xffffffffu
#endif
#define EN(j) ((PHMASK >> (j)) & 1u)
#define IN(k) (lo <= (k) && (k) < hi)
#ifndef TIMEPH
#define TIMEPH (-1)
#endif
struct Tm { int unused; };
#define TMW ((volatile LAS unsigned long long*)(F.ldsl + LDS_MISC_OFF + 16))
#define SEAM(k) do { if (IN(k) && IN((k) + 1)) xcd_barrier(bar); \
    if constexpr (TIMEPH >= 0) { if (__builtin_amdgcn_readfirstlane(threadIdx.x) == 0) { const unsigned long long now_ = __builtin_amdgcn_s_memrealtime(); if (((k) == 0 ? 0 : 1 + ((k) - 1) % PH_PER_LAYER) == TIMEPH) TMW[1] += now_ - TMW[0]; TMW[0] = now_; } } } while (0)
#ifndef REPMASK
#define REPMASK 0u
#endif
#define RUNPH(j, k, ...) if (EN(j) && IN(p + k)) { { __VA_ARGS__ } if constexpr (((REPMASK) >> (j)) & 1u) { __syncthreads(); { __VA_ARGS__ } } }
template <int l> __device__ __forceinline__ void layer_phases(Frame& F, const int lo, const int hi, const XcdBarrier& bar, Tm& tm) {
        constexpr int p = 1 + l * PH_PER_LAYER;
        constexpr int LAT = (l == 1);
        constexpr int NPAN = LAT ? 64 : 72;
        RUNPH(1, 0,  if (l == 0) pa_norm1(F, l); else conv_weights(F, l, CV_O_OUT, CV_O_W13, 0); )
        SEAM(p + 0);
        RUNPH(2, 1,
            { phase_ids(F); unsigned char* ws = F.ws;
              pg8::Gemm1Order S{pg8::make_gb((const bf16*)(ws + WS_ACT), D, (const bf16*)(ws + WS_WIN), D), F.G, (int)blockIdx.x, LAT, C_G / 256};
              const int ll = launder_s(l); const float* rc = (const float*)(ws + WS_ROPE);
              pg8::EpiProj E{(bf16*)(ws + WS_PROJ), INC, (const float*)(ws + WS_MISC + MISC_QKG) + ll * 512, rc, rc + 2048 * 64, (LAS float*)(F.ldsl + LDS_SSX_OFF)};
              pg8::gemm_phase(F.ldsl, D, D, D, S, E); }
            { phase_ids(F); unsigned char* ws = F.ws; KArgs a = kargs(); const int ll = launder_s(l);
              pg8::StaticOrder S{pg8::make_gb(ws + WS_U8, D, ws + WS_WING8, D, 1), NPAN, (INC - C_G) / 256, F.G, (int)blockIdx.x, LAT};
              pg8::EpiBf16T<true> E{(bf16*)(ws + WS_PROJ), INC, 0xffff, ain(a, I_BGATE) + (size_t)ll * 3 * D, C_G / 256, 1.0f / 64.0f}; pg8::gemm_phase<pg8::EpiBf16T<true>, pg8::StaticOrder, 1>(F.ldsl, D, D, D, S, E); }
            if (l == 0) { __syncthreads(); conv_weights(F, 0, CV_O_BR, CV_O_W13, (72 * 26) % F.G); __syncthreads(); conv_weights(F, 1, CV_O_W13, CV_O_W13 + 8192, (72 * 26) % F.G); } )
        SEAM(p + 1);
        if (EN(3) && IN(p + 2)) { pc_lru(F, l); if constexpr (((REPMASK) >> 3) & 1u) { __syncthreads(); pc_lru(F, l); } }
        SEAM(p + 2);
        RUNPH(4, 3,  pd_chain(F); pd_attn(F, l); )
        SEAM(p + 3);
        RUNPH(5, 4,  pe_combine(F, l); )
        SEAM(p + 4);
        RUNPH(6, 5,  phase_ids(F); unsigned char* ws = F.ws;
            pg8::BranchOrder S{ pg8::StaticOrder{pg8::make_gb((const bf16*)(ws + WS_YA), 1024, (const bf16*)(ws + WS_WBR), 1024), NPAN, D / 256, F.G, (int)blockIdx.x, LAT},
                                (size_t)(WS_YB - WS_YA) };
            static_assert(WS_YC - WS_YB == WS_YB - WS_YA, "branch inputs equally spaced");
            pg8::EpiChain E{(bf16*)(ws + WS_ACT), (const bf16*)(ws + WS_PROJ)}; pg8::gemm_phase(F.ldsl, 1024, 1024, 1024, S, E);
            if (l == 0) { __syncthreads(); conv_weights(F, 0, CV_O_W13, CV_O_W2, (72 * 8) % F.G); __syncthreads(); conv_weights(F, 1, CV_O_W13 + 10240, CV_NIT, (72 * 8) % F.G); } )
        SEAM(p + 5);
        RUNPH(7, 6,  phase_ids(F); unsigned char* ws = F.ws; KArgs a = kargs(); const int ll = launder_s(l);
            pg8::StaticOrder S{pg8::make_gb((const bf16*)(ws + WS_ACT), D, (const bf16*)(ws + WS_WOUT), D), NPAN, D / 256, F.G, (int)blockIdx.x, LAT};
            pg8::EpiWout<l != 0> E{l == 0 ? (const void*)ain(a, I_X) : (const void*)(ws + WS_H16L), l == 0 ? (const void*)ain(a, I_CTX) : (const void*)(ws + WS_HC), (bf16*)(ws + WS_H16L), (bf16*)(ws + WS_HC), (const float*)(ws + WS_MOD) + (size_t)ll * 9 * (NMOD * D)};
            pg8::gemm_phase(F.ldsl, D, D, D, S, E);
            if (l == 0) { __syncthreads(); conv_weights(F, 0, CV_O_W2, CV_NIT, (72 * 8) % F.G); __syncthreads(); conv_weights(F, 1, 0, CV_O_OUT, (72 * 8) % F.G); __syncthreads(); conv_weights(F, 1, CV_O_W13 + 8192, CV_O_W13 + 10240, (72 * 8) % F.G); } )
        SEAM(p + 6);
        RUNPH(8, 7,  ph_norm2_route(F, l); )
        SEAM(p + 7);
        RUNPH(10, 9,  phase_ids(F); unsigned char* ws = F.ws; const LAS int* tab = moe_tables(F, l);
            pg8::MoeOrderG S{pg8::make_gb(ws + WS_V8, D, ws + (l ? WS_W13B : WS_W13), D, 1), tab, (const int*)(ws + WS_BIG), (unsigned)D, 4, F.G, (int)blockIdx.x};
            pg8::EpiUp E{(bf16*)(ws + WS_OA), 1.0f / 64.0f}; pg8::gemm_phase<pg8::EpiUp, pg8::MoeOrderG, 1>(F.ldsl, D, D, D, S, E); )
        SEAM(p + 9);
        RUNPH(11, 10,  phase_ids(F); unsigned char* ws = F.ws; const LAS int* tab = moe_tables(F, l);
            pg8::MoeOrder S{pg8::make_gb((const bf16*)(ws + WS_OA), DE, (const bf16*)(ws + (l ? WS_W2B : WS_W2)), DE), tab, nullptr, 0u, 8, F.G, (int)blockIdx.x};
            pg8::EpiBf16 E{(bf16*)(ws + WS_BIG), D, 7, nullptr, 0, 1.0f}; pg8::gemm_phase(F.ldsl, DE, DE, DE, S, E); )
        SEAM(p + 10);
        RUNPH(12, 11,  pl_moe_combine<l == 0>(F, l); )
        if (l != 0) SEAM(p + 11);
}
__global__ void __launch_bounds__(512, 2) mega_fwd(Args args) {
    extern __shared__ __attribute__((aligned(16))) unsigned char lds[];
    Frame F;
    F.lds0 = lds; F.lds = lds; F.ldsl = (LAS unsigned char*)lds; F.ws = args.ws;
    F.tid = threadIdx.x; F.lane = F.tid & 63; F.wave = __builtin_amdgcn_readfirstlane(F.tid >> 6);
    F.G = gridDim.x; F.gw = blockIdx.x * 8 + F.wave; F.NGW = F.G * 8;
    volatile LAS unsigned* misc = (volatile LAS unsigned*)(F.ldsl + LDS_MISC_OFF);
    if (F.tid < 4) misc[F.tid] = 0u;
    __syncthreads();
    const int lo = args.ph_lo, hi = args.ph_hi;
    XcdBarrier bar; bar.bar = (unsigned*)(args.ws + WS_CTL) + CW_BAR; bar.x = 0; bar.st = misc;
    if (hi - lo > 1) bar = xcd_barrier_post((unsigned*)(args.ws + WS_CTL) + CW_BAR, misc);
    Tm tm; tm.unused = 0; if constexpr (TIMEPH >= 0) { if (__builtin_amdgcn_readfirstlane(threadIdx.x) == 0) { TMW[0] = __builtin_amdgcn_s_memrealtime(); TMW[1] = 0ull; } }
    if (EN(0) && IN(0)) { p0_misc(F); __syncthreads(); conv_weights(F, 0, 0, CV_O_BR, 0); }
    SEAM(0);
    layer_phases<0>(F, lo, hi, bar, tm);
    layer_phases<1>(F, lo, hi, bar, tm);
    if constexpr (TIMEPH >= 0) { xcd_barrier(bar); if (blockIdx.x == 0 && threadIdx.x == 0) args.out[0] = (float)TMW[1]; }
#undef IN
#undef SEAM
}

#ifndef MK_SINGLE
#define MK_SINGLE 1
#endif
extern "C" void kernel_launch(void* const* d_in, const int* in_sizes, int n_in, void* d_out, int out_size, void* d_ws, size_t ws_size, hipStream_t stream) {
    static int grid = 0;
    if (grid == 0) {
        if (n_in != 34 || out_size != NB * SEQ * D || ws_size < WS_END) { fprintf(stderr, "kernel_launch: unexpected shapes (n_in %d out %d ws %zu, need ws >= %zu)\n", n_in, out_size, ws_size, (size_t)WS_END); grid = -1; return; }
        int dev = 0, cus = 0, per_cu = 0;
        if (hipGetDevice(&dev) != hipSuccess || hipDeviceGetAttribute(&cus, hipDeviceAttributeMultiprocessorCount, dev) != hipSuccess) { grid = -1; return; }
        if (hipFuncSetAttribute((const void*)mega_fwd, hipFuncAttributeMaxDynamicSharedMemorySize, LDS_BYTES) != hipSuccess) { fprintf(stderr, "kernel_launch: hipFuncSetAttribute failed\n"); grid = -1; return; }
        if (hipOccupancyMaxActiveBlocksPerMultiprocessor(&per_cu, (const void*)mega_fwd, 512, LDS_BYTES) != hipSuccess || per_cu < 1) fprintf(stderr, "kernel_launch: occupancy query says %d\n", per_cu);
        (void)hipGetLastError();
        grid = cus;
    }
    if (grid < 0) return;
    (void)hipMemsetAsync((char*)d_ws + WS_CTL, 0, CTL_ZERO_BYTES, stream);
    Args a{};
    for (int i = 0; i < 34; ++i) a.in[i] = (const float*)d_in[i];
    a.out = (float*)d_out; a.ws = (unsigned char*)d_ws;
#if MK_SINGLE
    a.ph_lo = 0; a.ph_hi = N_PHASES;
    hipLaunchKernelGGL(mega_fwd, dim3(grid), dim3(512), LDS_BYTES, stream, a);
#else
    for (int p = 0; p < N_PHASES; ++p) { a.ph_lo = p; a.ph_hi = p + 1; hipLaunchKernelGGL(mega_fwd, dim3(grid), dim3(512), LDS_BYTES, stream, a); }
#endif
    const hipError_t le = hipPeekAtLastError();
    if (le != hipSuccess) fprintf(stderr, "kernel_launch: launch failed: %s\n", hipGetErrorName(le));
}
```

```cpp
#include <hip/hip_runtime.h>
#include <cstdio>
#include <cstdint>

#define GAS __attribute__((address_space(1)))
#define LAS __attribute__((address_space(3)))
typedef unsigned short bf16;
typedef unsigned v4u __attribute__((ext_vector_type(4)));
typedef unsigned v2u __attribute__((ext_vector_type(2)));
typedef float f32x4 __attribute__((ext_vector_type(4)));
typedef float f32x2 __attribute__((ext_vector_type(2)));
typedef short bf16x8 __attribute__((ext_vector_type(8)));
#define LDS_WAIT() asm volatile("s_waitcnt lgkmcnt(0)" ::: "memory")
#define VM_WAIT() asm volatile("s_waitcnt vmcnt(0)" ::: "memory")

constexpr int D = 2048, NB = 8, SEQ = 2048, CTXL = 256, TB = SEQ + CTXL, ROWS = NB * TB;
constexpr int INC = 12800;
constexpr int C_AQ = 0, C_AK = 1024, C_AV = 2048, C_BX = 3072, C_BY = 4096, C_CQ = 5120, C_CK = 6144, C_CV = 6400, C_G = 6656;
constexpr int NE = 32, DE = 512, NMOD = 6;
constexpr int MS = 45056;
constexpr int NCH = TB / 32;
constexpr float EPS = 1e-6f;

constexpr size_t MiB = 1u << 20;
constexpr size_t WS_CTL = 0, CTL_ZERO_BYTES = 1 * MiB;
constexpr size_t WS_MOD = 1 * MiB;
constexpr size_t WS_ROPE = 2 * MiB;
constexpr size_t WS_MISC = 3 * MiB;
constexpr size_t WS_LRUW = 4 * MiB;
constexpr size_t WS_ROUTE = 6 * MiB;
constexpr size_t WS_CARRY = 8 * MiB;
constexpr size_t WS_WIN = 24 * MiB;
constexpr size_t WS_WBR = 74 * MiB;
constexpr size_t WS_WOUT = 86 * MiB;
constexpr size_t WS_W13 = 94 * MiB;
constexpr size_t WS_W2 = 222 * MiB;
constexpr size_t WS_HC = 286 * MiB;
constexpr size_t WS_H16L = 158 * MiB;
constexpr size_t WS_ACT = 302 * MiB;
constexpr size_t WS_PROJ = 374 * MiB;
constexpr size_t WS_BIG = 824 * MiB;
constexpr size_t WS_OA = 1000 * MiB;
constexpr size_t WS_YA = 1072 * MiB;
constexpr size_t WS_YB = 1108 * MiB;
constexpr size_t WS_YC = 1144 * MiB;
constexpr size_t WS_WING8 = WS_WIN + (size_t)C_G * D * 2;
constexpr size_t WS_V8 = WS_YA;
constexpr size_t WS_U8 = WS_OA;
constexpr size_t WS_W13B = 1185 * MiB;
constexpr size_t WS_W2B = 1313 * MiB;
constexpr size_t WS_END = 1377 * MiB;
constexpr int CW_BAR = 4096;
constexpr int CW_CNT = 8192;
constexpr size_t MISC_LAM = 0;
constexpr size_t MISC_TILE = 1024;
constexpr size_t MISC_WR = 4096;
constexpr size_t MISC_QKG = 1000 * 1024;
constexpr size_t MISC_SP = 960 * 1024;
constexpr size_t RT_E = 0, RT_POS = 256 * 1024, RT_P = 512 * 1024, RT_DEST = 768 * 1024;
constexpr size_t CARRY_N = (size_t)2 * NB * NCH * 1024;
constexpr int LDS_BYTES = 147456;
constexpr int LDS_MISC_OFF = 135168;
constexpr int LDS_SSX_OFF = 139264;

__device__ __forceinline__ float bf2f(unsigned short b) { return __uint_as_float(((unsigned)b) << 16); }
__device__ __forceinline__ float bflo(unsigned u) { return __uint_as_float(u << 16); }
__device__ __forceinline__ float bfhi(unsigned u) { return __uint_as_float(u & 0xffff0000u); }
typedef __bf16 bf16x2_t_ __attribute__((ext_vector_type(2))); typedef float f32x2_t_ __attribute__((ext_vector_type(2)));
__device__ __forceinline__ unsigned cvt_pk(float lo, float hi) { const f32x2_t_ v = {lo, hi}; return __builtin_bit_cast(unsigned, __builtin_convertvector(v, bf16x2_t_)); }
__device__ __forceinline__ float sigmoidf_(float x) { return __builtin_amdgcn_rcpf(1.0f + __expf(-x)); }
template <int CTRL> __device__ __forceinline__ float dpp_f(float oldv, float src) {
    return __builtin_bit_cast(float, __builtin_amdgcn_update_dpp(__builtin_bit_cast(int, oldv), __builtin_bit_cast(int, src), CTRL, 0xf, 0xf, false));
}

__device__ __forceinline__ float row16_sum(float v) {
    v += dpp_f<0xB1>(0.f, v); v += dpp_f<0x4E>(0.f, v); v += dpp_f<0x141>(0.f, v); v += dpp_f<0x140>(0.f, v); return v;
}
__device__ __forceinline__ float wave_sum(float v) {
    v = row16_sum(v); v += __shfl_xor(v, 16);
    { auto rr = __builtin_amdgcn_permlane32_swap(__float_as_uint(v), __float_as_uint(v), false, false); v = __uint_as_float(rr[0]) + __uint_as_float(rr[1]); }
    return v;
}
namespace pg8 {
constexpr int BM = 256, BK = 64, HALF = 128, HTB = HALF * BK * 2, STAGE_BYTES = 8 * HTB, NXCD = 8, WGM = 8;
__host__ __device__ __forceinline__ int lds_byte(int r, int c) { const int st = (r >> 4) * 2 + (c >> 5), rr = r & 15, cc = c & 31, ob = rr * 64 + cc * 2; return st * 1024 + (ob ^ (((ob >> 9) & 1) << 5)); }
__host__ __device__ __forceinline__ void stage_rc(int b, int& R, int& C) { const int st = b / 1024, sb = b % 1024, swz = sb ^ (((sb >> 9) & 1) << 5); R = (st >> 1) * 16 + swz / 64; C = (st & 1) * 32 + (swz % 64) / 2; }
__host__ __device__ __forceinline__ int perm32(int rho) { const int n = rho >> 4, i = rho & 15; return 8 * (i >> 2) + 4 * n + (i & 3); }
typedef int v4i_ __attribute__((ext_vector_type(4))); typedef int v8i_ __attribute__((ext_vector_type(8)));
struct Unit { int pm, pn, fl; };
struct GB { const char* A; const char* B; size_t tA, tB; };
__device__ __forceinline__ GB make_gb(const void* A, int lda, const void* B, int ldb, int es = 2) { GB g; g.A = (const char*)A; g.B = (const char*)B; g.tA = (size_t)BM * lda * es; g.tB = (size_t)BM * ldb * es; return g; }
__device__ __forceinline__ void static_tile(int nM, int nN, int L, int& pm, int& pn) {
    const int nwg = nM * nN; int wgid = L; { const int q = nwg / NXCD, r = nwg % NXCD, xcd = wgid % NXCD, off = wgid / NXCD; wgid = (xcd < r ? xcd * (q + 1) : r * (q + 1) + (xcd - r) * q) + off; }
    const int nig = WGM * nN, gid = wgid / nig, fm = gid * WGM, gsz = (nM - fm) < WGM ? (nM - fm) : WGM;
    pm = fm + ((wgid % nig) % gsz); pn = (wgid % nig) / gsz;
}
__device__ __forceinline__ int lat_panel(int pl) { return (pl >> 3) * 9 + 1 + (pl & 7); }
struct StaticOrder {
    static constexpr bool GATHER = false; __device__ __forceinline__ unsigned rowoff(const Unit&, int) const { return 0u; }
    GB gb; int nM, nN, G, c, lat;
    __device__ __forceinline__ bool next(int i, Unit& u) const {
        const long L = (long)i * G + c; if (L >= (long)nM * nN) return false;
        int pm, pn; static_tile(nM, nN, (int)L, pm, pn); u.pm = lat ? lat_panel(pm) : pm; u.pn = pn; u.fl = 0; return true;
    }
    __device__ __forceinline__ const char* a_base(const Unit& u) const { return gb.A + (size_t)u.pm * gb.tA; }
    __device__ __forceinline__ const char* b_base(const Unit& u) const { return gb.B + (size_t)u.pn * gb.tB; }
    __device__ __forceinline__ bool zero_after(const Unit&) const { return true; }
};
struct Gemm1Order {
    static constexpr bool GATHER = false; __device__ __forceinline__ unsigned rowoff(const Unit&, int) const { return 0u; }
    GB gb; int G, c, l1, nN;
    __device__ __forceinline__ bool next(int i, Unit& u) const {
        const long L = (long)i * G + c; int pm, pn; u.fl = 0;
        if (!l1) { if (L >= 72 * nN) return false; static_tile(72, nN, (int)L, pm, pn); }
        else if (L < 64 * nN) { static_tile(64, nN, (int)L, pm, pn); pm = lat_panel(pm); }
        else { const int q = (int)L - 64 * nN; if (q >= 8 * 14) return false; const int k = q % 14; pm = (q / 14) * 9; pn = k < 12 ? 4 + k : 12 + k; }
        u.pm = pm; u.pn = pn; return true;
    }
    __device__ __forceinline__ const char* a_base(const Unit& u) const { return gb.A + (size_t)u.pm * gb.tA; }
    __device__ __forceinline__ const char* b_base(const Unit& u) const { return gb.B + (size_t)u.pn * gb.tB; }
    __device__ __forceinline__ bool zero_after(const Unit&) const { return true; }
};
struct BranchOrder {
    static constexpr bool GATHER = false; __device__ __forceinline__ unsigned rowoff(const Unit&, int) const { return 0u; }
    StaticOrder so; size_t astride;
    __device__ __forceinline__ bool next(int i, Unit& u) const { if (!so.next(i / 3, u)) return false; u.fl = i % 3; return true; }
    __device__ __forceinline__ const char* a_base(const Unit& u) const { return so.gb.A + (size_t)u.fl * astride + (size_t)u.pm * so.gb.tA; }
    __device__ __forceinline__ const char* b_base(const Unit& u) const { return so.gb.B + (size_t)u.fl * ((size_t)D * 1024 * 2) + (size_t)u.pn * so.gb.tB; }
    __device__ __forceinline__ bool zero_after(const Unit& u) const { return u.fl == 2; }
};
constexpr int MT_E = 1, MT_P0 = 193, MT_CNT = 385, MT_BASE = 417, MT_WORDS = 452, LCAP = 2 * ROWS;
template <bool G_> struct MoeOrderT {
    static constexpr bool GATHER = G_;
    GB gb; const LAS int* tab; const int* list; unsigned rowbytes; int NT, G, c;
    __device__ __forceinline__ bool next(int i, Unit& u) const {
        const long L0 = (long)i * G + c; const int nwg = tab[0] * NT; if (L0 >= nwg) return false;
        int L = (int)L0; { const int q = nwg / NXCD, r = nwg % NXCD, xcd = L % NXCD, off = L / NXCD; L = (xcd < r ? xcd * (q + 1) : r * (q + 1) + (xcd - r) * q) + off; }
        const int mt = L / NT, pnl = L % NT;
        u.pm = mt; u.pn = tab[MT_E + mt] * NT + pnl; u.fl = 0; return true;
    }
    __device__ __forceinline__ const char* a_base(const Unit& u) const { return gb.A + (size_t)u.pm * gb.tA; }
    __device__ __forceinline__ const char* b_base(const Unit& u) const { return gb.B + (size_t)u.pn * gb.tB; }
    __device__ __forceinline__ bool zero_after(const Unit&) const { return true; }
    __device__ __forceinline__ unsigned rowoff(const Unit& u, int row) const {
        const int e = tab[MT_E + u.pm], pos = tab[MT_P0 + u.pm] + row; const int ent = pos < tab[MT_CNT + e] ? list[(size_t)e * LCAP + pos] : 0;
        return (unsigned)(ent >> 1) * rowbytes;
    }
};
typedef MoeOrderT<false> MoeOrder;
typedef MoeOrderT<true> MoeOrderG;
template <bool GATE> struct EpiBf16T {
    static constexpr bool PERM = true;
    bf16* O; int ldc; int pn_mask; const float* bgate; int pn_add; float sc;
    __device__ __forceinline__ void operator()(f32x4 (&acc)[2][2][4][2], const Unit& u, int wr, int wc, int fr, int fq) const {
        const int pnc = (u.pn & pn_mask) + pn_add; const int row0 = u.pm * BM + wr * 64 + fr; const int col0 = pnc * BM + wc * 32 + 8 * fq;
        const bool gate = GATE && (pnc >= C_G / BM);
        f32x4 bg[2][2];
        if (gate) {
#pragma unroll
            for (int bj = 0; bj < 2; ++bj) { bg[bj][0] = *(const f32x4*)(bgate + (col0 - C_G) + bj * HALF); bg[bj][1] = *(const f32x4*)(bgate + (col0 - C_G) + bj * HALF + 4); } }
#pragma unroll
        for (int ai = 0; ai < 2; ++ai)
#pragma unroll
            for (int m = 0; m < 4; ++m) { bf16* rowp = O + (size_t)(row0 + ai * HALF + m * 16) * ldc + col0;
#pragma unroll
                for (int bj = 0; bj < 2; ++bj) { f32x4 v0 = acc[ai][bj][m][0] * sc, v1 = acc[ai][bj][m][1] * sc;
                    if (gate) {
#pragma unroll
                        for (int e = 0; e < 4; ++e) { v0[e] = sigmoidf_(v0[e] + bg[bj][0][e]); v1[e] = sigmoidf_(v1[e] + bg[bj][1][e]); } }
                    v4u w; w.x = cvt_pk(v0[0], v0[1]); w.y = cvt_pk(v0[2], v0[3]); w.z = cvt_pk(v1[0], v1[1]); w.w = cvt_pk(v1[2], v1[3]);
                    *(v4u*)(rowp + bj * HALF) = w; } }
    }
};
typedef EpiBf16T<false> EpiBf16;
struct EpiProj {
    static constexpr bool PERM = true;
    bf16* O; int ldc; const float* qkg; const float* rc; const float* rs; LAS float* ssx;
    __device__ __forceinline__ void operator()(f32x4 (&acc)[2][2][4][2], const Unit& u, int wr, int wc, int fr, int fq) const {
        const int pn = u.pn; const bool qk = pn < 8 || (pn >= 20 && pn <= 24);
        const int row0 = u.pm * BM + wr * 64 + fr;
        if (!qk) { const int col0 = pn * BM + wc * 32 + 8 * fq;
#pragma unroll
            for (int ai = 0; ai < 2; ++ai)
#pragma unroll
                for (int m = 0; m < 4; ++m) { bf16* rowp = O + (size_t)(row0 + ai * HALF + m * 16) * ldc + col0;
#pragma unroll
                    for (int bj = 0; bj < 2; ++bj) { const f32x4 v0 = acc[ai][bj][m][0], v1 = acc[ai][bj][m][1];
                        v4u w; w.x = cvt_pk(v0[0], v0[1]); w.y = cvt_pk(v0[2], v0[3]); w.z = cvt_pk(v1[0], v1[1]); w.w = cvt_pk(v1[2], v1[3]);
                        *(v4u*)(rowp + bj * HALF) = w; } }
            return; }
        const float* gvec = qkg + (pn < 4 ? 0 : (pn < 8 ? 128 : (pn < 24 ? 256 : 384)));
        const int g = 4 * wc + fq, base = (g < 8 ? 0 : 64) + 4 * (g & 7);
        const f32x4 ga = *(const f32x4*)(gvec + base), gb = *(const f32x4*)(gvec + base + 32);
#pragma unroll
        for (int ai = 0; ai < 2; ++ai)
#pragma unroll
            for (int m = 0; m < 4; ++m)
#pragma unroll
                for (int bj = 0; bj < 2; ++bj) { const f32x4 x0 = acc[ai][bj][m][0], x1 = acc[ai][bj][m][1];
                    float sq = (x0[0] * x0[0] + x0[1] * x0[1]) + (x0[2] * x0[2] + x0[3] * x0[3]) + (x1[0] * x1[0] + x1[1] * x1[1]) + (x1[2] * x1[2] + x1[3] * x1[3]);
                    sq += __shfl_xor(sq, 16); sq += __shfl_xor(sq, 32);
                    if (fq == 0) ssx[((ai * HALF + wr * 64 + m * 16 + fr) * 2 + bj) * 4 + wc] = sq; }
        asm volatile("s_waitcnt lgkmcnt(0)" ::: "memory"); __builtin_amdgcn_s_barrier(); asm volatile("" ::: "memory");
        const int pj = u.pm % 9; const bool lat = pj != 0; const int t0 = (pj - 1) * 256;
#pragma unroll
        for (int ai = 0; ai < 2; ++ai)
#pragma unroll
            for (int m = 0; m < 4; ++m) { const int rowl = ai * HALF + wr * 64 + m * 16 + fr;
                f32x4 cs = {1.f, 1.f, 1.f, 1.f}, sn = {0.f, 0.f, 0.f, 0.f};
                if (lat) { const int ti = (t0 + rowl) * 64 + (g < 8 ? 0 : 32) + 4 * (g & 7); cs = *(const f32x4*)(rc + ti); sn = *(const f32x4*)(rs + ti); }
                bf16* rowp = O + (size_t)(u.pm * BM + rowl) * ldc + pn * BM + 8 * g;
#pragma unroll
                for (int bj = 0; bj < 2; ++bj) { const f32x4 pp = *(const LAS f32x4*)(ssx + (rowl * 2 + bj) * 4);
                    const float rn = rsqrtf(((pp[0] + pp[1]) + (pp[2] + pp[3])) * (1.0f / 128.0f) + EPS);
                    const f32x4 y0 = acc[ai][bj][m][0] * rn * ga, y1 = acc[ai][bj][m][1] * rn * gb;
                    const f32x4 o0 = y0 * cs - y1 * sn, o1 = y1 * cs + y0 * sn;
                    v4u w; w.x = cvt_pk(o0[0], o0[1]); w.y = cvt_pk(o0[2], o0[3]); w.z = cvt_pk(o1[0], o1[1]); w.w = cvt_pk(o1[2], o1[3]);
                    *(v4u*)(rowp + bj * HALF) = w; } }
    }
};
struct EpiChain {
    static constexpr bool PERM = true;
    bf16* Mb; const bf16* proj;
    __device__ __forceinline__ void operator()(f32x4 (&acc)[2][2][4][2], const Unit& u, int wr, int wc, int fr, int fq) const {
        const int row0 = u.pm * BM + wr * 64 + fr, col0 = u.pn * BM + wc * 32 + 8 * fq; const int br = u.fl;
        const bf16* gp = proj + C_G + br * D + col0;
        v4u ga[2][2], gb[2][2];
#define EC_LOAD(buf, g_) do { const size_t row_ = (size_t)(row0 + ((g_) >> 2) * HALF + ((g_) & 3) * 16); _Pragma("unroll") for (int bj = 0; bj < 2; ++bj) { \
            ga[buf][bj] = *(const v4u*)(gp + row_ * INC + bj * HALF); if (br < 2) gb[buf][bj] = *(const v4u*)(gp + row_ * INC + D + bj * HALF); } } while (0)
        EC_LOAD(0, 0);
#pragma unroll
        for (int g8 = 0; g8 < 8; ++g8) { const int ai = g8 >> 2, m = g8 & 3, cb = g8 & 1; const size_t row = (size_t)(row0 + ai * HALF + m * 16);
            if (g8 < 7) EC_LOAD(cb ^ 1, g8 + 1);
            asm volatile("" ::: "memory");
#pragma unroll
            for (int bj = 0; bj < 2; ++bj) { const v4u a = ga[cb][bj];
                f32x4 g0 = {bflo(a.x), bfhi(a.x), bflo(a.y), bfhi(a.y)}, g1 = {bflo(a.z), bfhi(a.z), bflo(a.w), bfhi(a.w)};
                if (br < 2) { const v4u b = gb[cb][bj];
                    g0[0] *= __builtin_amdgcn_rcpf(bflo(b.x)); g0[1] *= __builtin_amdgcn_rcpf(bfhi(b.x)); g0[2] *= __builtin_amdgcn_rcpf(bflo(b.y)); g0[3] *= __builtin_amdgcn_rcpf(bfhi(b.y));
                    g1[0] *= __builtin_amdgcn_rcpf(bflo(b.z)); g1[1] *= __builtin_amdgcn_rcpf(bfhi(b.z)); g1[2] *= __builtin_amdgcn_rcpf(bflo(b.w)); g1[3] *= __builtin_amdgcn_rcpf(bfhi(b.w));
                    acc[ai][bj][m][0] *= g0; acc[ai][bj][m][1] *= g1; }
                else { const f32x4 v0 = acc[ai][bj][m][0] * g0, v1 = acc[ai][bj][m][1] * g1; v4u w; w.x = cvt_pk(v0[0], v0[1]); w.y = cvt_pk(v0[2], v0[3]); w.z = cvt_pk(v1[0], v1[1]); w.w = cvt_pk(v1[2], v1[3]);
                    *(v4u*)(Mb + row * D + col0 + bj * HALF) = w; } }
        }
#undef EC_LOAD
    }
};
template <bool BB> struct EpiWout {
    static constexpr bool PERM = true;
    const void* base_lat; const void* base_ctx; bf16* out_lat; bf16* out_ctx; const float* modl;
    __device__ __forceinline__ void operator()(f32x4 (&acc)[2][2][4][2], const Unit& u, int wr, int wc, int fr, int fq) const {
        const int b = u.pm / 9, j = u.pm % 9; const bool ctx = (j == 0);
        const size_t r0 = ctx ? (size_t)b * CTXL : (size_t)b * SEQ + (size_t)(j - 1) * 256;
        const char* bp = (const char*)(ctx ? base_ctx : base_lat) + r0 * D * (BB ? 2 : 4); bf16* op = (ctx ? out_ctx : out_lat) + r0 * D;
        const float* mg = modl + (size_t)(ctx ? 8 : b) * (NMOD * D) + 2 * D;
        const int rl0 = wr * 64 + fr, col0 = u.pn * BM + wc * 32 + 8 * fq;
        f32x4 gq[2][2], bs[2][2][2]; v4u bb[2][2];
#pragma unroll
        for (int bj = 0; bj < 2; ++bj)
#pragma unroll
            for (int hf = 0; hf < 2; ++hf) gq[bj][hf] = *(const f32x4*)(mg + col0 + bj * HALF + 4 * hf);
#define EW_LOAD(buf, g_) do { const size_t ro_ = (size_t)(rl0 + ((g_) >> 2) * HALF + ((g_) & 3) * 16) * D + col0; _Pragma("unroll") for (int bj = 0; bj < 2; ++bj) { \
            if constexpr (BB) bb[buf][bj] = *(const v4u*)(bp + (ro_ + bj * HALF) * 2); \
            else { bs[buf][bj][0] = *(const f32x4*)(bp + (ro_ + bj * HALF) * 4); bs[buf][bj][1] = *(const f32x4*)(bp + (ro_ + bj * HALF) * 4 + 16); } } } while (0)
        EW_LOAD(0, 0);
#pragma unroll
        for (int g8 = 0; g8 < 8; ++g8) { const int ai = g8 >> 2, m = g8 & 3, cb = g8 & 1; const size_t ro = (size_t)(rl0 + ai * HALF + m * 16) * D + col0;
            if (g8 < 7) EW_LOAD(cb ^ 1, g8 + 1);
            asm volatile("" ::: "memory");
#pragma unroll
            for (int bj = 0; bj < 2; ++bj) { f32x4 b0, b1;
                if constexpr (BB) { const v4u x = bb[cb][bj]; b0 = (f32x4){bflo(x.x), bfhi(x.x), bflo(x.y), bfhi(x.y)}; b1 = (f32x4){bflo(x.z), bfhi(x.z), bflo(x.w), bfhi(x.w)}; }
                else { b0 = bs[cb][bj][0]; b1 = bs[cb][bj][1]; }
                const f32x4 y0 = b0 + gq[bj][0] * acc[ai][bj][m][0], y1 = b1 + gq[bj][1] * acc[ai][bj][m][1];
                v4u w; w.x = cvt_pk(y0[0], y0[1]); w.y = cvt_pk(y0[2], y0[3]); w.z = cvt_pk(y1[0], y1[1]); w.w = cvt_pk(y1[2], y1[3]); *(v4u*)(op + ro + bj * HALF) = w; }
        }
#undef EW_LOAD
    }
};
struct EpiUp {
    static constexpr bool PERM = true;
    bf16* HB; float sc;
    __device__ __forceinline__ void operator()(f32x4 (&acc)[2][2][4][2], const Unit& u, int wr, int wc, int fr, int fq) const {
        const int row0 = u.pm * BM + wr * 64 + fr; const int col0 = (u.pn & 3) * HALF + wc * 32 + 8 * fq;
#pragma unroll
        for (int ai = 0; ai < 2; ++ai)
#pragma unroll
            for (int m = 0; m < 4; ++m) { bf16* rowp = HB + (size_t)(row0 + ai * HALF + m * 16) * DE + col0;
                f32x4 h0, h1;
#pragma unroll
                for (int e = 0; e < 4; ++e) { const float a0 = acc[ai][0][m][0][e] * sc, a1 = acc[ai][0][m][1][e] * sc;
                    h0[e] = a0 * sigmoidf_(a0) * (acc[ai][1][m][0][e] * sc); h1[e] = a1 * sigmoidf_(a1) * (acc[ai][1][m][1][e] * sc); }
                v4u w; w.x = cvt_pk(h0[0], h0[1]); w.y = cvt_pk(h0[2], h0[3]); w.z = cvt_pk(h1[0], h1[1]); w.w = cvt_pk(h1[2], h1[3]);
                *(v4u*)rowp = w; }
    }
};

template <class Epi, class Sched, int ES = 2>
__device__ __forceinline__ void gemm_phase(LAS unsigned char* lds, const int lda, const int ldb, const int K, const Sched& S, const Epi& E) {
    constexpr bool ALIGN_EPI = true;
    int tid_ = threadIdx.x; asm volatile("" : "+v"(tid_));
    const int tid = tid_, wid = __builtin_amdgcn_readfirstlane(tid >> 6), lane = tid & 63, wr = wid >> 2, wc = wid & 3, fr = lane & 15, fq = lane >> 4;
    const int nt = K * ES / (BK * 2);
    constexpr bool GATH = Sched::GATHER;
    unsigned voffA[2], voffB[2]; int gR[2]; unsigned gC[2];
    unsigned vc[2][2], vn[2][2];
#pragma unroll
    for (int i = 0; i < 2; ++i) { int R, C; stage_rc(tid * 16 + i * 8192, R, C); const int Rb = Epi::PERM ? ((R & ~31) + perm32(R & 31)) : R;
        voffA[i] = (unsigned)(R * lda * ES + C * 2); voffB[i] = (unsigned)(Rb * ldb * ES + C * 2); gR[i] = R; gC[i] = (unsigned)C * 2u; }
    const size_t kstep = (size_t)(BK * 2);
    const size_t hstepA = (size_t)HALF * lda * ES, hstepB = (size_t)HALF * ldb * ES;
    const unsigned ldsw = (unsigned)wid * 1024u;
    const int aoff = lds_byte(wr * 64 + fr, fq * 8), boff = lds_byte(wc * 32 + fr, fq * 8);
#define PG8_SA(b, h) (((b) * 2 + (h)) * HTB)
#define PG8_SB(b, h) ((4 + (b) * 2 + (h)) * HTB)
#define PG8_STAGE(bufoff, gbase, voff) do { _Pragma("unroll") for (int _i = 0; _i < 2; ++_i) \
        __builtin_amdgcn_global_load_lds((const unsigned*)((const char*)(gbase) + (voff)[_i]), (LAS unsigned*)(lds + (bufoff) + ldsw + _i * 8192), 16, 0, 0); } while (0)
#define PG8_STAGE_A(bufoff, ptr, h, kb) do { if constexpr (GATH) { _Pragma("unroll") for (int _i = 0; _i < 2; ++_i) \
        __builtin_amdgcn_global_load_lds((const unsigned*)(S.gb.A + (size_t)(kb) + vc[h][_i]), (LAS unsigned*)(lds + (bufoff) + ldsw + _i * 8192), 16, 0, 0); } else PG8_STAGE(bufoff, ptr, voffA); } while (0)
#define PG8_ROWOFFS(dst, u) do { _Pragma("unroll") for (int _h = 0; _h < 2; ++_h) _Pragma("unroll") for (int _i = 0; _i < 2; ++_i) dst[_h][_i] = S.rowoff(u, _h * HALF + gR[_i]) + gC[_i]; } while (0)
#define PG8_LD16(off) (*(const LAS v4i_*)(lds + (off)))
#define PG8_LDA(dst, b, h) do { _Pragma("unroll") for (int m = 0; m < 4; ++m) { if constexpr (ES == 2) { _Pragma("unroll") for (int k = 0; k < 2; ++k) dst[m][k] = *(const LAS bf16x8*)(lds + PG8_SA(b, h) + aoff + m * 2048 + k * 1024); } \
        else dst##8[m] = __builtin_shufflevector(PG8_LD16(PG8_SA(b, h) + aoff + m * 2048), PG8_LD16(PG8_SA(b, h) + aoff + m * 2048 + 1024), 0, 1, 2, 3, 4, 5, 6, 7); } } while (0)
#define PG8_LDB(dst, b, h) do { _Pragma("unroll") for (int n = 0; n < 2; ++n) { if constexpr (ES == 2) { _Pragma("unroll") for (int k = 0; k < 2; ++k) dst[n][k] = *(const LAS bf16x8*)(lds + PG8_SB(b, h) + boff + n * 2048 + k * 1024); } \
        else dst##8[n] = __builtin_shufflevector(PG8_LD16(PG8_SB(b, h) + boff + n * 2048), PG8_LD16(PG8_SB(b, h) + boff + n * 2048 + 1024), 0, 1, 2, 3, 4, 5, 6, 7); } } while (0)
#define PG8_MMA(ai, bj, At, Bt) do { __builtin_amdgcn_s_setprio(1); if constexpr (ES == 2) { _Pragma("unroll") for (int m = 0; m < 4; ++m) _Pragma("unroll") for (int n = 0; n < 2; ++n) _Pragma("unroll") for (int k = 0; k < 2; ++k) \
        acc[ai][bj][m][n] = __builtin_amdgcn_mfma_f32_16x16x32_bf16(Bt[n][k], At[m][k], acc[ai][bj][m][n], 0, 0, 0); } else { _Pragma("unroll") for (int m = 0; m < 4; ++m) _Pragma("unroll") for (int n = 0; n < 2; ++n) \
        asm("v_mfma_scale_f32_16x16x128_f8f6f4 %0, %1, %2, %0, %3, %3 op_sel_hi:[0,0,0]" : "+v"(acc[ai][bj][m][n]) : "v"(Bt##8[n]), "v"(At##8[m]), "v"(sc8_)); } \
        __builtin_amdgcn_s_setprio(0); } while (0)
#define PG8_WAIT_V(n) asm volatile("s_waitcnt vmcnt(" #n ")" ::: "memory")
#define PG8_WAIT_L(n) asm volatile("s_waitcnt lgkmcnt(" #n ")" ::: "memory")
#define PG8_BAR __builtin_amdgcn_s_barrier()
#define PG8_SCHED __builtin_amdgcn_sched_barrier(0)
    Unit cur, nxt; int ui = 0;
    if (!S.next(0, cur)) return;
    f32x4 acc[2][2][4][2];
#pragma unroll
    for (int a = 0; a < 2; ++a)
#pragma unroll
        for (int b = 0; b < 2; ++b)
#pragma unroll
            for (int m = 0; m < 4; ++m)
#pragma unroll
                for (int n = 0; n < 2; ++n) acc[a][b][m][n] = (f32x4){0.f, 0.f, 0.f, 0.f};
    int sc8_ = 0x7F7F7F7F; asm volatile("" : "+v"(sc8_));
    bf16x8 At[4][2], B0[2][2], B1[2][2]; v8i_ At8[4], B08[2], B18[2];
    const char* cA = S.a_base(cur); const char* cB = S.b_base(cur);
    if constexpr (GATH) { PG8_ROWOFFS(vc, cur); }
    PG8_STAGE(PG8_SB(0, 0), cB, voffB); PG8_STAGE(PG8_SB(0, 1), cB + hstepB, voffB); PG8_STAGE_A(PG8_SA(0, 0), cA, 0, 0); PG8_STAGE_A(PG8_SA(0, 1), cA + hstepA, 1, 0);
    if (wr == 1) PG8_BAR;
    PG8_WAIT_V(2); PG8_BAR;
    PG8_STAGE(PG8_SB(1, 0), cB + kstep, voffB); PG8_STAGE_A(PG8_SA(1, 0), cA + kstep, 0, kstep); PG8_STAGE(PG8_SB(1, 1), cB + hstepB + kstep, voffB);
    PG8_WAIT_V(6); PG8_BAR;
    for (;;) {
        const bool has_next = S.next(ui + 1, nxt);
        const char* nA = has_next ? S.a_base(nxt) : cA; const char* nB = has_next ? S.b_base(nxt) : cB;
        if constexpr (GATH) { if (has_next) { PG8_ROWOFFS(vn, nxt); } else {
#pragma unroll
            for (int _h = 0; _h < 2; ++_h) { vn[_h][0] = vc[_h][0]; vn[_h][1] = vc[_h][1]; } } }
        for (int t = 0; t < nt; t += 2) {
            const bool last = (t == nt - 2);
            const char* a1 = cA + (size_t)(t + 1) * kstep;
            const char* a2 = last ? nA : cA + (size_t)(t + 2) * kstep; const char* b2 = last ? nB : cB + (size_t)(t + 2) * kstep;
            const char* a3 = a2 + kstep; const char* b3 = b2 + kstep;
            const size_t k1 = (size_t)(t + 1) * kstep, k2 = last ? 0 : (size_t)(t + 2) * kstep, k3 = k2 + kstep;
            PG8_LDB(B0, 0, 0); PG8_LDB(B1, 0, 1); PG8_SCHED; PG8_LDA(At, 0, 0); PG8_STAGE_A(PG8_SA(1, 1), a1 + hstepA, 1, k1);
            if constexpr (GATH) { if (last) {
#pragma unroll
                for (int _h = 0; _h < 2; ++_h) { vc[_h][0] = vn[_h][0]; vc[_h][1] = vn[_h][1]; } } }
            PG8_WAIT_V(8); PG8_WAIT_L(0); PG8_BAR; PG8_MMA(0, 0, At, B0); PG8_MMA(0, 1, At, B1); PG8_BAR; PG8_SCHED;
            PG8_LDA(At, 0, 1); PG8_STAGE(PG8_SB(0, 0), b2, voffB); PG8_STAGE(PG8_SB(0, 1), b2 + hstepB, voffB); PG8_STAGE_A(PG8_SA(0, 0), a2, 0, k2);
            PG8_WAIT_V(8); PG8_WAIT_L(0); PG8_BAR; PG8_MMA(1, 0, At, B0); PG8_MMA(1, 1, At, B1); PG8_BAR; PG8_SCHED;
            PG8_LDB(B0, 1, 0); PG8_LDB(B1, 1, 1); PG8_SCHED; PG8_LDA(At, 1, 0); PG8_STAGE_A(PG8_SA(0, 1), a2 + hstepA, 1, k2);
            PG8_WAIT_V(8); PG8_WAIT_L(0); PG8_BAR; PG8_MMA(0, 0, At, B0); PG8_MMA(0, 1, At, B1); PG8_BAR; PG8_SCHED;
            PG8_LDA(At, 1, 1); PG8_STAGE(PG8_SB(1, 0), b3, voffB); PG8_STAGE(PG8_SB(1, 1), b3 + hstepB, voffB); PG8_STAGE_A(PG8_SA(1, 0), a3, 0, k3);
            PG8_WAIT_V(8); PG8_WAIT_L(0); PG8_BAR; PG8_MMA(1, 0, At, B0); PG8_MMA(1, 1, At, B1); PG8_BAR; PG8_SCHED;
        }
        if constexpr (ALIGN_EPI) { if (wr == 0) PG8_BAR; }
        if constexpr (ES == 1) {
#define PG8_TIE8(pre, a_, b_) asm volatile(pre : "+v"(acc[a_][b_][0][0]), "+v"(acc[a_][b_][0][1]), "+v"(acc[a_][b_][1][0]), "+v"(acc[a_][b_][1][1]), "+v"(acc[a_][b_][2][0]), "+v"(acc[a_][b_][2][1]), "+v"(acc[a_][b_][3][0]), "+v"(acc[a_][b_][3][1]))
            PG8_TIE8("s_nop 7\n\ts_nop 7\n\ts_nop 7\n\ts_nop 7", 0, 0); PG8_TIE8("", 0, 1); PG8_TIE8("", 1, 0); PG8_TIE8("", 1, 1);
#undef PG8_TIE8
        }
        { int fr2 = fr, fq2 = fq; asm volatile("" : "+v"(fr2), "+v"(fq2)); E(acc, cur, wr, wc, fr2, fq2); }
        if (!has_next) break;
        if (S.zero_after(cur)) {
#pragma unroll
        for (int a = 0; a < 2; ++a)
#pragma unroll
            for (int b = 0; b < 2; ++b)
#pragma unroll
                for (int m = 0; m < 4; ++m)
#pragma unroll
                    for (int n = 0; n < 2; ++n) acc[a][b][m][n] = (f32x4){0.f, 0.f, 0.f, 0.f}; }
        cur = nxt; cA = nA; cB = nB; ++ui;
        if constexpr (ALIGN_EPI) { if (wr == 1) PG8_BAR; }
    }
    PG8_WAIT_V(0);
    if constexpr (!ALIGN_EPI) { if (wr == 0) PG8_BAR; }
    PG8_BAR;
#undef PG8_SA
#undef PG8_SB
#undef PG8_STAGE
#undef PG8_LDA
#undef PG8_LD16
#undef PG8_STAGE_A
#undef PG8_ROWOFFS
#undef PG8_LDB
#undef PG8_MMA
#undef PG8_WAIT_V
#undef PG8_WAIT_L
#undef PG8_BAR
#undef PG8_SCHED
}
}

namespace att {
constexpr int AD = 128, NW = 8, QBLK = 32, KVBLK = 64;
constexpr float SCALE = 0.088388347648318440f;
constexpr float THR = 8.f;
constexpr int LDQ = INC, LDK = INC;
constexpr size_t SHM_V = KVBLK * AD * 2, SHM_K = KVBLK * AD * 2, SHM_ATTN = 2 * SHM_V + 2 * SHM_K + NW * 64 * 4;
using s16x4 = __attribute__((ext_vector_type(4))) short;
using f32x16 = __attribute__((ext_vector_type(16))) float;
#define KSWZ(row, colB) ((row) * 256 + ((colB) ^ (((row) & 7) << 4)))
#define SBAR() __builtin_amdgcn_sched_barrier(0)
__device__ __forceinline__ int crow(int r, int hi) { return (r & 3) + 8 * (r >> 2) + 4 * hi; }
__device__ __forceinline__ void partialSM(f32x16& p0, f32x16& p1, float& m_reg, float& mn, float& alpha) {
  constexpr float C = SCALE * 1.4426950408889634f;
  float pmax = p0[0]; for (int r = 1; r < 16; ++r) pmax = fmaxf(pmax, p0[r]); for (int r = 0; r < 16; ++r) pmax = fmaxf(pmax, p1[r]);
  { auto rr = __builtin_amdgcn_permlane32_swap(__float_as_uint(pmax), __float_as_uint(pmax), false, false);
    pmax = fmaxf(__uint_as_float(rr[0]), __uint_as_float(rr[1])); }
  if (__builtin_expect(__all(pmax - m_reg <= THR / SCALE), 1)) { mn = m_reg; alpha = 1.f; }
  else { mn = fmaxf(m_reg, pmax); alpha = __builtin_amdgcn_exp2f((m_reg - mn) * C); m_reg = mn; }
  float mnC = -mn * C;
  for (int r = 0; r < 16; ++r) p0[r] = fmaf(p0[r], C, mnC); for (int r = 0; r < 16; ++r) p1[r] = fmaf(p1[r], C, mnC);
  for (int r = 0; r < 16; ++r) p0[r] = __builtin_amdgcn_exp2f(p0[r]);
}
__device__ __forceinline__ void finishSM(f32x16& p0, f32x16& p1, float alpha, float& l_reg, bf16x8& pa0, bf16x8& pa1, bf16x8& pa2, bf16x8& pa3) {
  for (int r = 0; r < 16; ++r) p1[r] = __builtin_amdgcn_exp2f(p1[r]);
  float ps = 0; for (int r = 0; r < 16; ++r) ps += p0[r]; for (int r = 0; r < 16; ++r) ps += p1[r];
  { auto rr = __builtin_amdgcn_permlane32_swap(__float_as_uint(ps), __float_as_uint(ps), false, false);
    ps = __uint_as_float(rr[0]) + __uint_as_float(rr[1]); }
  l_reg = l_reg * alpha + ps;
#define PK4(P, BASE, OUT) do { unsigned a0 = cvt_pk(P[BASE + 0], P[BASE + 1]), a1 = cvt_pk(P[BASE + 2], P[BASE + 3]);   \
    unsigned b0 = cvt_pk(P[BASE + 4], P[BASE + 5]), b1 = cvt_pk(P[BASE + 6], P[BASE + 7]);                              \
    auto r0 = __builtin_amdgcn_permlane32_swap(a0, b0, false, false); auto r1 = __builtin_amdgcn_permlane32_swap(a1, b1, false, false); \
    v4u w = {r0[0], r1[0], r0[1], r1[1]}; OUT = *reinterpret_cast<bf16x8*>(&w); } while (0)
  PK4(p0, 0, pa0); PK4(p0, 8, pa1); PK4(p1, 0, pa2); PK4(p1, 8, pa3);
#undef PK4
}
__device__ __forceinline__ void qkt(f32x16& p0, f32x16& p1, const bf16* Ks, const bf16x8* qr, int r32, int hi) {
  p0 = f32x16{}; p1 = f32x16{};
  for (int d0 = 0; d0 < 8; ++d0) { int cb = (d0 * 16 + hi * 8) * 2;
    bf16x8 b0 = *reinterpret_cast<const bf16x8*>((const char*)Ks + KSWZ(r32, cb));
    bf16x8 b1 = *reinterpret_cast<const bf16x8*>((const char*)Ks + KSWZ(32 + r32, cb));
    p0 = __builtin_amdgcn_mfma_f32_32x32x16_bf16(b0, qr[d0], p0, 0, 0, 0);
    p1 = __builtin_amdgcn_mfma_f32_32x32x16_bf16(b1, qr[d0], p1, 0, 0, 0); }
}
__device__ __forceinline__ int v_st(int k, int c) { const int kk = (k & ~0xC) | ((k & 4) << 1) | ((k & 8) >> 1); return ((kk >> 3) * 4 + (c >> 5)) * 512 + ((kk & 7) * 32 + (c & 31)) * 2; }
__device__ __forceinline__ int v_rd_base(int lane) { return ((lane & 3) << 3) | (((lane >> 2) & 3) << 6) | (((lane >> 4) & 1) << 5) | (((lane >> 5) & 1) << 8); }
constexpr int v_rd_off(int d0, int ks, int half) { return d0 * 512 + ks * 4096 + half * 2048; }
template <int OFF> __device__ __forceinline__ s16x4 tr_read(int vb) {
  s16x4 r; asm volatile("ds_read_b64_tr_b16 %0, %1 offset:%2" : "=&v"(r) : "v"(vb), "i"(OFF) : "memory"); return r;
}
template <int D0> __device__ __forceinline__ void pv_one(f32x16& od, int vb, bf16x8 pa0, bf16x8 pa1, bf16x8 pa2, bf16x8 pa3) {
  const s16x4 l0 = tr_read<v_rd_off(D0, 0, 0)>(vb), h0 = tr_read<v_rd_off(D0, 0, 1)>(vb), l1 = tr_read<v_rd_off(D0, 1, 0)>(vb), h1 = tr_read<v_rd_off(D0, 1, 1)>(vb);
  const s16x4 l2 = tr_read<v_rd_off(D0, 2, 0)>(vb), h2 = tr_read<v_rd_off(D0, 2, 1)>(vb), l3 = tr_read<v_rd_off(D0, 3, 0)>(vb), h3 = tr_read<v_rd_off(D0, 3, 1)>(vb);
  asm volatile("s_waitcnt lgkmcnt(0)" ::: "memory"); SBAR();
#define PK(L, H) (bf16x8){L[0], L[1], L[2], L[3], H[0], H[1], H[2], H[3]}
  od = __builtin_amdgcn_mfma_f32_32x32x16_bf16(pa0, PK(l0, h0), od, 0, 0, 0);
  od = __builtin_amdgcn_mfma_f32_32x32x16_bf16(pa1, PK(l1, h1), od, 0, 0, 0);
  od = __builtin_amdgcn_mfma_f32_32x32x16_bf16(pa2, PK(l2, h2), od, 0, 0, 0);
  od = __builtin_amdgcn_mfma_f32_32x32x16_bf16(pa3, PK(l3, h3), od, 0, 0, 0);
#undef PK
}
__device__ __forceinline__ void pv_d0(f32x16* o, int vb, bf16x8 pa0, bf16x8 pa1, bf16x8 pa2, bf16x8 pa3) {
  pv_one<0>(o[0], vb, pa0, pa1, pa2, pa3); pv_one<1>(o[1], vb, pa0, pa1, pa2, pa3); pv_one<2>(o[2], vb, pa0, pa1, pa2, pa3); pv_one<3>(o[3], vb, pa0, pa1, pa2, pa3);
}
__device__ __forceinline__ void attn_dense_body(const bf16* __restrict__ Qb, const bf16* __restrict__ Kh, const bf16* __restrict__ Vh,
                                                bf16* __restrict__ Ob, int ldo, int seq, char* lds) {
  constexpr int SDEPTH = 2;
  int tid_ = threadIdx.x; asm volatile("" : "+v"(tid_));
  const int tid = tid_, wid = tid >> 6, lane = tid & 63, r32 = lane & 31, hi = lane >> 5;
  bf16* V_lds = (bf16*)lds; bf16* K_lds = (bf16*)(lds + 2 * SHM_V);
  float* ws = (float*)(lds + 2 * SHM_V + 2 * SHM_K) + wid * 64; float* li_l = ws; float* al_l = ws + 32;
  float m_reg = -1e30f, l_reg = 0; f32x16 o[4] = {}; bf16x8 qr[8];
  const bf16* Qw = Qb + (long)(wid * QBLK + r32) * LDQ + hi * 8;
#pragma unroll
  for (int d0 = 0; d0 < 8; ++d0) qr[d0] = *reinterpret_cast<const bf16x8*>(Qw + d0 * 16);
  const int sr = tid >> 4, sc = (tid & 15) * 8, vst0 = v_st(sr, sc), vst1 = v_st(32 + sr, sc);
  const int vb0 = (int)(uintptr_t)V_lds + v_rd_base(lane);
  struct { bf16x8 vs0, vs1, ks0, ks1; } sr_[SDEPTH];
#define SLOAD(i, k0) do { sr_[i].vs0 = *(const bf16x8*)(&Vh[(long)((k0) + sr) * LDK + sc]); sr_[i].vs1 = *(const bf16x8*)(&Vh[(long)((k0) + 32 + sr) * LDK + sc]); \
    sr_[i].ks0 = *(const bf16x8*)(&Kh[(long)((k0) + sr) * LDK + sc]); sr_[i].ks1 = *(const bf16x8*)(&Kh[(long)((k0) + 32 + sr) * LDK + sc]); } while (0)
#define SWRITE(b, i) do { *(bf16x8*)((char*)V_lds + (b) * SHM_V + vst0) = sr_[i].vs0;          \
    *(bf16x8*)((char*)V_lds + (b) * SHM_V + vst1) = sr_[i].vs1; int kc = sc * 2;               \
    *(bf16x8*)((char*)K_lds + (b) * SHM_K + KSWZ(sr, kc)) = sr_[i].ks0;                       \
    *(bf16x8*)((char*)K_lds + (b) * SHM_K + KSWZ(32 + sr, kc)) = sr_[i].ks1; } while (0)
#define SWAIT() asm volatile("s_waitcnt vmcnt(4)" ::: "memory")
#define RESC(a) do { if (__any((a) < 1.f)) { if (hi == 0) al_l[r32] = (a); asm volatile("s_waitcnt lgkmcnt(0)" ::: "memory"); \
    for (int d = 0; d < 4; ++d) for (int r = 0; r < 16; ++r) o[d][r] *= al_l[crow(r, hi)]; } } while (0)
  f32x16 pA0, pA1, pB0, pB1; float mnA, mnB, alA, alB; bf16x8 pa0, pa1, pa2, pa3; const int NT = seq / KVBLK;
  constexpr int SE = 0, SO = SDEPTH - 1;
  SLOAD(SE, 0); asm volatile("s_waitcnt vmcnt(0)" ::: "memory"); SWRITE(0, SE); __syncthreads();
  qkt(pA0, pA1, K_lds, qr, r32, hi); partialSM(pA0, pA1, m_reg, mnA, alA);
  SLOAD(SO, KVBLK); if (2 < NT) SLOAD(SE, 2 * KVBLK);
  SWAIT(); SWRITE(1, SO); __syncthreads();
  for (int j = 1; j + 1 < NT; j += 2) {
    SBAR(); qkt(pB0, pB1, (bf16*)((char*)K_lds + SHM_K), qr, r32, hi);
    finishSM(pA0, pA1, alA, l_reg, pa0, pa1, pa2, pa3); SBAR();
    SLOAD(SO, (j + SDEPTH) * KVBLK); SBAR();
    pv_d0(o, vb0, pa0, pa1, pa2, pa3); partialSM(pB0, pB1, m_reg, mnB, alB);
    __syncthreads(); SWAIT(); SWRITE(0, SE);
    RESC(alB); __syncthreads();
    SBAR(); qkt(pA0, pA1, K_lds, qr, r32, hi);
    finishSM(pB0, pB1, alB, l_reg, pa0, pa1, pa2, pa3); SBAR();
    if (j + 3 < NT) SLOAD(SE, (j + 1 + SDEPTH) * KVBLK); SBAR();
    pv_d0(o, vb0 + (int)SHM_V, pa0, pa1, pa2, pa3); partialSM(pA0, pA1, m_reg, mnA, alA);
    __syncthreads(); SWAIT(); SWRITE(1, SO);
    RESC(alA); __syncthreads();
  }
  SBAR(); qkt(pB0, pB1, (bf16*)((char*)K_lds + SHM_K), qr, r32, hi);
  finishSM(pA0, pA1, alA, l_reg, pa0, pa1, pa2, pa3); SBAR();
  pv_d0(o, vb0, pa0, pa1, pa2, pa3); partialSM(pB0, pB1, m_reg, mnB, alB);
  __syncthreads(); RESC(alB);
  finishSM(pB0, pB1, alB, l_reg, pa0, pa1, pa2, pa3); SBAR();
  pv_d0(o, vb0 + (int)SHM_V, pa0, pa1, pa2, pa3);
  if (hi == 0) li_l[r32] = l_reg; asm volatile("s_waitcnt lgkmcnt(0)" ::: "memory");
  float rli[16];
#pragma unroll
  for (int r = 0; r < 16; ++r) rli[r] = __builtin_amdgcn_rcpf(li_l[crow(r, hi)]);
  bf16* Ow = Ob + (long)(wid * QBLK) * ldo;
#pragma unroll
  for (int r = 0; r < 16; ++r) { int orow = crow(r, hi);
    for (int d0 = 0; d0 < 4; ++d0) Ow[(long)orow * ldo + d0 * 32 + r32] = (bf16)(cvt_pk(o[d0][r] * rli[r], 0.f) & 0xffffu); }
#undef SLOAD
#undef SWRITE
#undef SWAIT
#undef RESC
}
constexpr int DV_VB = 2 * (int)SHM_V, DV_KOFF = 3 * DV_VB, DV_WSOFF = DV_KOFF + 2 * (int)SHM_K;
#define TRL(D0, KS, HF) tr_read<((D0) >> 2) * (int)SHM_V + v_rd_off((D0) & 3, KS, HF)>(vb)
#define TRLV(D0, KS, HF, VB) tr_read<((D0) >> 2) * (int)SHM_V + v_rd_off((D0) & 3, KS, HF)>(VB)
#define DV_RDV(s_, D0, KS0, VB) do { s_##0 = TRLV(D0, KS0, 0, VB); s_##1 = TRLV(D0, KS0, 1, VB); s_##2 = TRLV(D0, (KS0) + 1, 0, VB); s_##3 = TRLV(D0, (KS0) + 1, 1, VB); } while (0)
#define DV_RD(s_, D0, KS0) do { s_##0 = TRL(D0, KS0, 0); s_##1 = TRL(D0, KS0, 1); s_##2 = TRL(D0, (KS0) + 1, 0); s_##3 = TRL(D0, (KS0) + 1, 1); } while (0)
#define DV_PK(L, H) (bf16x8){L[0], L[1], L[2], L[3], H[0], H[1], H[2], H[3]}
#define DV_MM(s_, D0, P0, P1) do { o[D0] = __builtin_amdgcn_mfma_f32_32x32x16_bf16(P0, DV_PK(s_##0, s_##1), o[D0], 0, 0, 0); o[D0] = __builtin_amdgcn_mfma_f32_32x32x16_bf16(P1, DV_PK(s_##2, s_##3), o[D0], 0, 0, 0); } while (0)
#define DV_W(n) do { asm volatile("s_waitcnt lgkmcnt(" #n ")" ::: "memory"); SBAR(); } while (0)
#define DV_KRD(s_, d0) do { const int a_ = kb ^ ((d0) << 5); asm volatile("ds_read_b128 %0, %2\n\tds_read_b128 %1, %2 offset:8192" : "=&v"(s_##0), "=&v"(s_##1) : "v"(a_) : "memory"); } while (0)
#define DV_QM(s_, d0) do { p0 = __builtin_amdgcn_mfma_f32_32x32x16_bf16(s_##0, qr[d0], p0, 0, 0, 0); p1 = __builtin_amdgcn_mfma_f32_32x32x16_bf16(s_##1, qr[d0], p1, 0, 0, 0); \
    asm volatile("" : "+v"(p0), "+v"(p1)); } while (0)
#define DV_EX(P, i) do { P[2 * (i)] = __builtin_amdgcn_exp2f(P[2 * (i)]); P[2 * (i) + 1] = __builtin_amdgcn_exp2f(P[2 * (i) + 1]); } while (0)
#define DV_EXS(P, i) do { DV_EX(P, i); ps += P[2 * (i)] + P[2 * (i) + 1]; } while (0)
#define DV_PK4(P, BASE, OUT) do { unsigned a0_ = cvt_pk(P[BASE + 0], P[BASE + 1]), a1_ = cvt_pk(P[BASE + 2], P[BASE + 3]);   \
    unsigned b0_ = cvt_pk(P[BASE + 4], P[BASE + 5]), b1_ = cvt_pk(P[BASE + 6], P[BASE + 7]);                              \
    auto r0_ = __builtin_amdgcn_permlane32_swap(a0_, b0_, false, false); auto r1_ = __builtin_amdgcn_permlane32_swap(a1_, b1_, false, false); \
    v4u w_ = {r0_[0], r1_[0], r0_[1], r1_[1]}; OUT = *reinterpret_cast<bf16x8*>(&w_); } while (0)
template <int NDT>
__device__ __forceinline__ void attn_dv256_body(const bf16* __restrict__ Qb, const bf16* __restrict__ Kh, const bf16* __restrict__ Vh,
                                                bf16* __restrict__ Ob, int ldo, int seq, char* lds, LAS unsigned char* ldsl) {
  constexpr float C = SCALE * 1.4426950408889634f;
  int tid_ = threadIdx.x; asm volatile("" : "+v"(tid_));
  const int tid = tid_, wid = __builtin_amdgcn_readfirstlane(tid >> 6), lane = tid & 63, r32 = lane & 31, hi = lane >> 5;
  float* ws = (float*)(lds + DV_WSOFF) + wid * 64; float* li_l = ws; float* al_l = ws + 32;
  float m_reg = -1e30f, l_reg = 0; f32x16 o[NDT] = {}; bf16x8 qr[8];
  const bf16* Qw = Qb + (long)(wid * QBLK + r32) * LDQ + hi * 8;
#pragma unroll
  for (int d0 = 0; d0 < 8; ++d0) qr[d0] = *reinterpret_cast<const bf16x8*>(Qw + d0 * 16);
  const int krow = wid * 4 + (lane >> 4);
  const unsigned ksrc = (unsigned)(krow * LDK + (((lane & 15) ^ (krow & 7)) << 3)) * 2u;
  const int kk = ((wid >> 1) << 3) | ((lane >> 2) & 7), vk = (kk & ~0xC) | ((kk & 4) << 1) | ((kk & 8) >> 1);
  const unsigned vsrc = (unsigned)(vk * LDK + ((((lane >> 5) & 1) | ((wid & 1) << 1)) << 5) + ((lane & 3) << 3)) * 2u;
  const unsigned ldsw = (unsigned)wid * 1024u;
  const int vbase = (int)(uintptr_t)ldsl + v_rd_base(lane);
  const int kbase = (int)(uintptr_t)ldsl + DV_KOFF + r32 * 256 + ((hi << 4) ^ ((r32 & 7) << 4));
#define DV_GLL(src, dst) __builtin_amdgcn_global_load_lds((const unsigned*)(src), (LAS unsigned*)(dst), 16, 0, 0)
#define DV_DMA(kbuf, voff, k0) do { const char* kp_ = (const char*)(Kh + (size_t)(k0) * LDK); const char* vp_ = (const char*)(Vh + (size_t)(k0) * LDK); \
    _Pragma("unroll") for (int i_ = 0; i_ < 2; ++i_) { \
      DV_GLL(kp_ + (size_t)i_ * (32 * LDK * 2) + ksrc, ldsl + DV_KOFF + (kbuf) * (int)SHM_K + ldsw + i_ * 8192); \
      DV_GLL(vp_ + (size_t)i_ * (32 * LDK * 2) + vsrc, ldsl + (voff) + ldsw + i_ * 8192); \
      if constexpr (NDT == 8) DV_GLL(vp_ + (size_t)i_ * (32 * LDK * 2) + 256 + vsrc, ldsl + (voff) + (int)SHM_V + ldsw + i_ * 8192); } } while (0)
#define DV_RESC(a) do { if (__any((a) < 1.f)) { if (hi == 0) al_l[r32] = (a); asm volatile("s_waitcnt lgkmcnt(0)" ::: "memory"); \
    for (int d = 0; d < NDT; ++d) for (int r = 0; r < 16; ++r) o[d][r] *= al_l[crow(r, hi)]; } } while (0)
  const int NT = seq / KVBLK;
  int b0 = 0, b1 = DV_VB, b2 = 2 * DV_VB;
  DV_DMA(0, b0, 0); if (NT > 1) DV_DMA(1, b1, KVBLK);
  asm volatile("s_waitcnt vmcnt(0)" ::: "memory"); __syncthreads();
  bf16x8 pp2 = {}, pp3 = {};
  bf16x8 ka0, ka1, kb0, kb1;
  { const int kb = kbase; DV_KRD(ka, 0); DV_KRD(kb, 1); }
#pragma unroll 1
  for (int j = 0; j < NT; ++j) {
    f32x16 p0 = {}, p1 = {}; float alpha, pmax, mnC, ps; bf16x8 pa0, pa1; s16x4 a0, a1, a2, a3, c0, c1, c2, c3;
    const int vbX = vbase + (j == 0 ? b0 : b2), vbY = vbase + b0;
    {
      bf16x8 kc0, kc1; const int kb = kbase + (j & 1) * (int)SHM_K;
      SBAR();
      DV_KRD(kc, 2); DV_W(4); DV_QM(ka, 0);
      DV_KRD(ka, 3); DV_W(4); DV_QM(kb, 1);
      DV_KRD(kb, 4); DV_W(4); DV_QM(kc, 2);
      DV_KRD(kc, 5); DV_W(4); DV_QM(ka, 3);
      DV_KRD(ka, 6); DV_W(4); DV_QM(kb, 4);
      DV_KRD(kb, 7); DV_W(4); DV_QM(kc, 5);
      DV_RDV(a, 0, 2, vbX); DV_RDV(c, 1, 2, vbX);
      DV_W(10); DV_QM(ka, 6);
      DV_W(8); DV_QM(kb, 7);
    }
    {
      const int vb = vbX; ps = 0.f;
#define DV_SM_MAX0() do { pmax = p0[0]; for (int r = 1; r < 16; ++r) pmax = fmaxf(pmax, p0[r]); } while (0)
#define DV_SM_MAX1() do { for (int r = 0; r < 16; ++r) pmax = fmaxf(pmax, p1[r]); } while (0)
#define DV_SM_M() do { { auto rr = __builtin_amdgcn_permlane32_swap(__float_as_uint(pmax), __float_as_uint(pmax), false, false); pmax = fmaxf(__uint_as_float(rr[0]), __uint_as_float(rr[1])); } \
        const bool keep = __all(pmax - m_reg <= THR / SCALE); const float mn = keep ? m_reg : fmaxf(m_reg, pmax);     \
        alpha = __builtin_amdgcn_exp2f((m_reg - mn) * C); m_reg = mn; mnC = -mn * C; } while (0)
#define DV_SM_F(P) do { for (int r = 0; r < 16; ++r) P[r] = fmaf(P[r], C, mnC); } while (0)
      if constexpr (NDT == 8) {
        DV_W(4); DV_MM(a, 0, pp2, pp3);
        DV_SM_MAX0();
        DV_RD(a, 2, 2); DV_W(4); DV_MM(c, 1, pp2, pp3);
        DV_SM_MAX1();
        DV_RD(c, 3, 2); DV_W(4); DV_MM(a, 2, pp2, pp3);
        DV_SM_M(); DV_SM_F(p0);
        DV_RD(a, 4, 2); DV_W(4); DV_MM(c, 3, pp2, pp3);
        DV_SM_F(p1);
        DV_EXS(p0, 0);
        DV_RD(c, 5, 2); DV_W(4); DV_MM(a, 4, pp2, pp3);
        DV_EXS(p0, 1); DV_EXS(p0, 2);
        DV_RD(a, 6, 2); DV_W(4); DV_MM(c, 5, pp2, pp3);
        DV_EXS(p0, 3); DV_EXS(p0, 4);
        DV_RD(c, 7, 2); DV_W(4); DV_MM(a, 6, pp2, pp3);
        DV_EXS(p0, 5); DV_EXS(p0, 6);
        DV_RDV(a, 0, 0, vbY); DV_W(4); DV_MM(c, 7, pp2, pp3);
        DV_EXS(p0, 7);
        DV_RDV(c, 1, 0, vbY);
      } else {
        DV_W(4); DV_MM(a, 0, pp2, pp3);
        DV_SM_MAX0(); DV_SM_MAX1();
        DV_RD(a, 2, 2); DV_W(4); DV_MM(c, 1, pp2, pp3);
        DV_SM_M(); DV_SM_F(p0); DV_SM_F(p1);
        DV_RD(c, 3, 2); DV_W(4); DV_MM(a, 2, pp2, pp3);
        DV_EXS(p0, 0); DV_EXS(p0, 1); DV_EXS(p0, 2); DV_EXS(p0, 3);
        DV_RDV(a, 0, 0, vbY); DV_W(4); DV_MM(c, 3, pp2, pp3);
        DV_EXS(p0, 4); DV_EXS(p0, 5); DV_EXS(p0, 6); DV_EXS(p0, 7);
        DV_RDV(c, 1, 0, vbY);
      }
#undef DV_SM_MAX0
#undef DV_SM_MAX1
#undef DV_SM_M
#undef DV_SM_F
      DV_PK4(p0, 0, pa0); DV_PK4(p0, 8, pa1);
      DV_W(0);
    }
    DV_RESC(alpha);
    asm volatile("s_waitcnt vmcnt(0)" ::: "memory"); __syncthreads();
    {
      const int vb = vbY; SBAR();
      if constexpr (NDT == 8) {
        DV_MM(a, 0, pa0, pa1); DV_EXS(p1, 0);
        DV_RD(a, 2, 0); DV_W(4); DV_MM(c, 1, pa0, pa1); DV_EXS(p1, 1);
        DV_RD(c, 3, 0); DV_W(4); DV_MM(a, 2, pa0, pa1); DV_EXS(p1, 2);
        DV_RD(a, 4, 0); DV_W(4); DV_MM(c, 3, pa0, pa1); DV_EXS(p1, 3);
        DV_RD(c, 5, 0); DV_W(4); DV_MM(a, 4, pa0, pa1); DV_EXS(p1, 4);
        DV_RD(a, 6, 0); DV_W(4); DV_MM(c, 5, pa0, pa1); DV_EXS(p1, 5);
        DV_RD(c, 7, 0); DV_W(4); DV_MM(a, 6, pa0, pa1); DV_EXS(p1, 6);
        { const int kb = kbase + ((j + 1) & 1) * (int)SHM_K; DV_KRD(ka, 0); DV_KRD(kb, 1); }
        DV_W(4); DV_MM(c, 7, pa0, pa1); DV_EXS(p1, 7);
      } else {
        DV_MM(a, 0, pa0, pa1); DV_EXS(p1, 0); DV_EXS(p1, 1);
        DV_RD(a, 2, 0); DV_W(4); DV_MM(c, 1, pa0, pa1); DV_EXS(p1, 2); DV_EXS(p1, 3);
        DV_RD(c, 3, 0); DV_W(4); DV_MM(a, 2, pa0, pa1); DV_EXS(p1, 4); DV_EXS(p1, 5);
        { const int kb = kbase + ((j + 1) & 1) * (int)SHM_K; DV_KRD(ka, 0); DV_KRD(kb, 1); }
        DV_W(4); DV_MM(c, 3, pa0, pa1); DV_EXS(p1, 6); DV_EXS(p1, 7);
      }
      if (j + 2 < NT) DV_DMA(j & 1, b2, (j + 2) * KVBLK);
      { auto rr = __builtin_amdgcn_permlane32_swap(__float_as_uint(ps), __float_as_uint(ps), false, false); ps = __uint_as_float(rr[0]) + __uint_as_float(rr[1]); }
      l_reg = l_reg * alpha + ps;
      DV_PK4(p1, 0, pp2); DV_PK4(p1, 8, pp3);
      DV_W(0);
    }
    { const int t = b0; b0 = b1; b1 = b2; b2 = t; }
  }
  {
    s16x4 a0, a1, a2, a3, c0, c1, c2, c3; const int vb = vbase + b2; SBAR();
    DV_RD(a, 0, 2); DV_RD(c, 1, 2);
    DV_W(4); DV_MM(a, 0, pp2, pp3);
    DV_RD(a, 2, 2); DV_W(4); DV_MM(c, 1, pp2, pp3);
    if constexpr (NDT == 8) {
      DV_RD(c, 3, 2); DV_W(4); DV_MM(a, 2, pp2, pp3);
      DV_RD(a, 4, 2); DV_W(4); DV_MM(c, 3, pp2, pp3);
      DV_RD(c, 5, 2); DV_W(4); DV_MM(a, 4, pp2, pp3);
      DV_RD(a, 6, 2); DV_W(4); DV_MM(c, 5, pp2, pp3);
      DV_RD(c, 7, 2); DV_W(4); DV_MM(a, 6, pp2, pp3);
      DV_W(0); DV_MM(c, 7, pp2, pp3);
    } else {
      DV_RD(c, 3, 2); DV_W(4); DV_MM(a, 2, pp2, pp3);
      DV_W(0); DV_MM(c, 3, pp2, pp3);
    }
  }
  asm volatile("s_waitcnt lgkmcnt(0)" ::: "memory"); __builtin_amdgcn_s_barrier();
  if (hi == 0) li_l[r32] = l_reg; asm volatile("s_waitcnt lgkmcnt(0)" ::: "memory");
  float rli[16];
#pragma unroll
  for (int r = 0; r < 16; ++r) rli[r] = __builtin_amdgcn_rcpf(li_l[crow(r, hi)]);
  bf16* Ow = Ob + (long)(wid * QBLK) * ldo;
#pragma unroll
  for (int r = 0; r < 16; ++r) { int orow = crow(r, hi);
#pragma unroll
    for (int d0 = 0; d0 < NDT; ++d0) Ow[(long)orow * ldo + d0 * 32 + r32] = (bf16)(cvt_pk(o[d0][r] * rli[r], 0.f) & 0xffffu); }
#undef DV_GLL
#undef DV_DMA
#undef DV_RESC
}
#undef TRL
#undef TRLV
#undef DV_RDV
#undef DV_RD
#undef DV_PK
#undef DV_MM
#undef DV_W
#undef DV_KRD
#undef DV_QM
#undef DV_EX
#undef DV_EXS
#undef DV_PK4
}

#define XB_TMO      128
#define XB_XCNT(j)  (256  + 64 * (j))
#define XB_XSUB(j)  (1280 + 64 * (j))
#define XB_XGEN(j)  (2304 + 64 * (j))
#define XB_TOP      3328
#define XB_TOPGEN   3392
#define XCD_BAR_WORDS 3456
#define XB_SPIN_CAP (1u << 18)
__device__ __forceinline__ unsigned xb_ld(unsigned* p)              { return __hip_atomic_load(p, __ATOMIC_RELAXED, __HIP_MEMORY_SCOPE_AGENT); }
__device__ __forceinline__ unsigned xb_add(unsigned* p, unsigned v) { return __hip_atomic_fetch_add(p, v, __ATOMIC_RELAXED, __HIP_MEMORY_SCOPE_AGENT); }
__device__ __forceinline__ unsigned xb_xcc_id() { return (unsigned)__builtin_amdgcn_s_getreg((3 << 11) | 20) & 0xFu; }
#define XB_SPIN(cond, bar) do { unsigned _sp = 0; while (cond) { __builtin_amdgcn_s_sleep(1); \
    if ((++_sp & 255u) == 0u) { if (xb_ld(&(bar)[XB_TMO])) break; if (_sp > XB_SPIN_CAP) { atomicAdd(&(bar)[XB_TMO], 1u); break; } } } } while (0)
struct XcdBarrier { unsigned* bar; unsigned x; volatile LAS unsigned* st; };
__device__ __forceinline__ XcdBarrier xcd_barrier_post(unsigned* bar, volatile LAS unsigned* st) {
    XcdBarrier b; b.bar = bar; b.x = xb_xcc_id(); b.st = st;
    if (threadIdx.x == 0) (void)xb_add(&bar[XB_XCNT(b.x)], 1u);
    return b;
}
__device__ __forceinline__ void xcd_barrier_complete(unsigned* bar, unsigned x, unsigned& nloc, unsigned& nx) {
    const unsigned G = gridDim.x * gridDim.y * gridDim.z;
    unsigned sum, cnt, mine, sp = 0u;
    for (;;) {
        sum = 0u; cnt = 0u; mine = 0u;
#pragma unroll
        for (unsigned j = 0; j < 16; ++j) { const unsigned c = xb_ld(&bar[XB_XCNT(j)]); sum += c; cnt += (c > 0u) ? 1u : 0u; mine = (j == x) ? c : mine; }
        if (sum == G) break;
        __builtin_amdgcn_s_sleep(1);
        if ((++sp & 255u) == 0u) { if (xb_ld(&bar[XB_TMO])) break; if (sp > XB_SPIN_CAP) { atomicAdd(&bar[XB_TMO], 1u); break; } }
    }
    nloc = mine > 0u ? mine : 1u; nx = cnt > 0u ? cnt : 1u;
}
__device__ __forceinline__ void xcd_barrier(const XcdBarrier& b) {
    asm volatile("s_waitcnt vmcnt(0)" ::: "memory");
    __syncthreads();
    if (threadIdx.x == 0) {
        unsigned* bar = b.bar;
        __builtin_amdgcn_s_waitcnt(0);
        unsigned nloc = b.st[0], nx = b.st[1];
        if (nloc == 0u) { xcd_barrier_complete(bar, b.x, nloc, nx); b.st[0] = nloc; b.st[1] = nx; }
        const unsigned old = xb_add(&bar[XB_XSUB(b.x)], 1u);
        const unsigned gen = old / nloc;
        if (old + 1u == (gen + 1u) * nloc) {
            __builtin_amdgcn_fence(__ATOMIC_RELEASE, "agent");
            asm volatile("s_waitcnt vmcnt(0)" ::: "memory");
            const unsigned og = xb_add(&bar[XB_TOP], 1u);
            const unsigned tg = og / nx;
            if (og + 1u == (tg + 1u) * nx) xb_add(&bar[XB_TOPGEN], 1u);
            else XB_SPIN(xb_ld(&bar[XB_TOPGEN]) == tg, bar);
            __builtin_amdgcn_fence(__ATOMIC_ACQUIRE, "agent");
            xb_add(&bar[XB_XGEN(b.x)], 1u);
            asm volatile("s_waitcnt vmcnt(0)" ::: "memory");
        } else {
            XB_SPIN(xb_ld(&bar[XB_XGEN(b.x)]) == gen, bar);
            __builtin_amdgcn_fence(__ATOMIC_ACQUIRE, "agent");
            asm volatile("s_waitcnt vmcnt(0)" ::: "memory");
        }
    }
    __syncthreads();
}

struct Args { const float* in[34]; float* out; unsigned char* ws; int ph_lo, ph_hi; };
typedef const __attribute__((address_space(4))) Args* KArgs;
template <class T> __device__ __forceinline__ T* as_global(T* p) { return (T*)(GAS T*)p; }
__device__ __forceinline__ KArgs kargs() { KArgs p = (KArgs)__builtin_amdgcn_kernarg_segment_ptr(); asm volatile("" : "+s"(p)); return p; }
__device__ __forceinline__ const float* ain(KArgs a, int i) { return as_global(a->in[i]); }
__device__ __forceinline__ float* aout(KArgs a) { return as_global(a->out); }
struct Frame {
    unsigned char* lds; unsigned char* lds0;
    LAS unsigned char* ldsl;
    unsigned char* ws;
    int tid, lane, wave, G, gw, NGW;
};
enum { I_X = 0, I_C, I_CTX, I_CCTX, I_WADA, I_BADA, I_N1G, I_N2G, I_WIN, I_BGATE, I_QNA, I_KNA, I_DLAM, I_SUBN, I_QNC, I_KNC, I_CONVW, I_CONVB,
       I_LWA, I_LBA, I_LWX, I_LBX, I_LLAM, I_WBA, I_WBB, I_WBC, I_WOUT, I_WGRP, I_BGRP, I_WRT, I_BRT, I_W1, I_W3, I_W2 };

__device__ __forceinline__ void phase_ids(Frame& F) {
    int t = threadIdx.x; asm volatile("" : "+v"(t)); F.tid = t; F.lane = t & 63; F.wave = __builtin_amdgcn_readfirstlane(t >> 6); F.gw = blockIdx.x * 8 + F.wave;
    GAS unsigned char* w = (GAS unsigned char*)kargs()->ws; asm volatile("" : "+s"(w)); F.ws = (unsigned char*)w; F.lds = F.lds0; F.ldsl = (LAS unsigned char*)F.lds0;
}
__device__ __forceinline__ int launder_s(int v) { asm volatile("" : "+s"(v)); return v; }
__host__ __device__ __forceinline__ int qk_perm(int n) { const int q = n >> 5, i = n & 31; return 8 * (((q >> 1) << 3) + (i >> 2)) + (i & 3) + ((q & 1) << 2); }
__device__ __forceinline__ void tr_item(const float* __restrict__ W, int N, bf16* __restrict__ WT, int K, int k0, int n0, int drow0, LAS float* scr, int lane, bool hperm = false) {
#pragma unroll 8
    for (int i = 0; i < 64; ++i) scr[i * 65 + lane] = __builtin_nontemporal_load(&W[(size_t)(k0 + i) * N + n0 + lane]);
    LDS_WAIT();
    const int c = lane & 7;
#pragma unroll
    for (int j = 0; j < 8; ++j) { const int n = (lane >> 3) + 8 * j; const LAS float* s = scr + (8 * c) * 65 + n;
        v4u o; o.x = cvt_pk(s[0], s[65]); o.y = cvt_pk(s[130], s[195]); o.z = cvt_pk(s[260], s[325]); o.w = cvt_pk(s[390], s[455]);
        const int drow = hperm ? (drow0 & ~127) + qk_perm((drow0 & 127) + n) : drow0 + n;
        *(v4u*)(WT + (size_t)drow * K + k0 + 8 * c) = o; }
    LDS_WAIT();
}
__device__ __forceinline__ void tr_item8(const float* __restrict__ W, int N, unsigned char* __restrict__ WT, int K, int k0, int n0, int drow0, float scale, LAS float* scr, int lane) {
#pragma unroll 8
    for (int i = 0; i < 64; ++i) scr[i * 65 + lane] = __builtin_nontemporal_load(&W[(size_t)(k0 + i) * N + n0 + lane]);
    LDS_WAIT();
    const int c = lane & 7;
#pragma unroll
    for (int j = 0; j < 8; ++j) { const int n = (lane >> 3) + 8 * j; const LAS float* s = scr + (8 * c) * 65 + n;
        unsigned lo = 0u, hi = 0u;
        lo = __builtin_amdgcn_cvt_pk_fp8_f32(s[0] * scale, s[65] * scale, lo, false); lo = __builtin_amdgcn_cvt_pk_fp8_f32(s[130] * scale, s[195] * scale, lo, true);
        hi = __builtin_amdgcn_cvt_pk_fp8_f32(s[260] * scale, s[325] * scale, hi, false); hi = __builtin_amdgcn_cvt_pk_fp8_f32(s[390] * scale, s[455] * scale, hi, true);
        v2u o; o.x = lo; o.y = hi; *(v2u*)(WT + (size_t)(drow0 + n) * K + k0 + 8 * c) = o; }
    LDS_WAIT();
}
constexpr int CV_IN = 32 * 200, CV_BR = 16 * 32, CV_OUT = 32 * 32, CV_W = 32 * 256;
constexpr int CV_O_BR = CV_IN, CV_O_OUT = CV_O_BR + 3 * CV_BR, CV_O_W13 = CV_O_OUT + CV_OUT, CV_O_W2 = CV_O_W13 + 2 * CV_W, CV_NIT = CV_O_W2 + CV_W;
__device__ __forceinline__ void conv_weights(Frame& F, int l, int it_lo, int it_hi, int wg_lo) {
    phase_ids(F); l = launder_s(l); KArgs a = kargs();
    if ((int)blockIdx.x < wg_lo) return;
    LAS float* scr = (LAS float*)(F.ldsl + F.wave * 16640);
    constexpr int I_IN = CV_IN, I_BR = CV_BR, I_OUT = CV_OUT, I_W = CV_W;
    bf16* WIN = (bf16*)(F.ws + WS_WIN); bf16* WBR = (bf16*)(F.ws + WS_WBR); bf16* WOUT = (bf16*)(F.ws + WS_WOUT);
    bf16* W13 = (bf16*)(F.ws + (l ? WS_W13B : WS_W13)); bf16* W2 = (bf16*)(F.ws + (l ? WS_W2B : WS_W2));
    for (int it = it_lo + ((int)blockIdx.x - wg_lo) * 8 + F.wave; it < it_hi; it += (F.G - wg_lo) * 8) {
        int r = it;
        if (r < I_IN) { const int kb = r / 200, nb = r % 200;
            if (nb * 64 < C_G) { const int n0 = nb * 64; const bool qk = n0 < C_AV || (n0 >= C_CQ && n0 < C_CV);
                tr_item(ain(a, I_WIN) + (size_t)l * D * INC, INC, WIN, D, kb * 64, n0, n0, scr, F.lane, qk); }
            else tr_item8(ain(a, I_WIN) + (size_t)l * D * INC, INC, F.ws + WS_WING8, D, kb * 64, nb * 64, nb * 64 - C_G, 64.0f, scr, F.lane);
            continue; } r -= I_IN;
        if (r < 3 * I_BR) { const int br = r / I_BR, q = r % I_BR, kb = q / 32, nb = q % 32;
            tr_item(ain(a, I_WBA + br) + (size_t)l * 1024 * D, D, WBR + (size_t)br * D * 1024, 1024, kb * 64, nb * 64, nb * 64, scr, F.lane); continue; } r -= 3 * I_BR;
        if (r < I_OUT) { const int kb = r / 32, nb = r % 32; tr_item(ain(a, I_WOUT) + (size_t)l * D * D, D, WOUT, D, kb * 64, nb * 64, nb * 64, scr, F.lane); continue; } r -= I_OUT;
        if (r < 2 * I_W) { const int which = r / I_W, q = r % I_W, e = q / 256, q2 = q % 256, kb = q2 / 8, nb = q2 % 8;
            const int n0 = nb * 64; const int drow = e * 1024 + (n0 / 128) * 256 + (n0 % 128) + which * 128;
            tr_item8(ain(a, which ? I_W3 : I_W1) + ((size_t)l * NE + e) * D * DE, DE, (unsigned char*)W13, D, kb * 64, n0, drow, 64.0f, scr, F.lane); continue; } r -= 2 * I_W;
        { const int e = r / 256, q2 = r % 256, kb = q2 / 32, nb = q2 % 32;
            tr_item(ain(a, I_W2) + ((size_t)l * NE + e) * DE * D, D, W2, DE, kb * 64, nb * 64, e * D + nb * 64, scr, F.lane); }
    }
}

__device__ __forceinline__ void p0_misc(Frame& F) {
    phase_ids(F); KArgs a = kargs();
    LAS float* sl = (LAS float*)F.ldsl;
    LAS float* red = sl + 9 * 2048;
    const float* c = ain(a, I_C); const float* cc = ain(a, I_CCTX);
    float* mod = (float*)(F.ws + WS_MOD);
    if (blockIdx.x < 192 || F.G < 192) {
        for (int idx = F.tid; idx < 9 * 2048; idx += 512) { const int b = idx >> 11, k = idx & 2047; const float v = b < 8 ? c[b * 2048 + k] : cc[k]; sl[idx] = v / (1.0f + expf(-v)); }
        __syncthreads();
        for (int it = blockIdx.x; it < 192; it += F.G) {
            const int l = it / 96, cb = it % 96, col = cb * 128 + 2 * F.lane;
            const float* wp = ain(a, I_WADA) + ((size_t)l * D + F.wave * 256) * (NMOD * D) + col;
            float ax[9], ay[9];
#pragma unroll
            for (int b = 0; b < 9; ++b) { ax[b] = 0.f; ay[b] = 0.f; }
            for (int k = 0; k < 256; k += 8) {
                f32x2 w[8];
#pragma unroll
                for (int u = 0; u < 8; ++u) w[u] = __builtin_nontemporal_load((const f32x2*)(wp + (size_t)(k + u) * (NMOD * D)));
#pragma unroll
                for (int u = 0; u < 8; ++u)
#pragma unroll
                    for (int b = 0; b < 9; ++b) { const float s = sl[b * 2048 + F.wave * 256 + k + u]; ax[b] += s * w[u].x; ay[b] += s * w[u].y; }
            }
#pragma unroll
            for (int b = 0; b < 9; ++b) { red[(F.wave * 9 + b) * 128 + 2 * F.lane] = ax[b]; red[(F.wave * 9 + b) * 128 + 2 * F.lane + 1] = ay[b]; }
            __syncthreads();
            for (int o = F.tid; o < 9 * 128; o += 512) { const int b = o >> 7, ci = o & 127; float s = 0.f;
#pragma unroll
                for (int w = 0; w < 8; ++w) s += red[(w * 9 + b) * 128 + ci];
                mod[((size_t)l * 9 + b) * (NMOD * D) + cb * 128 + ci] = s + ain(a, I_BADA)[(size_t)l * (NMOD * D) + cb * 128 + ci]; }
            __syncthreads();
        }
    }
    { float* rc = (float*)(F.ws + WS_ROPE); float* rs = rc + 2048 * 64;
      for (int idx = blockIdx.x * 512 + F.tid; idx < 2048 * 64; idx += F.G * 512) { const int t = idx >> 6, j = idx & 63, jj = j & 31;
          const float inv = 1.0f / powf(10000.0f, (float)(2 * jj) / 64.0f); const float pos = (float)(j < 32 ? (t >> 6) : (t & 63));
          float s, co; sincosf(pos * inv, &s, &co); rc[idx] = co; rs[idx] = s; } }
    if (blockIdx.x == 0 && F.wave < 2) { const int l = F.wave; const float* dl = ain(a, I_DLAM) + (size_t)l * 4 * 128;
        float s01 = dl[F.lane] * dl[128 + F.lane] + dl[64 + F.lane] * dl[192 + F.lane];
        float s23 = dl[256 + F.lane] * dl[384 + F.lane] + dl[320 + F.lane] * dl[448 + F.lane];
        s01 = wave_sum(s01); s23 = wave_sum(s23);
        const float li = l == 0 ? 0.2f : 0.3555090676f;
        if (F.lane == 0) ((float*)(F.ws + WS_MISC + MISC_LAM))[l] = expf(s01) - expf(s23) + li; }
    { bf16* wr = (bf16*)(F.ws + WS_MISC + MISC_WR);
      for (int idx = blockIdx.x * 512 + F.tid; idx < 2 * 48 * 2048; idx += F.G * 512) { const int l = idx / (48 * 2048), rem = idx % (48 * 2048), e = rem >> 11, k = rem & 2047;
          float w = 0.f; if (e < 4) w = ain(a, I_WGRP)[((size_t)l * D + k) * 4 + e]; else if (e < 36) w = ain(a, I_WRT)[((size_t)l * D + k) * 32 + (e - 4)];
          const unsigned hi = cvt_pk(w, 0.f) & 0xffffu; const float lo = w - bflo(hi);
          wr[((size_t)(l * 2 + 0) * 48 + e) * 2048 + k] = (bf16)hi; wr[((size_t)(l * 2 + 1) * 48 + e) * 2048 + k] = (bf16)(cvt_pk(lo, 0.f) & 0xffffu); } }
    { float* qg = (float*)(F.ws + WS_MISC + MISC_QKG); for (int idx = blockIdx.x * 512 + F.tid; idx < 2 * 4 * 128; idx += F.G * 512) { const int l = idx >> 9, w = (idx >> 7) & 3, k = idx & 127;
          qg[idx] = ain(a, w == 0 ? I_QNA : (w == 1 ? I_KNA : (w == 2 ? I_QNC : I_KNC)))[l * 128 + k]; } }
    { float* spt = (float*)(F.ws + WS_MISC + MISC_SP); for (int idx = blockIdx.x * 512 + F.tid; idx < 2 * 2 * 1024; idx += F.G * 512) spt[idx] = log1pf(expf(-ain(a, I_LLAM)[idx])); }
    { bf16* lw = (bf16*)(F.ws + WS_LRUW);
      for (int idx = blockIdx.x * 512 + F.tid; idx < 2 * 2 * 2 * 8 * 128 * 128; idx += F.G * 512) {
          const int cidx = idx & 127, d = (idx >> 7) & 127, n = (idx >> 14) & 7, dir = (idx >> 17) & 1, mat = (idx >> 18) & 1, l = idx >> 19;
          const float w = ain(a, mat ? I_LWX : I_LWA)[((((size_t)l * 2 + dir) * 8 + n) * 128 + cidx) * 128 + d];
          lw[idx] = (bf16)(cvt_pk(w, 0.f) & 0xffffu); } }
}

__device__ __forceinline__ void row_split(int r, int& b, int& i) { b = r / TB; i = r - b * TB; }
__device__ __forceinline__ size_t hrow_off(int b, int i, bool& ctx) { ctx = i < CTXL; return ctx ? ((size_t)b * CTXL + i) * D : ((size_t)b * SEQ + (i - CTXL)) * D; }

__device__ __forceinline__ void norm_mod(f32x4 (&v)[8], const float* g, const float* shift, const float* scale, int lane) {
    float ss = 0.f;
#pragma unroll
    for (int j = 0; j < 8; ++j) ss += (v[j][0] * v[j][0] + v[j][1] * v[j][1]) + (v[j][2] * v[j][2] + v[j][3] * v[j][3]);
    ss = wave_sum(ss);
    const float rs = rsqrtf(ss * (1.0f / D) + EPS);
#pragma unroll
    for (int j = 0; j < 8; ++j) { const int c = (lane + 64 * j) * 4; const f32x4 gg = *(const f32x4*)(g + c), sh = *(const f32x4*)(shift + c), sc = *(const f32x4*)(scale + c);
        v[j] = v[j] * rs * gg * (sc + 1.0f) + sh; }
}

__device__ __forceinline__ void wave_rows(const Frame& F, int total, int& r0, int& r1) { const int rpw = (total + F.NGW - 1) / F.NGW; r0 = F.gw * rpw; r1 = r0 + rpw < total ? r0 + rpw : total; if (r0 > total) r0 = total; }
__device__ __forceinline__ const bf16* hrow_ptr16(const bf16* hl, const bf16* hc, int r, int& bidx) { int b, i; row_split(r, b, i); bool ctx; const size_t off = hrow_off(b, i, ctx); bidx = ctx ? 8 : b; return (ctx ? hc : hl) + off; }
__device__ __forceinline__ const float* hrow_ptr(const float* hl, const float* hc, int r, int& bidx) { int b, i; row_split(r, b, i); bool ctx; const size_t off = hrow_off(b, i, ctx); bidx = ctx ? 8 : b; return (ctx ? hc : hl) + off; }
__device__ __forceinline__ void pa_norm1(Frame& F, int l) {
    phase_ids(F); l = launder_s(l); KArgs a = kargs();
    const float* hl = l == 0 ? ain(a, I_X) : aout(a); const float* hc = l == 0 ? ain(a, I_CTX) : (const float*)(F.ws + WS_HC);
    const float* mod = (const float*)(F.ws + WS_MOD) + (size_t)l * 9 * (NMOD * D);
    const float* g = ain(a, I_N1G) + (size_t)l * D; bf16* U = (bf16*)(F.ws + WS_ACT); unsigned char* U8 = F.ws + WS_U8;
    int r0, r1; wave_rows(F, ROWS, r0, r1);
    f32x4 cur[8], nxt[8], Gc[8], Sc[8]; int bcur = -1, bi;
    if (r0 < r1) { const f32x4* xr = (const f32x4*)hrow_ptr(hl, hc, r0, bi) + F.lane;
#pragma unroll
        for (int j = 0; j < 8; ++j) cur[j] = xr[64 * j]; }
    for (int r = r0; r < r1; ++r) {
        int bnx = bi;
        if (r + 1 < r1) { const f32x4* xr = (const f32x4*)hrow_ptr(hl, hc, r + 1, bnx) + F.lane;
#pragma unroll
            for (int j = 0; j < 8; ++j) nxt[j] = xr[64 * j]; }
        if (bi != bcur) { bcur = bi; const float* mb = mod + (size_t)bi * (NMOD * D);
#pragma unroll
            for (int j = 0; j < 8; ++j) { const int c = (F.lane + 64 * j) * 4; Gc[j] = *(const f32x4*)(g + c) * (*(const f32x4*)(mb + D + c) + 1.0f); Sc[j] = *(const f32x4*)(mb + c); } }
        float ss = 0.f;
#pragma unroll
        for (int j = 0; j < 8; ++j) ss += (cur[j][0] * cur[j][0] + cur[j][1] * cur[j][1]) + (cur[j][2] * cur[j][2] + cur[j][3] * cur[j][3]);
        ss = wave_sum(ss); const float rs = rsqrtf(ss * (1.0f / D) + EPS);
        v2u* o = (v2u*)(U + (size_t)r * D) + F.lane;
#pragma unroll
        for (int j = 0; j < 8; ++j) { const f32x4 y = cur[j] * rs * Gc[j] + Sc[j]; v2u w; w.x = cvt_pk(y[0], y[1]); w.y = cvt_pk(y[2], y[3]); o[64 * j] = w;
            unsigned q8 = 0u; q8 = __builtin_amdgcn_cvt_pk_fp8_f32(y[0], y[1], q8, false); q8 = __builtin_amdgcn_cvt_pk_fp8_f32(y[2], y[3], q8, true); ((unsigned*)(U8 + (size_t)r * D))[F.lane + 64 * j] = q8; }
#pragma unroll
        for (int j = 0; j < 8; ++j) cur[j] = nxt[j];
        bi = bnx;
    }
}

struct QkCtx { const float *qna, *kna, *qnc, *knc; f32x4 cs, sn; float sgn; int half, li; };
__device__ __forceinline__ int qk_col(const QkCtx& q, int it, const float*& g) {
    const int hidx = 2 * it + q.half; int colbase;
    if (hidx < 8) { colbase = C_AQ + hidx * 128; g = q.qna; } else if (hidx < 16) { colbase = C_AK + (hidx - 8) * 128; g = q.kna; }
    else if (hidx < 24) { colbase = C_CQ + (hidx - 16) * 128; g = q.qnc; } else { colbase = C_CK + (hidx - 24) * 128; g = q.knc; }
    return colbase + 4 * q.li;
}
__device__ __forceinline__ v2u qk_math(const v2u raw, const float* g, const QkCtx& q) {
    f32x4 x = {bflo(raw.x), bfhi(raw.x), bflo(raw.y), bfhi(raw.y)};
    float ss = (x[0] * x[0] + x[1] * x[1]) + (x[2] * x[2] + x[3] * x[3]);
    ss = row16_sum(ss); ss += __shfl_xor(ss, 16);
    const float rn = rsqrtf(ss * (1.0f / 128.0f) + EPS);
    const f32x4 gg = *(const f32x4*)(g + 4 * q.li);
    f32x4 y = x * rn * gg;
    f32x4 pr; pr[0] = dpp_f<0x128>(0.f, y[0]); pr[1] = dpp_f<0x128>(0.f, y[1]); pr[2] = dpp_f<0x128>(0.f, y[2]); pr[3] = dpp_f<0x128>(0.f, y[3]);
    y = y * q.cs + pr * q.sn * q.sgn;
    v2u w; w.x = cvt_pk(y[0], y[1]); w.y = cvt_pk(y[2], y[3]); return w;
}
template <int N> __device__ __forceinline__ void qk_heads(bf16* prow, const QkCtx& q, const int (&its)[N]) {
    v2u raw[N]; int col[N]; const float* g[N];
#pragma unroll
    for (int k = 0; k < N; ++k) { col[k] = qk_col(q, its[k], g[k]); raw[k] = *(const v2u*)(prow + col[k]); }
#pragma unroll
    for (int k = 0; k < N; ++k) raw[k] = qk_math(raw[k], g[k], q);
#pragma unroll
    for (int k = 0; k < N; ++k) *(v2u*)(prow + col[k]) = raw[k];
}
__device__ __forceinline__ void pc_qk(Frame& F, int l) {
    phase_ids(F); l = launder_s(l); KArgs a = kargs();
    bf16* PROJ = (bf16*)(F.ws + WS_PROJ);
    const float* rc = (const float*)(F.ws + WS_ROPE); const float* rs = rc + 2048 * 64;
    QkCtx q; q.qna = ain(a, I_QNA) + l * 128; q.kna = ain(a, I_KNA) + l * 128; q.qnc = ain(a, I_QNC) + l * 128; q.knc = ain(a, I_KNC) + l * 128;
    q.half = F.lane >> 5; q.li = F.lane & 31; q.sgn = (q.li & 8) ? 1.0f : -1.0f;
    for (int r = F.gw; r < ROWS; r += F.NGW) {
        int b, i; row_split(r, b, i); const bool lat = i >= CTXL; const int t = i - CTXL;
        bf16* prow = PROJ + (size_t)r * INC;
        q.cs = (f32x4){1.f, 1.f, 1.f, 1.f}; q.sn = (f32x4){0.f, 0.f, 0.f, 0.f};
        if (lat) { const int ti = t * 64 + (q.li >> 4) * 32 + 4 * (q.li & 7); q.cs = *(const f32x4*)(rc + ti); q.sn = *(const f32x4*)(rs + ti); }
        if (l == 1 && !lat) { const int its[5] = {4, 5, 6, 7, 12}; qk_heads<5>(prow, q, its); }
        else { const int its[13] = {0, 1, 2, 3, 4, 5, 6, 7, 8, 9, 10, 11, 12}; qk_heads<13>(prow, q, its); }
    }
}

template <bool FWD> __device__ __forceinline__ void row_scan(float& A, float& H) {
#define RS_STEP(N) { const float Ap = dpp_f<(FWD ? 0x110 : 0x100) + N>(1.0f, A); const float Hp = dpp_f<(FWD ? 0x110 : 0x100) + N>(0.0f, H); H = fmaf(A, Hp, H); A = A * Ap; }
    RS_STEP(1) RS_STEP(2) RS_STEP(4) RS_STEP(8)
#undef RS_STEP
}
__device__ __forceinline__ void pc_lru(Frame& F, int l) {
    phase_ids(F); l = launder_s(l); KArgs a = kargs();
    const bf16* PROJ = (const bf16*)(F.ws + WS_PROJ);
    bf16* hloc = (bf16*)(F.ws + WS_BIG); bf16* acum = hloc + (size_t)2 * ROWS * 1024;
    float* cA = (float*)(F.ws + WS_CARRY); float* cH = cA + CARRY_N;
    const bf16* LW = (const bf16*)(F.ws + WS_LRUW);
    const float* SP = (const float*)(F.ws + WS_MISC + MISC_SP) + (size_t)l * 2 * 1024;
    const float* convw = ain(a, I_CONVW) + (size_t)l * 4 * 1024; const float* convb = ain(a, I_CONVB) + (size_t)l * 1024;
    const int dir = F.wave >> 2, cq = F.wave & 3, tl = F.lane & 15, q4 = F.lane >> 4;
    const int ct = F.tid >> 4, ch0 = (F.tid & 15) * 8;
    const int NU = NB * NCH * 8;
    int n_cur = -1, n_cw = -1; bf16x8 Wa[2][4], Wx[2][4]; f32x4 ba[2], bx[2], sp[2], cb0, cb1, cw0[4], cw1[4];
    v4u raw[4]; int u = blockIdx.x;
#define LRU_LOAD(U) { const int n_ = (U) & 7, bc_ = (U) >> 3, c_ = bc_ % NCH, b_ = bc_ / NCH; const int r0_ = b_ * TB + c_ * 32; \
        const int lo_ = (c_ < 8) ? b_ * TB : b_ * TB + CTXL, hi_ = (c_ < 8) ? b_ * TB + CTXL : (b_ + 1) * TB; \
        _Pragma("unroll") for (int k = 0; k < 4; ++k) { const int rr = r0_ + ct - 2 + k; raw[k] = (v4u){0u, 0u, 0u, 0u}; \
            if (rr >= lo_ && rr < hi_) raw[k] = *(const v4u*)(PROJ + (size_t)rr * INC + C_BX + n_ * 128 + ch0); } }
    if (u < NU) LRU_LOAD(u);
    int buf = 0;
    for (; u < NU; u += F.G) {
        const int n = u & 7, bc = u >> 3, c = bc % NCH, b = bc / NCH; const int r0 = b * TB + c * 32;
        LAS bf16* xcb = (LAS bf16*)(F.ldsl + buf * 25600); LAS float* xcf = (LAS float*)(F.ldsl + buf * 25600 + 8704);
        if (n != n_cw) { n_cw = n; const int chg = n * 128 + ch0; cb0 = *(const f32x4*)(convb + chg); cb1 = *(const f32x4*)(convb + chg + 4);
#pragma unroll
            for (int k = 0; k < 4; ++k) { cw0[k] = *(const f32x4*)(convw + k * 1024 + chg); cw1[k] = *(const f32x4*)(convw + k * 1024 + chg + 4); } }
        { float acc8[8];
#pragma unroll
          for (int e = 0; e < 4; ++e) { acc8[e] = cb0[e]; acc8[4 + e] = cb1[e]; }
#pragma unroll
          for (int k = 0; k < 4; ++k) { const v4u rw = raw[k];
              const f32x4 w0 = cw0[k], w1 = cw1[k];
              acc8[0] += w0[0] * bflo(rw.x); acc8[1] += w0[1] * bfhi(rw.x); acc8[2] += w0[2] * bflo(rw.y); acc8[3] += w0[3] * bfhi(rw.y);
              acc8[4] += w1[0] * bflo(rw.z); acc8[5] += w1[1] * bfhi(rw.z); acc8[6] += w1[2] * bflo(rw.w); acc8[7] += w1[3] * bfhi(rw.w); }
          v4u pk; pk.x = cvt_pk(acc8[0], acc8[1]); pk.y = cvt_pk(acc8[2], acc8[3]); pk.z = cvt_pk(acc8[4], acc8[5]); pk.w = cvt_pk(acc8[6], acc8[7]);
          *(LAS v4u*)(xcb + ct * 136 + ch0) = pk;
          *(LAS f32x4*)(xcf + ct * 132 + ch0) = (f32x4){acc8[0], acc8[1], acc8[2], acc8[3]}; *(LAS f32x4*)(xcf + ct * 132 + ch0 + 4) = (f32x4){acc8[4], acc8[5], acc8[6], acc8[7]}; }
        __syncthreads();
        if (u + F.G < NU) LRU_LOAD(u + F.G);
        if (n != n_cur) { n_cur = n;
#pragma unroll
            for (int nt = 0; nt < 2; ++nt) { const int chA = cq * 32 + nt * 16 + tl;
#pragma unroll
                for (int k = 0; k < 4; ++k) {
                    Wa[nt][k] = *(const bf16x8*)(LW + ((((size_t)(l * 2 + 0) * 2 + dir) * 8 + n) * 128 + chA) * 128 + k * 32 + q4 * 8);
                    Wx[nt][k] = *(const bf16x8*)(LW + ((((size_t)(l * 2 + 1) * 2 + dir) * 8 + n) * 128 + chA) * 128 + k * 32 + q4 * 8); }
                const int chg = n * 128 + cq * 32 + nt * 16 + 4 * q4;
                ba[nt] = *(const f32x4*)(ain(a, I_LBA) + ((size_t)l * 2 + dir) * 1024 + chg); bx[nt] = *(const f32x4*)(ain(a, I_LBX) + ((size_t)l * 2 + dir) * 1024 + chg);
                sp[nt] = *(const f32x4*)(SP + (size_t)dir * 1024 + chg); } }
#pragma unroll
        for (int nt = 0; nt < 2; ++nt) {
            const int chl = cq * 32 + nt * 16 + 4 * q4;
            f32x4 av[2], hv[2];
#pragma unroll
            for (int mt = 0; mt < 2; ++mt) {
                f32x4 ra = {0.f, 0.f, 0.f, 0.f}, rx = {0.f, 0.f, 0.f, 0.f};
#pragma unroll
                for (int k = 0; k < 4; ++k) { const bf16x8 X = *(const LAS bf16x8*)(xcb + (mt * 16 + tl) * 136 + k * 32 + q4 * 8);
                    ra = __builtin_amdgcn_mfma_f32_16x16x32_bf16(Wa[nt][k], X, ra, 0, 0, 0); rx = __builtin_amdgcn_mfma_f32_16x16x32_bf16(Wx[nt][k], X, rx, 0, 0, 0); }
                const f32x4 xv = *(const LAS f32x4*)(xcf + (mt * 16 + tl) * 132 + chl);
#pragma unroll
                for (int j = 0; j < 4; ++j) { const float rg = sigmoidf_(ra[j] + ba[nt][j]), ig = sigmoidf_(rx[j] + bx[nt][j]);
                    const float la = -8.0f * rg * sp[nt][j]; const float aa = __expf(la); const float mult = __builtin_amdgcn_sqrtf(fmaxf(1.0f - aa * aa, 0.0f));
                    av[mt][j] = aa; hv[mt][j] = mult * ig * xv[j]; }
            }
            f32x4 cAo, cHo;
#pragma unroll
            for (int j = 0; j < 4; ++j) {
                float A0 = av[0][j], H0 = hv[0][j], A1 = av[1][j], H1 = hv[1][j];
                if (dir == 0) { row_scan<true>(A0, H0); row_scan<true>(A1, H1);
                    const float Ac = __shfl(A0, (F.lane & 48) | 15), Hc = __shfl(H0, (F.lane & 48) | 15);
                    H1 = fmaf(A1, Hc, H1); A1 = A1 * Ac; cAo[j] = A1; cHo[j] = H1; }
                else { row_scan<false>(A0, H0); row_scan<false>(A1, H1);
                    const float Ac = __shfl(A1, (F.lane & 48)), Hc = __shfl(H1, (F.lane & 48));
                    H0 = fmaf(A0, Hc, H0); A0 = A0 * Ac; cAo[j] = A0; cHo[j] = H0; }
                av[0][j] = A0; hv[0][j] = H0; av[1][j] = A1; hv[1][j] = H1;
            }
#pragma unroll
            for (int mt = 0; mt < 2; ++mt) { const size_t o = ((size_t)dir * ROWS + r0 + mt * 16 + tl) * 1024 + n * 128 + chl;
                v2u wh, wa; wh.x = cvt_pk(hv[mt][0], hv[mt][1]); wh.y = cvt_pk(hv[mt][2], hv[mt][3]); wa.x = cvt_pk(av[mt][0], av[mt][1]); wa.y = cvt_pk(av[mt][2], av[mt][3]);
                *(v2u*)(hloc + o) = wh; *(v2u*)(acum + o) = wa; }
            if (tl == (dir == 0 ? 15 : 0)) { const size_t ci = (((size_t)dir * NB + b) * NCH + c) * 1024 + n * 128 + chl; *(f32x4*)(cA + ci) = cAo; *(f32x4*)(cH + ci) = cHo; }
        }
        buf ^= 1;
    }
#undef LRU_LOAD
}

__device__ __forceinline__ void pd_chain(Frame& F) {
    phase_ids(F);
    const float* cA = (const float*)(F.ws + WS_CARRY); const float* cH = cA + CARRY_N; float* Hin = (float*)(F.ws + WS_CARRY) + 2 * CARRY_N;
    for (int blk = blockIdx.x; blk < 32; blk += F.G) {
        const int idx = blk * 512 + F.tid, dir = idx >> 13, b = (idx >> 10) & 7, ch = idx & 1023;
        const size_t base = (((size_t)dir * NB + b) * NCH) * 1024 + ch; float H = 0.f;
#pragma unroll 1
        for (int s0 = 0; s0 < NCH; s0 += 24) { float av[24], hv[24];
#pragma unroll
            for (int k = 0; k < 24; ++k) { const int s_ = s0 + k, c = dir == 0 ? s_ : (s_ < 8 ? 7 - s_ : 79 - s_); av[k] = cA[base + (size_t)c * 1024]; hv[k] = cH[base + (size_t)c * 1024]; }
#pragma unroll
            for (int k = 0; k < 24; ++k) { const int s_ = s0 + k, c = dir == 0 ? s_ : (s_ < 8 ? 7 - s_ : 79 - s_); Hin[base + (size_t)c * 1024] = H; H = av[k] * H + hv[k]; } }
    }
}
__device__ __forceinline__ void pd_attn(Frame& F, int l) {
    phase_ids(F); l = launder_s(l);
    const bf16* PROJ = (const bf16*)(F.ws + WS_PROJ); bf16* OA = (bf16*)(F.ws + WS_OA); bf16* YC = (bf16*)(F.ws + WS_YC);
    constexpr int NLAT = 1024, NCTX = 128;
    const int nun = NLAT + (l == 0 ? NCTX : 0);
    for (int u = blockIdx.x; u < nun; u += F.G) {
        int b, q0row, seq, hd; bool diff;
        if (u < NLAT) {
            int qb;
            if (F.G == 256) {
                const int rd = u >> 8, xcd = blockIdx.x & 7, slot = blockIdx.x >> 3; qb = slot & 7; diff = rd < 2;
                if (diff) { const int gi = (rd * 8 + xcd) * 2 + (slot >> 4); b = gi >> 2; hd = (gi & 3) * 2 + ((slot >> 3) & 1); }
                else { const int gi = (rd - 2) * 8 + xcd; b = gi >> 1; hd = (gi & 1) * 4 + (slot >> 3); }
            } else { diff = u < 512; const int v = u & 511; qb = v & 7; hd = (v >> 3) & 7; b = v >> 6; }
            q0row = b * TB + CTXL + qb * 256; seq = TB; }
        else { const int v = u - NLAT; diff = v < 64; hd = v & 7; b = (v & 63) >> 3; q0row = b * TB; seq = CTXL; }
        const bf16* kb = PROJ + (size_t)b * TB * INC; const bf16* qp = PROJ + (size_t)q0row * INC;
        if (diff) att::attn_dv256_body<8>(qp + C_AQ + hd * 128, kb + C_AK + hd * 128, kb + C_AV + (hd >> 1) * 256, OA + (size_t)q0row * D + hd * 256, D, seq, (char*)F.lds, F.ldsl);
        else att::attn_dv256_body<4>(qp + C_CQ + hd * 128, kb + C_CK + (hd >> 2) * 128, kb + C_CV + (hd >> 2) * 128, YC + (size_t)q0row * 1024 + hd * 128, 1024, seq, (char*)F.lds, F.ldsl);
    }
}

__device__ __forceinline__ void pe_combine(Frame& F, int l) {
    phase_ids(F); l = launder_s(l); KArgs a = kargs();
    const bf16* OA = (const bf16*)(F.ws + WS_OA); bf16* YA = (bf16*)(F.ws + WS_YA); bf16* YB = (bf16*)(F.ws + WS_YB); const bf16* PROJ = (const bf16*)(F.ws + WS_PROJ);
    const bf16* hloc = (const bf16*)(F.ws + WS_BIG); const bf16* acum = hloc + (size_t)2 * ROWS * 1024;
    const float* Hin = (const float*)(F.ws + WS_CARRY) + 2 * CARRY_N;
    const float lam = ((const float*)(F.ws + WS_MISC + MISC_LAM))[l]; const float omli = 1.0f - (l == 0 ? 0.2f : 0.3555090676f);
    const f32x4 sg = *(const f32x4*)(ain(a, I_SUBN) + (size_t)l * 256 + 4 * F.lane);
    int r0, r1; wave_rows(F, ROWS, r0, r1);
#define PE_SKIP(r) (l == 1 && ((r) % TB) < CTXL)
    { v2u cur[8], nxt[8]; int r = r0; while (r < r1 && PE_SKIP(r)) ++r; bool have = r < r1;
      if (have) {
#pragma unroll
          for (int m = 0; m < 8; ++m) cur[m] = __builtin_nontemporal_load((const v2u*)(OA + (size_t)r * D + m * 256 + 4 * F.lane)); }
      while (have) {
          int rn = r + 1; while (rn < r1 && PE_SKIP(rn)) ++rn; const bool hn = rn < r1;
          if (hn) {
#pragma unroll
              for (int m = 0; m < 8; ++m) nxt[m] = __builtin_nontemporal_load((const v2u*)(OA + (size_t)rn * D + m * 256 + 4 * F.lane)); }
#pragma unroll
          for (int h = 0; h < 4; ++h) { const v2u p = cur[2 * h], q = cur[2 * h + 1];
              f32x4 o = {bflo(p.x) - lam * bflo(q.x), bfhi(p.x) - lam * bfhi(q.x), bflo(p.y) - lam * bflo(q.y), bfhi(p.y) - lam * bfhi(q.y)};
              float ss = (o[0] * o[0] + o[1] * o[1]) + (o[2] * o[2] + o[3] * o[3]); ss = wave_sum(ss);
              const float rn2 = rsqrtf(ss * (1.0f / 256.0f) + EPS) * omli;
              o = o * rn2 * sg; v2u w; w.x = cvt_pk(o[0], o[1]); w.y = cvt_pk(o[2], o[3]); *(v2u*)(YA + (size_t)r * 1024 + h * 256 + 4 * F.lane) = w; }
#pragma unroll
          for (int m = 0; m < 8; ++m) cur[m] = nxt[m];
          r = rn; have = hn; } }
    { v4u cur[2][5], nxt[2][5]; f32x4 Hf[2][2], Hb[2][2]; int ccur = -1;
#define PE_LD(X, r) { _Pragma("unroll") for (int hv = 0; hv < 2; ++hv) { const int ch = F.lane * 16 + hv * 8; \
          X[hv][0] = __builtin_nontemporal_load((const v4u*)(hloc + (size_t)(r) * 1024 + ch)); X[hv][1] = __builtin_nontemporal_load((const v4u*)(acum + (size_t)(r) * 1024 + ch)); \
          X[hv][2] = __builtin_nontemporal_load((const v4u*)(hloc + ((size_t)ROWS + (r)) * 1024 + ch)); X[hv][3] = __builtin_nontemporal_load((const v4u*)(acum + ((size_t)ROWS + (r)) * 1024 + ch)); \
          X[hv][4] = *(const v4u*)(PROJ + (size_t)(r) * INC + C_BY + ch); } }
      int r = r0; while (r < r1 && PE_SKIP(r)) ++r; bool have = r < r1;
      if (have) PE_LD(cur, r);
      while (have) {
          int rn = r + 1; while (rn < r1 && PE_SKIP(rn)) ++rn; const bool hn = rn < r1;
          if (hn) PE_LD(nxt, rn);
          const int b = r / TB, i = r - b * TB, c = i >> 5, cc = b * NCH + c;
          if (cc != ccur) { ccur = cc; const size_t hf = ((size_t)(0 * NB + b) * NCH + c) * 1024, hb = ((size_t)(1 * NB + b) * NCH + c) * 1024;
#pragma unroll
              for (int hv = 0; hv < 2; ++hv) { const int ch = F.lane * 16 + hv * 8;
                  Hf[hv][0] = *(const f32x4*)(Hin + hf + ch); Hf[hv][1] = *(const f32x4*)(Hin + hf + ch + 4); Hb[hv][0] = *(const f32x4*)(Hin + hb + ch); Hb[hv][1] = *(const f32x4*)(Hin + hb + ch + 4); } }
#pragma unroll
          for (int hv = 0; hv < 2; ++hv) { const int ch = F.lane * 16 + hv * 8;
              const v4u lf = cur[hv][0], af = cur[hv][1], lb = cur[hv][2], ab = cur[hv][3], by = cur[hv][4];
              const f32x4 Hf0 = Hf[hv][0], Hf1 = Hf[hv][1], Hb0 = Hb[hv][0], Hb1 = Hb[hv][1];
              float y[8];
#define FIX(e, LF, AF, LB, AB, BY, HF, HB, GET) { const float hsum = GET(LF) + GET(AF) * HF + GET(LB) + GET(AB) * HB; const float x = GET(BY); \
                  const float u2 = 0.7978845608f * (x + 0.044715f * x * x * x); const float th = 1.0f - 2.0f * __builtin_amdgcn_rcpf(1.0f + __expf(2.0f * u2)); y[e] = hsum * 0.5f * x * (1.0f + th); }
              FIX(0, lf.x, af.x, lb.x, ab.x, by.x, Hf0[0], Hb0[0], bflo) FIX(1, lf.x, af.x, lb.x, ab.x, by.x, Hf0[1], Hb0[1], bfhi)
              FIX(2, lf.y, af.y, lb.y, ab.y, by.y, Hf0[2], Hb0[2], bflo) FIX(3, lf.y, af.y, lb.y, ab.y, by.y, Hf0[3], Hb0[3], bfhi)
              FIX(4, lf.z, af.z, lb.z, ab.z, by.z, Hf1[0], Hb1[0], bflo) FIX(5, lf.z, af.z, lb.z, ab.z, by.z, Hf1[1], Hb1[1], bfhi)
              FIX(6, lf.w, af.w, lb.w, ab.w, by.w, Hf1[2], Hb1[2], bflo) FIX(7, lf.w, af.w, lb.w, ab.w, by.w, Hf1[3], Hb1[3], bfhi)
#undef FIX
              v4u w; w.x = cvt_pk(y[0], y[1]); w.y = cvt_pk(y[2], y[3]); w.z = cvt_pk(y[4], y[5]); w.w = cvt_pk(y[6], y[7]);
              *(v4u*)(YB + (size_t)r * 1024 + ch) = w; }
#pragma unroll
          for (int hv = 0; hv < 2; ++hv)
#pragma unroll
              for (int k = 0; k < 5; ++k) cur[hv][k] = nxt[hv][k];
          r = rn; have = hn; }
#undef PE_LD
    }
#undef PE_SKIP
}

__device__ __forceinline__ void ph_norm2_route(Frame& F, int l) {
    phase_ids(F); l = launder_s(l); KArgs a = kargs();
    const bf16* hl = (const bf16*)(F.ws + WS_H16L); const bf16* hc = (const bf16*)(F.ws + WS_HC);
    const float* mod = (const float*)(F.ws + WS_MOD) + (size_t)l * 9 * (NMOD * D);
    const float* g = ain(a, I_N2G) + (size_t)l * D; unsigned char* V8 = F.ws + WS_V8;
    LAS bf16* Thi = (LAS bf16*)F.ldsl; LAS bf16* Tlo = (LAS bf16*)(F.ldsl + 65792);
    LAS float* red = (LAS float*)F.ldsl;
    LAS float* logit = (LAS float*)(F.ldsl + 24576);
    const bf16* wr = (const bf16*)(F.ws + WS_MISC + MISC_WR) + (size_t)l * 2 * 48 * 2048;
    unsigned* cnt = (unsigned*)(F.ws + WS_CTL) + CW_CNT + 64 * l;
    int* tok_e = (int*)(F.ws + WS_ROUTE + RT_E); int* tok_pos = (int*)(F.ws + WS_ROUTE + RT_POS); float* tok_p = (float*)(F.ws + WS_ROUTE + RT_P);
    int* list = (int*)(F.ws + WS_BIG);
    const int l15 = F.lane & 15, l4 = F.lane >> 4;
    const int nblk = l == 1 ? NB * (SEQ / 16) : ROWS / 16;
    bf16x8 PBh[4][3], PBl[4][3];
#pragma unroll
    for (int ks = 0; ks < 4; ++ks) { const int k0 = (F.wave * 8 + ks) * 32 + l4 * 8;
#pragma unroll
        for (int ct = 0; ct < 3; ++ct) { PBh[ks][ct] = *(const bf16x8*)(wr + (size_t)(ct * 16 + l15) * 2048 + k0); PBl[ks][ct] = *(const bf16x8*)(wr + (size_t)(48 + ct * 16 + l15) * 2048 + k0); } }
    int pe1 = 0, pe2 = 0, pr = -1; unsigned pp1 = 0u, pp2 = 0u;
#define PH_FLUSH() do { if (F.tid < 16 && pr >= 0) { list[(size_t)pe1 * pg8::LCAP + pp1] = 2 * pr; list[(size_t)pe2 * pg8::LCAP + pp2] = 2 * pr + 1; tok_pos[2 * pr] = (int)pp1; tok_pos[2 * pr + 1] = (int)pp2; } } while (0)
    for (int vb = blockIdx.x; vb < nblk; vb += F.G) {
        const int blk = l == 1 ? (vb / (SEQ / 16)) * (TB / 16) + CTXL / 16 + vb % (SEQ / 16) : vb;
#pragma unroll
        for (int rr = 0; rr < 2; ++rr) { const int lr = F.wave * 2 + rr, r = blk * 16 + lr;
            int b, i; row_split(r, b, i); bool ctx; const size_t off = hrow_off(b, i, ctx);
            const v2u* xr = (const v2u*)((ctx ? hc : hl) + off) + F.lane;
            f32x4 v[8]; v2u xv[8];
#pragma unroll
            for (int j = 0; j < 8; ++j) xv[j] = xr[64 * j];
#pragma unroll
            for (int j = 0; j < 8; ++j) v[j] = (f32x4){bflo(xv[j].x), bfhi(xv[j].x), bflo(xv[j].y), bfhi(xv[j].y)};
            const float* mb = mod + (size_t)(ctx ? 8 : b) * (NMOD * D);
            norm_mod(v, g, mb + 3 * D, mb + 4 * D, F.lane);
#pragma unroll
            for (int j = 0; j < 8; ++j) { v2u w; w.x = cvt_pk(v[j][0], v[j][1]); w.y = cvt_pk(v[j][2], v[j][3]);
                { unsigned q8 = 0u; q8 = __builtin_amdgcn_cvt_pk_fp8_f32(v[j][0], v[j][1], q8, false); q8 = __builtin_amdgcn_cvt_pk_fp8_f32(v[j][2], v[j][3], q8, true); ((unsigned*)(V8 + (size_t)r * D))[F.lane + 64 * j] = q8; }
                v2u wl; wl.x = cvt_pk(v[j][0] - bflo(w.x), v[j][1] - bfhi(w.x)); wl.y = cvt_pk(v[j][2] - bflo(w.y), v[j][3] - bfhi(w.y));
                *(LAS v2u*)(Thi + lr * 2056 + (F.lane + 64 * j) * 4) = w; *(LAS v2u*)(Tlo + lr * 2056 + (F.lane + 64 * j) * 4) = wl; } }
        __syncthreads();
        f32x4 acc[3];
#pragma unroll
        for (int ct = 0; ct < 3; ++ct) acc[ct] = (f32x4){0.f, 0.f, 0.f, 0.f};
#pragma unroll
        for (int ks = 0; ks < 4; ++ks) { const int k0 = (F.wave * 8 + ks) * 32 + l4 * 8;
            const bf16x8 Ah = *(const LAS bf16x8*)(Thi + l15 * 2056 + k0), Al = *(const LAS bf16x8*)(Tlo + l15 * 2056 + k0);
#pragma unroll
            for (int ct = 0; ct < 3; ++ct) {
                acc[ct] = __builtin_amdgcn_mfma_f32_16x16x32_bf16(Ah, PBh[ks][ct], acc[ct], 0, 0, 0);
                acc[ct] = __builtin_amdgcn_mfma_f32_16x16x32_bf16(Ah, PBl[ks][ct], acc[ct], 0, 0, 0);
                acc[ct] = __builtin_amdgcn_mfma_f32_16x16x32_bf16(Al, PBh[ks][ct], acc[ct], 0, 0, 0); } }
#pragma unroll 2
        for (int ks = 4; ks < 8; ++ks) { const int k0 = (F.wave * 8 + ks) * 32 + l4 * 8;
            const bf16x8 Ah = *(const LAS bf16x8*)(Thi + l15 * 2056 + k0), Al = *(const LAS bf16x8*)(Tlo + l15 * 2056 + k0);
#pragma unroll
            for (int ct = 0; ct < 3; ++ct) { const bf16x8 Bh = *(const bf16x8*)(wr + (size_t)(ct * 16 + l15) * 2048 + k0), Bl = *(const bf16x8*)(wr + (size_t)(48 + ct * 16 + l15) * 2048 + k0);
                acc[ct] = __builtin_amdgcn_mfma_f32_16x16x32_bf16(Ah, Bh, acc[ct], 0, 0, 0);
                acc[ct] = __builtin_amdgcn_mfma_f32_16x16x32_bf16(Ah, Bl, acc[ct], 0, 0, 0);
                acc[ct] = __builtin_amdgcn_mfma_f32_16x16x32_bf16(Al, Bh, acc[ct], 0, 0, 0); } }
        __syncthreads();
#pragma unroll
        for (int ct = 0; ct < 3; ++ct)
#pragma unroll
            for (int j = 0; j < 4; ++j) red[(F.wave * 16 + l4 * 4 + j) * 48 + ct * 16 + l15] = acc[ct][j];
        __syncthreads();
        for (int o = F.tid; o < 16 * 36; o += 512) { const int row = o / 36, e = o % 36; float s = 0.f;
#pragma unroll
            for (int w = 0; w < 8; ++w) s += red[(w * 16 + row) * 48 + e];
            s += e < 4 ? ain(a, I_BGRP)[l * 4 + e] : ain(a, I_BRT)[l * 32 + (e - 4)];
            logit[o] = s; }
        __syncthreads();
        if (F.tid < 16) { const LAS float* lg = logit + F.tid * 36; const int r = blk * 16 + F.tid;
            int gi = 0; float gm = lg[0];
            for (int e = 1; e < 4; ++e) { const float v = lg[e]; if (v > gm) { gm = v; gi = e; } }
            float gs = 0.f; for (int e = 0; e < 4; ++e) gs += expf(lg[e] - gm);
            const float gw = 1.0f / gs;
            const LAS float* el = lg + 4 + gi * 8;
            int i1 = 0; float v1 = el[0];
            for (int e = 1; e < 8; ++e) { const float v = el[e]; if (v > v1) { v1 = v; i1 = e; } }
            int i2 = -1; float v2 = -3.0e38f;
            for (int e = 0; e < 8; ++e) { const float v = el[e]; if (e != i1 && v > v2) { v2 = v; i2 = e; } }
            const float p1 = 1.0f / (1.0f + expf(v2 - v1)); const float p2 = 1.0f - p1;
            const int e1 = gi * 8 + i1, e2 = gi * 8 + i2;
            PH_FLUSH();
            pp1 = atomicAdd(&cnt[e1], 1u); pp2 = atomicAdd(&cnt[e2], 1u); pe1 = e1; pe2 = e2; pr = r;
            tok_e[2 * r] = e1; tok_e[2 * r + 1] = e2; tok_p[2 * r] = p1 * gw; tok_p[2 * r + 1] = p2 * gw; }
        __syncthreads();
    }
    PH_FLUSH();
#undef PH_FLUSH
}


constexpr int LDS_TAB_OFF = LDS_MISC_OFF + 64;
__device__ __forceinline__ LAS int* moe_tables(Frame& F, int l) {
    LAS int* tab = (LAS int*)(F.ldsl + LDS_TAB_OFF);
    const unsigned* cnt = (const unsigned*)(F.ws + WS_CTL) + CW_CNT + 64 * l;
    if (F.tid == 0) { int run = 0, nt = 0;
        for (int e = 0; e < NE; ++e) { const int c = (int)__hip_atomic_load(&cnt[e], __ATOMIC_RELAXED, __HIP_MEMORY_SCOPE_AGENT); tab[pg8::MT_CNT + e] = c; tab[pg8::MT_BASE + e] = run;
            const int n = (c + 255) >> 8; for (int t = 0; t < n; ++t) { tab[pg8::MT_E + nt] = e; tab[pg8::MT_P0 + nt] = t * 256; ++nt; } run += n * 256; }
        tab[pg8::MT_BASE + NE] = run; tab[0] = nt; }
    __syncthreads();
    return tab;
}

template <bool FUSE> __device__ __forceinline__ void pl_moe_combine(Frame& F, int l) {
    phase_ids(F); l = launder_s(l); KArgs a = kargs();
    bf16* hl = (bf16*)(F.ws + WS_H16L); bf16* hc = (bf16*)(F.ws + WS_HC); float* outl = aout(a);
    const float* mod = (const float*)(F.ws + WS_MOD) + (size_t)l * 9 * (NMOD * D);
    const bf16* YS = (const bf16*)(F.ws + WS_BIG);
    const int* tok_e = (const int*)(F.ws + WS_ROUTE + RT_E); const int* tok_pos = (const int*)(F.ws + WS_ROUTE + RT_POS); const float* tok_p = (const float*)(F.ws + WS_ROUTE + RT_P);
    const LAS int* tab = moe_tables(F, l);
    int r0, r1; wave_rows(F, ROWS, r0, r1);
    int md0 = 0, md1 = 0; float mp0 = 0.f, mp1 = 0.f;
    if (r0 + F.lane < r1) { const int r = r0 + F.lane; md0 = tab[pg8::MT_BASE + (tok_e[2 * r] & 31)] + tok_pos[2 * r]; md1 = tab[pg8::MT_BASE + (tok_e[2 * r + 1] & 31)] + tok_pos[2 * r + 1]; mp0 = tok_p[2 * r]; mp1 = tok_p[2 * r + 1]; }
    f32x4 hcur[8]; v2u hcr[8], hnxt[8]; v2u y0c[8], y1c[8], y0n[8], y1n[8]; int bi = 0; bool have = false;
    f32x4 Gc[8], Sc[8]; int bgc = -1; const float* modn = (const float*)(F.ws + WS_MOD) + (size_t)(l + 1) * 9 * (NMOD * D); const float* gn = ain(a, I_N1G) + (size_t)(l + 1) * D;
    bf16* U = (bf16*)(F.ws + WS_ACT); unsigned char* U8 = F.ws + WS_U8;
#define PL_SKIP(r) (l == 1 && ((r) % TB) < CTXL)
#define PL_LOAD(H, Y0, Y1, r, BI) { const v2u* hp_ = (const v2u*)hrow_ptr16(hl, hc, (r), BI) + F.lane; const int k_ = (r) - r0; \
        const int d0_ = __shfl(md0, k_), d1_ = __shfl(md1, k_); const v2u* a0_ = (const v2u*)(YS + (size_t)d0_ * D) + F.lane; const v2u* a1_ = (const v2u*)(YS + (size_t)d1_ * D) + F.lane; \
        _Pragma("unroll") for (int j = 0; j < 8; ++j) { H[j] = hp_[64 * j]; Y0[j] = __builtin_nontemporal_load(a0_ + 64 * j); Y1[j] = __builtin_nontemporal_load(a1_ + 64 * j); } }
    int r = r0; while (r < r1 && PL_SKIP(r)) ++r;
    if (r < r1) { PL_LOAD(hcr, y0c, y1c, r, bi); have = true; }
    while (have) {
        int rn = r + 1; while (rn < r1 && PL_SKIP(rn)) ++rn;
        int bnx = bi; const bool hn = rn < r1;
        if (hn) PL_LOAD(hnxt, y0n, y1n, rn, bnx);
        const float p0 = __shfl(mp0, r - r0), p1 = __shfl(mp1, r - r0);
        const float* mg = mod + (size_t)bi * (NMOD * D) + 5 * D;
        int bdummy; bf16* hp = (bf16*)hrow_ptr16(hl, hc, r, bdummy);
        float* op; { int b_, i_; row_split(r, b_, i_); bool cx_; op = outl + hrow_off(b_, i_, cx_); }
#pragma unroll
        for (int j = 0; j < 8; ++j) { const int c = (F.lane + 64 * j) * 4; const v2u u0 = y0c[j], u1 = y1c[j], hx = hcr[j];
            const f32x4 g = *(const f32x4*)(mg + c); f32x4 h = {bflo(hx.x), bfhi(hx.x), bflo(hx.y), bfhi(hx.y)};
            h[0] += g[0] * (p0 * bflo(u0.x) + p1 * bflo(u1.x)); h[1] += g[1] * (p0 * bfhi(u0.x) + p1 * bfhi(u1.x));
            h[2] += g[2] * (p0 * bflo(u0.y) + p1 * bflo(u1.y)); h[3] += g[3] * (p0 * bfhi(u0.y) + p1 * bfhi(u1.y));
            if constexpr (FUSE) { v2u w; w.x = cvt_pk(h[0], h[1]); w.y = cvt_pk(h[2], h[3]); *(v2u*)(hp + c) = w; } else *(f32x4*)(op + c) = h;
            hcur[j] = h; }
        if constexpr (FUSE) {
            if (bi != bgc) { bgc = bi; const float* mb = modn + (size_t)bi * (NMOD * D);
#pragma unroll
                for (int j = 0; j < 8; ++j) { const int c = (F.lane + 64 * j) * 4; Gc[j] = *(const f32x4*)(gn + c) * (*(const f32x4*)(mb + D + c) + 1.0f); Sc[j] = *(const f32x4*)(mb + c); } }
            float ss = 0.f;
#pragma unroll
            for (int j = 0; j < 8; ++j) ss += (hcur[j][0] * hcur[j][0] + hcur[j][1] * hcur[j][1]) + (hcur[j][2] * hcur[j][2] + hcur[j][3] * hcur[j][3]);
            ss = wave_sum(ss); const float rs = rsqrtf(ss * (1.0f / D) + EPS);
            v2u* o = (v2u*)(U + (size_t)r * D) + F.lane;
#pragma unroll
            for (int j = 0; j < 8; ++j) { const f32x4 y = hcur[j] * rs * Gc[j] + Sc[j]; v2u w; w.x = cvt_pk(y[0], y[1]); w.y = cvt_pk(y[2], y[3]); o[64 * j] = w;
                unsigned q8 = 0u; q8 = __builtin_amdgcn_cvt_pk_fp8_f32(y[0], y[1], q8, false); q8 = __builtin_amdgcn_cvt_pk_fp8_f32(y[2], y[3], q8, true); ((unsigned*)(U8 + (size_t)r * D))[F.lane + 64 * j] = q8; } }
#pragma unroll
        for (int j = 0; j < 8; ++j) { hcr[j] = hnxt[j]; y0c[j] = y0n[j]; y1c[j] = y1n[j]; }
        r = rn; bi = bnx; have = hn;
    }
#undef PL_LOAD
#undef PL_SKIP
}

constexpr int PH_PER_LAYER = 12, N_PHASES = 1 + 2 * PH_PER_LAYER;
#ifndef PHMASK
#define PHMASK 0xffffffffu
#endif
#define EN(j) ((PHMASK >> (j)) & 1u)
#define IN(k) (lo <= (k) && (k) < hi)
#ifndef TIMEPH
#define TIMEPH (-1)
#endif
struct Tm { int unused; };
#define TMW ((volatile LAS unsigned long long*)(F.ldsl + LDS_MISC_OFF + 16))
#define SEAM(k) do { if (IN(k) && IN((k) + 1)) xcd_barrier(bar); \
    if constexpr (TIMEPH >= 0) { if (__builtin_amdgcn_readfirstlane(threadIdx.x) == 0) { const unsigned long long now_ = __builtin_amdgcn_s_memrealtime(); if (((k) == 0 ? 0 : 1 + ((k) - 1) % PH_PER_LAYER) == TIMEPH) TMW[1] += now_ - TMW[0]; TMW[0] = now_; } } } while (0)
#ifndef REPMASK
#define REPMASK 0u
#endif
#define RUNPH(j, k, ...) if (EN(j) && IN(p + k)) { { __VA_ARGS__ } if constexpr (((REPMASK) >> (j)) & 1u) { __syncthreads(); { __VA_ARGS__ } } }
template <int l> __device__ __forceinline__ void layer_phases(Frame& F, const int lo, const int hi, const XcdBarrier& bar, Tm& tm) {
        constexpr int p = 1 + l * PH_PER_LAYER;
        constexpr int LAT = (l == 1);
        constexpr int NPAN = LAT ? 64 : 72;
        RUNPH(1, 0,  if (l == 0) pa_norm1(F, l); else conv_weights(F, l, CV_O_OUT, CV_O_W13, 0); )
        SEAM(p + 0);
        RUNPH(2, 1,
            { phase_ids(F); unsigned char* ws = F.ws;
              pg8::Gemm1Order S{pg8::make_gb((const bf16*)(ws + WS_ACT), D, (const bf16*)(ws + WS_WIN), D), F.G, (int)blockIdx.x, LAT, C_G / 256};
              const int ll = launder_s(l); const float* rc = (const float*)(ws + WS_ROPE);
              pg8::EpiProj E{(bf16*)(ws + WS_PROJ), INC, (const float*)(ws + WS_MISC + MISC_QKG) + ll * 512, rc, rc + 2048 * 64, (LAS float*)(F.ldsl + LDS_SSX_OFF)};
              pg8::gemm_phase(F.ldsl, D, D, D, S, E); }
            { phase_ids(F); unsigned char* ws = F.ws; KArgs a = kargs(); const int ll = launder_s(l);
              pg8::StaticOrder S{pg8::make_gb(ws + WS_U8, D, ws + WS_WING8, D, 1), NPAN, (INC - C_G) / 256, F.G, (int)blockIdx.x, LAT};
              pg8::EpiBf16T<true> E{(bf16*)(ws + WS_PROJ), INC, 0xffff, ain(a, I_BGATE) + (size_t)ll * 3 * D, C_G / 256, 1.0f / 64.0f}; pg8::gemm_phase<pg8::EpiBf16T<true>, pg8::StaticOrder, 1>(F.ldsl, D, D, D, S, E); }
            if (l == 0) { __syncthreads(); conv_weights(F, 0, CV_O_BR, CV_O_W13, (72 * 26) % F.G); __syncthreads(); conv_weights(F, 1, CV_O_W13, CV_O_W13 + 8192, (72 * 26) % F.G); } )
        SEAM(p + 1);
        if (EN(3) && IN(p + 2)) { pc_lru(F, l); if constexpr (((REPMASK) >> 3) & 1u) { __syncthreads(); pc_lru(F, l); } }
        SEAM(p + 2);
        RUNPH(4, 3,  pd_chain(F); pd_attn(F, l); )
        SEAM(p + 3);
        RUNPH(5, 4,  pe_combine(F, l); )
        SEAM(p + 4);
        RUNPH(6, 5,  phase_ids(F); unsigned char* ws = F.ws;
            pg8::BranchOrder S{ pg8::StaticOrder{pg8::make_gb((const bf16*)(ws + WS_YA), 1024, (const bf16*)(ws + WS_WBR), 1024), NPAN, D / 256, F.G, (int)blockIdx.x, LAT},
                                (size_t)(WS_YB - WS_YA) };
            static_assert(WS_YC - WS_YB == WS_YB - WS_YA, "branch inputs equally spaced");
            pg8::EpiChain E{(bf16*)(ws + WS_ACT), (const bf16*)(ws + WS_PROJ)}; pg8::gemm_phase(F.ldsl, 1024, 1024, 1024, S, E);
            if (l == 0) { __syncthreads(); conv_weights(F, 0, CV_O_W13, CV_O_W2, (72 * 8) % F.G); __syncthreads(); conv_weights(F, 1, CV_O_W13 + 10240, CV_NIT, (72 * 8) % F.G); } )
        SEAM(p + 5);
        RUNPH(7, 6,  phase_ids(F); unsigned char* ws = F.ws; KArgs a = kargs(); const int ll = launder_s(l);
            pg8::StaticOrder S{pg8::make_gb((const bf16*)(ws + WS_ACT), D, (const bf16*)(ws + WS_WOUT), D), NPAN, D / 256, F.G, (int)blockIdx.x, LAT};
            pg8::EpiWout<l != 0> E{l == 0 ? (const void*)ain(a, I_X) : (const void*)(ws + WS_H16L), l == 0 ? (const void*)ain(a, I_CTX) : (const void*)(ws + WS_HC), (bf16*)(ws + WS_H16L), (bf16*)(ws + WS_HC), (const float*)(ws + WS_MOD) + (size_t)ll * 9 * (NMOD * D)};
            pg8::gemm_phase(F.ldsl, D, D, D, S, E);
            if (l == 0) { __syncthreads(); conv_weights(F, 0, CV_O_W2, CV_NIT, (72 * 8) % F.G); __syncthreads(); conv_weights(F, 1, 0, CV_O_OUT, (72 * 8) % F.G); __syncthreads(); conv_weights(F, 1, CV_O_W13 + 8192, CV_O_W13 + 10240, (72 * 8) % F.G); } )
        SEAM(p + 6);
        RUNPH(8, 7,  ph_norm2_route(F, l); )
        SEAM(p + 7);
        RUNPH(10, 9,  phase_ids(F); unsigned char* ws = F.ws; const LAS int* tab = moe_tables(F, l);
            pg8::MoeOrderG S{pg8::make_gb(ws + WS_V8, D, ws + (l ? WS_W13B : WS_W13), D, 1), tab, (const int*)(ws + WS_BIG), (unsigned)D, 4, F.G, (int)blockIdx.x};
            pg8::EpiUp E{(bf16*)(ws + WS_OA), 1.0f / 64.0f}; pg8::gemm_phase<pg8::EpiUp, pg8::MoeOrderG, 1>(F.ldsl, D, D, D, S, E); )
        SEAM(p + 9);
        RUNPH(11, 10,  phase_ids(F); unsigned char* ws = F.ws; const LAS int* tab = moe_tables(F, l);
            pg8::MoeOrder S{pg8::make_gb((const bf16*)(ws + WS_OA), DE, (const bf16*)(ws + (l ? WS_W2B : WS_W2)), DE), tab, nullptr, 0u, 8, F.G, (int)blockIdx.x};
            pg8::EpiBf16 E{(bf16*)(ws + WS_BIG), D, 7, nullptr, 0, 1.0f}; pg8::gemm_phase(F.ldsl, DE, DE, DE, S, E); )
        SEAM(p + 10);
        RUNPH(12, 11,  pl_moe_combine<l == 0>(F, l); )
        if (l != 0) SEAM(p + 11);
}
__global__ void __launch_bounds__(512, 2) mega_fwd(Args args) {
    extern __shared__ __attribute__((aligned(16))) unsigned char lds[];
    Frame F;
    F.lds0 = lds; F.lds = lds; F.ldsl = (LAS unsigned char*)lds; F.ws = args.ws;
    F.tid = threadIdx.x; F.lane = F.tid & 63; F.wave = __builtin_amdgcn_readfirstlane(F.tid >> 6);
    F.G = gridDim.x; F.gw = blockIdx.x * 8 + F.wave; F.NGW = F.G * 8;
    volatile LAS unsigned* misc = (volatile LAS unsigned*)(F.ldsl + LDS_MISC_OFF);
    if (F.tid < 4) misc[F.tid] = 0u;
    __syncthreads();
    const int lo = args.ph_lo, hi = args.ph_hi;
    XcdBarrier bar; bar.bar = (unsigned*)(args.ws + WS_CTL) + CW_BAR; bar.x = 0; bar.st = misc;
    if (hi - lo > 1) bar = xcd_barrier_post((unsigned*)(args.ws + WS_CTL) + CW_BAR, misc);
    Tm tm; tm.unused = 0; if constexpr (TIMEPH >= 0) { if (__builtin_amdgcn_readfirstlane(threadIdx.x) == 0) { TMW[0] = __builtin_amdgcn_s_memrealtime(); TMW[1] = 0ull; } }
    if (EN(0) && IN(0)) { p0_misc(F); __syncthreads(); if (F.G == 256) { conv_weights(F, 0, 0, 1600, 192); __syncthreads(); conv_weights(F, 0, 1600, CV_O_BR, 0); } else conv_weights(F, 0, 0, CV_O_BR, 0); }
    SEAM(0);
    layer_phases<0>(F, lo, hi, bar, tm);
    layer_phases<1>(F, lo, hi, bar, tm);
    if constexpr (TIMEPH >= 0) { xcd_barrier(bar); if (blockIdx.x == 0 && threadIdx.x == 0) args.out[0] = (float)TMW[1]; }
#undef IN
#undef SEAM
}

#ifndef MK_SINGLE
#define MK_SINGLE 1
#endif
extern "C" void kernel_launch(void* const* d_in, const int* in_sizes, int n_in, void* d_out, int out_size, void* d_ws, size_t ws_size, hipStream_t stream) {
    static int grid = 0;
    if (grid == 0) {
        if (n_in != 34 || out_size != NB * SEQ * D || ws_size < WS_END) { fprintf(stderr, "kernel_launch: unexpected shapes (n_in %d out %d ws %zu, need ws >= %zu)\n", n_in, out_size, ws_size, (size_t)WS_END); grid = -1; return; }
        int dev = 0, cus = 0, per_cu = 0;
        if (hipGetDevice(&dev) != hipSuccess || hipDeviceGetAttribute(&cus, hipDeviceAttributeMultiprocessorCount, dev) != hipSuccess) { grid = -1; return; }
        if (hipFuncSetAttribute((const void*)mega_fwd, hipFuncAttributeMaxDynamicSharedMemorySize, LDS_BYTES) != hipSuccess) { fprintf(stderr, "kernel_launch: hipFuncSetAttribute failed\n"); grid = -1; return; }
        if (hipOccupancyMaxActiveBlocksPerMultiprocessor(&per_cu, (const void*)mega_fwd, 512, LDS_BYTES) != hipSuccess || per_cu < 1) fprintf(stderr, "kernel_launch: occupancy query says %d\n", per_cu);
        (void)hipGetLastError();
        grid = cus;
    }
    if (grid < 0) return;
    (void)hipMemsetAsync((char*)d_ws + WS_CTL, 0, CTL_ZERO_BYTES, stream);
    Args a{};
    for (int i = 0; i < 34; ++i) a.in[i] = (const float*)d_in[i];
    a.out = (float*)d_out; a.ws = (unsigned char*)d_ws;
#if MK_SINGLE
    a.ph_lo = 0; a.ph_hi = N_PHASES;
    hipLaunchKernelGGL(mega_fwd, dim3(grid), dim3(512), LDS_BYTES, stream, a);
#else
    for (int p = 0; p < N_PHASES; ++p) { a.ph_lo = p; a.ph_hi = p + 1; hipLaunchKernelGGL(mega_fwd, dim3(grid), dim3(512), LDS_BYTES, stream, a); }
#endif
    const hipError_t le = hipPeekAtLastError();
    if (le != hipSuccess) fprintf(stderr, "kernel_launch: launch failed: %s\n", hipGetErrorName(le));
}
```
